# Optimizing an MI355X kernel written in HIP

```python
import jax, jax.numpy as jnp
from jax import lax
import numpy as np

D_MODEL = 1024
BATCH = 4
SEQ = 4096
DEPTH = 1
DEC_BATCH = 16
DEC_SEQ = 16
PAST_LEN = 2048

CHUNK = 64
D_MIX = D_MODEL
D_POOL = D_MIX // 2
D_CONV = D_MIX - D_POOL
POOL_WINDOWS = (2, 4, 8, 16)
N_POOL_GROUPS = len(POOL_WINDOWS)
POOL_GROUP = D_POOL // N_POOL_GROUPS
POOL_STATE = max(POOL_WINDOWS) - 1
N_CONV_HEADS = 8
CONV_WIDTH = 3
CONV_STATE = CONV_WIDTH - 1
D_IN = D_POOL + 3 * D_CONV
N_MEM = 256
N_XHEADS = 4
XHEAD_DIM = D_MODEL // N_XHEADS
D_FF = 4 * D_MODEL
EPS = 1e-6

kernel_name = 'hybrid_pool_conv_stream_encoder_step'


def rmsnorm(x, g):
    x32 = x.astype(jnp.float32)
    y = x32 * lax.rsqrt(jnp.mean(jnp.square(x32), axis=-1, keepdims=True) + EPS)
    return (y * g.astype(jnp.float32)).astype(x.dtype)


def group_rmsnorm(y, g, n_groups):
    b, t, d = y.shape
    y32 = y.astype(jnp.float32).reshape(b, t, n_groups, d // n_groups)
    y32 = y32 * lax.rsqrt(jnp.mean(jnp.square(y32), axis=-1, keepdims=True) + EPS)
    return (y32.reshape(b, t, d) * g.astype(jnp.float32)).astype(y.dtype)


def pool_mix(u_ext, start_pos, w_pool, pool_scale):
    b, l, _ = u_ext.shape
    t = l - POOL_STATE
    u32 = u_ext.astype(jnp.float32)
    cs = jnp.cumsum(jnp.pad(u32, ((0, 0), (1, 0), (0, 0))), axis=1)
    pos = start_pos + jnp.arange(t, dtype=jnp.int32)
    lo = POOL_STATE + 1
    outs = []
    for gi, w in enumerate(POOL_WINDOWS):
        sl = slice(gi * POOL_GROUP, (gi + 1) * POOL_GROUP)
        win_sum = cs[:, lo:lo + t, sl] - cs[:, lo - w:lo - w + t, sl]
        cnt = jnp.minimum(pos + 1, w).astype(jnp.float32)[None, :, None]
        outs.append(win_sum / cnt - u32[:, POOL_STATE:, sl])
    pooled = jnp.stack(outs, axis=2)
    mapped = jnp.einsum('btgc,gcd->btgd', pooled, w_pool.astype(jnp.float32))
    return (mapped.reshape(b, t, D_POOL) * pool_scale.astype(jnp.float32)).astype(u_ext.dtype)


def conv_mix(bg, cg, h, conv_prev, w_conv):
    v = cg * h
    v_ext = jnp.concatenate([conv_prev.astype(v.dtype), v], axis=1)
    t = v.shape[1]
    z = sum(w_conv[k] * v_ext[:, k:k + t] for k in range(CONV_WIDTH))
    return bg * z, v_ext[:, -CONV_STATE:]


def memory_kv(mem, g_mem, w_k, w_v):
    m = rmsnorm(mem, g_mem)
    k = jnp.einsum('bmd,dhe->bmhe', m, w_k)
    v = jnp.einsum('bmd,dhe->bmhe', m, w_v)
    return k, v


def cross_attn(xn, mem_k, mem_v, w_q, w_co):
    q = jnp.einsum('btd,dhe->bthe', xn, w_q)
    s = jnp.einsum('bthe,bmhe->bhtm', q, mem_k).astype(jnp.float32) * (XHEAD_DIM ** -0.5)
    p = jax.nn.softmax(s, axis=-1).astype(mem_v.dtype)
    o = jnp.einsum('bhtm,bmhe->bthe', p, mem_v)
    return jnp.einsum('bthe,hed->btd', o, w_co)


def encoder_layer(x, pool_prev, conv_prev, start_pos, mem_k, mem_v,
                  g_mix_pre, w_in, w_pool, pool_scale, w_conv, g_pool_out, g_conv_out, w_out,
                  g_mix_post, g_x_pre, w_q, w_co, g_x_post, g_ff_pre, w_up, w_down, g_ff_post):
    xn = rmsnorm(x, g_mix_pre)
    proj = xn @ w_in
    u, bg, cg, h = jnp.split(proj, [D_POOL, D_POOL + D_CONV, D_POOL + 2 * D_CONV], axis=-1)
    u_ext = jnp.concatenate([pool_prev.astype(u.dtype), u], axis=1)
    y_pool = pool_mix(u_ext, start_pos, w_pool, pool_scale)
    y_conv, conv_state = conv_mix(bg, cg, h, conv_prev, w_conv)
    merged = jnp.concatenate([group_rmsnorm(y_pool, g_pool_out, N_POOL_GROUPS),
                              group_rmsnorm(y_conv, g_conv_out, N_CONV_HEADS)], axis=-1)
    x = x + rmsnorm(merged @ w_out, g_mix_post)
    x = x + rmsnorm(cross_attn(rmsnorm(x, g_x_pre), mem_k, mem_v, w_q, w_co), g_x_post)
    hid = jnp.square(jax.nn.relu(rmsnorm(x, g_ff_pre) @ w_up))
    x = x + rmsnorm(hid @ w_down, g_ff_post)
    return x, u_ext[:, -POOL_STATE:], conv_state


def setup_inputs(seed: int = 0) -> dict:
    key = jax.random.key(seed)
    ks = iter(jax.random.split(key, 40))

    def nrm(shape, scale):
        return jax.random.normal(next(ks), shape, jnp.float32) * scale

    def gain(shape):
        return 1.0 + nrm(shape, 0.05)

    L = DEPTH
    return {
        'x_prompt': nrm((BATCH, SEQ, D_MODEL), 1.0),
        'x_sample': nrm((DEC_BATCH, DEC_SEQ, D_MODEL), 1.0),
        'state_pool': nrm((L, DEC_BATCH, POOL_STATE, D_POOL), 1.0),
        'state_conv': nrm((L, DEC_BATCH, CONV_STATE, D_CONV), 1.0),
        'cache_mem_k': nrm((L, DEC_BATCH, N_MEM, N_XHEADS, XHEAD_DIM), 1.0),
        'cache_mem_v': nrm((L, DEC_BATCH, N_MEM, N_XHEADS, XHEAD_DIM), 1.0),
        'mem_prompt': nrm((BATCH, N_MEM, D_MODEL), 1.0),
        'g_mix_pre': gain((L, D_MODEL)),
        'w_in': nrm((L, D_MODEL, D_IN), D_MODEL ** -0.5),
        'w_pool': nrm((L, N_POOL_GROUPS, POOL_GROUP, POOL_GROUP), POOL_GROUP ** -0.5),
        'pool_scale': 0.5 + nrm((L, D_POOL), 0.1),
        'w_conv': nrm((L, CONV_WIDTH, D_CONV), CONV_WIDTH ** -0.5),
        'g_pool_out': gain((L, D_POOL)),
        'g_conv_out': gain((L, D_CONV)),
        'w_out': nrm((L, D_MIX, D_MODEL), D_MIX ** -0.5),
        'g_mix_post': gain((L, D_MODEL)),
        'g_mem': gain((L, D_MODEL)),
        'w_k': nrm((L, D_MODEL, N_XHEADS, XHEAD_DIM), D_MODEL ** -0.5),
        'w_v': nrm((L, D_MODEL, N_XHEADS, XHEAD_DIM), D_MODEL ** -0.5),
        'g_x_pre': gain((L, D_MODEL)),
        'w_q': nrm((L, D_MODEL, N_XHEADS, XHEAD_DIM), D_MODEL ** -0.5),
        'w_co': nrm((L, N_XHEADS, XHEAD_DIM, D_MODEL), D_MODEL ** -0.5),
        'g_x_post': gain((L, D_MODEL)),
        'g_ff_pre': gain((L, D_MODEL)),
        'w_up': nrm((L, D_MODEL, D_FF), D_MODEL ** -0.5),
        'w_down': nrm((L, D_FF, D_MODEL), D_FF ** -0.5),
        'g_ff_post': gain((L, D_MODEL)),
    }


def reference(x_prompt, x_sample, state_pool, state_conv, cache_mem_k, cache_mem_v, mem_prompt,
              g_mix_pre, w_in, w_pool, pool_scale, w_conv, g_pool_out, g_conv_out, w_out,
              g_mix_post, g_mem, w_k, w_v, g_x_pre, w_q, w_co, g_x_post,
              g_ff_pre, w_up, w_down, g_ff_post):
    yp, ys = x_prompt, x_sample
    bp = x_prompt.shape[0]
    pool_p, conv_p, mk_p, mv_p, pool_s, conv_s = [], [], [], [], [], []
    for l in range(DEPTH):
        lw = (g_mix_pre[l], w_in[l], w_pool[l], pool_scale[l], w_conv[l], g_pool_out[l],
              g_conv_out[l], w_out[l], g_mix_post[l], g_x_pre[l], w_q[l], w_co[l], g_x_post[l],
              g_ff_pre[l], w_up[l], w_down[l], g_ff_post[l])
        mk, mv = memory_kv(mem_prompt, g_mem[l], w_k[l], w_v[l])
        zero_pool = jnp.zeros((bp, POOL_STATE, D_POOL), yp.dtype)
        zero_conv = jnp.zeros((bp, CONV_STATE, D_CONV), yp.dtype)
        yp, sp, cp = encoder_layer(yp, zero_pool, zero_conv, 0, mk, mv, *lw)
        ys, ss, cs = encoder_layer(ys, state_pool[l], state_conv[l], PAST_LEN,
                                   cache_mem_k[l], cache_mem_v[l], *lw)
        pool_p.append(sp); conv_p.append(cp); mk_p.append(mk); mv_p.append(mv)
        pool_s.append(ss); conv_s.append(cs)
    return (yp, ys, jnp.stack(pool_p), jnp.stack(conv_p), jnp.stack(mk_p), jnp.stack(mv_p),
            jnp.stack(pool_s), jnp.stack(conv_s))
```

```cpp
#include <hip/hip_runtime.h>
#include <cstdio>
#include <cstdint>

namespace pg8 {
#define PG8_LAS __attribute__((address_space(3)))
typedef unsigned short bf16_t;
typedef short bf16x8 __attribute__((ext_vector_type(8)));
typedef float f32x4 __attribute__((ext_vector_type(4)));
typedef unsigned u32x4 __attribute__((ext_vector_type(4)));
typedef unsigned u32x2 __attribute__((ext_vector_type(2)));
constexpr int BM = 256, BK = 64, HALF = 128, HTB = HALF * BK * 2  , STAGE_BYTES = 8 * HTB, NXCD = 8, WGM = 8;

__host__ __device__ __forceinline__ int lds_byte(int r, int c) { const int st = (r >> 4) * 2 + (c >> 5), rr = r & 15, cc = c & 31, ob = rr * 64 + cc * 2; return st * 1024 + (ob ^ (((ob >> 9) & 1) << 5)); }
__host__ __device__ __forceinline__ void stage_rc(int b, int& R, int& C) { const int st = b / 1024, sb = b % 1024, swz = sb ^ (((sb >> 9) & 1) << 5); R = (st >> 1) * 16 + swz / 64; C = (st & 1) * 32 + (swz % 64) / 2; }
__host__ __device__ __forceinline__ int perm32(int rho) { const int n = rho >> 4, i = rho & 15; return 8 * (i >> 2) + 4 * n + (i & 3); }

struct Unit { int pm, pn; };
struct Gemm { const bf16_t* A; const bf16_t* Bt; int M, N, K; };

struct StaticOrder {
    int nM, nN, nwg, G, c;
    __host__ __device__ void init(int M, int N, int G_, int c_) { nM = M / BM; nN = N / BM; nwg = nM * nN; G = G_; c = c_; }
    __host__ __device__ __forceinline__ bool next(int i, Unit& u) const {
        const long L = (long)i * G + c; if (L >= nwg) return false;
        int wgid = (int)L; { const int q = nwg / NXCD, r = nwg % NXCD, xcd = wgid % NXCD, off = wgid / NXCD; wgid = (xcd < r ? xcd * (q + 1) : r * (q + 1) + (xcd - r) * q) + off; }
        const int nig = WGM * nN, gid = wgid / nig, fm = gid * WGM, gsz = (nM - fm) < WGM ? (nM - fm) : WGM;
        u.pm = fm + ((wgid % nig) % gsz); u.pn = (wgid % nig) / gsz; return true;
    }
    __device__ __forceinline__ void a_ready(const Unit&) const {}
    __device__ __forceinline__ void done(const Unit&) const {}
};

__device__ __forceinline__ unsigned cvt_pk_bf16(float lo, float hi) { unsigned r; asm volatile("v_cvt_pk_bf16_f32 %0, %1, %2" : "=v"(r) : "v"(lo), "v"(hi)); return r; }

struct EpiF32 {
    static constexpr bool PERM = false, AFTER_DRAIN = false;
    float* C; int ldc;
    __device__ __forceinline__ void operator()(const f32x4 (&acc)[2][2][4][2], const Unit& u, int wr, int wc, int fr, int fq) const {
        const int row0 = u.pm * BM + wr * 64 + fr, col0 = u.pn * BM + wc * 32 + 4 * fq;
#pragma unroll
        for (int ai = 0; ai < 2; ++ai)
#pragma unroll
            for (int m = 0; m < 4; ++m) { float* rowp = C + (size_t)(row0 + ai * HALF + m * 16) * ldc + col0;
#pragma unroll
                for (int bj = 0; bj < 2; ++bj)
#pragma unroll
                    for (int n = 0; n < 2; ++n) *(f32x4*)(rowp + bj * HALF + n * 16) = acc[ai][bj][m][n]; }
    }
};
template <int ACT> struct EpiBf16 {
    static constexpr bool PERM = true, AFTER_DRAIN = false;
    bf16_t* O; int ldc;
    __device__ __forceinline__ void operator()(const f32x4 (&acc)[2][2][4][2], const Unit& u, int wr, int wc, int fr, int fq) const {
        const int row0 = u.pm * BM + wr * 64 + fr, col0 = u.pn * BM + wc * 32 + 8 * fq;
#pragma unroll
        for (int ai = 0; ai < 2; ++ai)
#pragma unroll
            for (int m = 0; m < 4; ++m) { bf16_t* rowp = O + (size_t)(row0 + ai * HALF + m * 16) * ldc + col0;
#pragma unroll
                for (int bj = 0; bj < 2; ++bj) { f32x4 v0 = acc[ai][bj][m][0], v1 = acc[ai][bj][m][1];
                    if (ACT == 1) {
#pragma unroll
                        for (int j = 0; j < 4; ++j) { const float a = fmaxf(v0[j], 0.f), b = fmaxf(v1[j], 0.f); v0[j] = a * a; v1[j] = b * b; } }
                    u32x4 w; w.x = cvt_pk_bf16(v0[0], v0[1]); w.y = cvt_pk_bf16(v0[2], v0[3]); w.z = cvt_pk_bf16(v1[0], v1[1]); w.w = cvt_pk_bf16(v1[2], v1[3]);
                    *(u32x4*)(rowp + bj * HALF) = w; } }
    }
};
struct Epi1 {
    static constexpr bool PERM = true, AFTER_DRAIN = false;
    bf16_t* P1; float* pool_p; float* conv_p; float* pool_s; float* conv_s;
    __device__ __forceinline__ void operator()(const f32x4 (&acc)[2][2][4][2], const Unit& u, int wr, int wc, int fr, int fq) const {
        const int row0 = u.pm * BM + wr * 64 + fr;
        const bool sample = (u.pm == 64), tailp = ((u.pm & 15) == 15) && !sample;
        if (u.pn < 4) {
            const int col0 = u.pn * BM + wc * 32 + 8 * fq;
#pragma unroll
            for (int ai = 0; ai < 2; ++ai)
#pragma unroll
                for (int m = 0; m < 4; ++m) { const int row = row0 + ai * HALF + m * 16; bf16_t* rowp = P1 + (size_t)row * 1536 + col0;
#pragma unroll
                    for (int bj = 0; bj < 2; ++bj) { const f32x4 v0 = acc[ai][bj][m][0], v1 = acc[ai][bj][m][1];
                        u32x4 w; w.x = cvt_pk_bf16(v0[0], v0[1]); w.y = cvt_pk_bf16(v0[2], v0[3]); w.z = cvt_pk_bf16(v1[0], v1[1]); w.w = cvt_pk_bf16(v1[2], v1[3]);
                        *(u32x4*)(rowp + bj * HALF) = w;
                        if (u.pn < 2) {
                            float* dst = nullptr;
                            if (sample) { const int t = row & 15, sb = (row >> 4) & 15; if (t >= 1) dst = pool_s + ((size_t)(sb * 15 + t - 1) * 512 + col0 + bj * HALF); }
                            else if (tailp) { const int t = row & 4095, b = row >> 12; if (t >= 4081) dst = pool_p + ((size_t)(b * 15 + t - 4081) * 512 + col0 + bj * HALF); }
                            if (dst) { *(f32x4*)dst = v0; *(f32x4*)(dst + 4) = v1; }
                        } } }
        } else {
            const int ch0 = (u.pn - 4) * 128 + wc * 32 + 8 * fq;
#pragma unroll
            for (int ai = 0; ai < 2; ++ai)
#pragma unroll
                for (int m = 0; m < 4; ++m) { const int row = row0 + ai * HALF + m * 16;
                    const f32x4 v0 = acc[ai][0][m][0] * acc[ai][1][m][0], v1 = acc[ai][0][m][1] * acc[ai][1][m][1];
                    u32x4 w; w.x = cvt_pk_bf16(v0[0], v0[1]); w.y = cvt_pk_bf16(v0[2], v0[3]); w.z = cvt_pk_bf16(v1[0], v1[1]); w.w = cvt_pk_bf16(v1[2], v1[3]);
                    *(u32x4*)(P1 + (size_t)row * 1536 + 1024 + ch0) = w;
                    float* dst = nullptr;
                    if (sample) { const int t = row & 15, sb = (row >> 4) & 15; if (t >= 14) dst = conv_s + ((size_t)(sb * 2 + t - 14) * 512 + ch0); }
                    else if (tailp) { const int t = row & 4095, b = row >> 12; if (t >= 4094) dst = conv_p + ((size_t)(b * 2 + t - 4094) * 512 + ch0); }
                    if (dst) { *(f32x4*)dst = v0; *(f32x4*)(dst + 4) = v1; } }
        }
    }
};
struct EpiKV {
    static constexpr bool PERM = false, AFTER_DRAIN = false;
    float* outK; float* outV; bf16_t* KB; bf16_t* VT;
    __device__ __forceinline__ void operator()(const f32x4 (&acc)[2][2][4][2], const Unit& u, int wr, int wc, int fr, int fq) const {
        const int row0 = u.pm * BM + wr * 64 + fr;
        if (u.pn < 4) {
            const int col0 = u.pn * BM + wc * 32 + 4 * fq;
#pragma unroll
            for (int ai = 0; ai < 2; ++ai)
#pragma unroll
                for (int m = 0; m < 4; ++m) { const size_t off = (size_t)(row0 + ai * HALF + m * 16) * 1024 + col0;
#pragma unroll
                    for (int bj = 0; bj < 2; ++bj)
#pragma unroll
                        for (int n = 0; n < 2; ++n) { const f32x4 v = acc[ai][bj][m][n]; __builtin_nontemporal_store(v, (f32x4*)(outK + off + bj * HALF + n * 16));
                            u32x2 w; w.x = cvt_pk_bf16(v[0], v[1]); w.y = cvt_pk_bf16(v[2], v[3]); *(u32x2*)(KB + off + bj * HALF + n * 16) = w; } }
        } else {
            const int h = u.pn - 4, e0 = wc * 32 + 4 * fq;
            bf16_t* vt = VT + (size_t)(u.pm * 4 + h) * 65536;
#pragma unroll
            for (int ai = 0; ai < 2; ++ai)
#pragma unroll
                for (int m = 0; m < 4; ++m) { const int mrow = wr * 64 + fr + ai * HALF + m * 16;
                    const int pos = (mrow & ~12) | ((mrow & 4) << 1) | ((mrow & 8) >> 1);
                    const size_t off = (size_t)(u.pm * BM + mrow) * 1024 + h * 256 + e0;
#pragma unroll
                    for (int bj = 0; bj < 2; ++bj)
#pragma unroll
                        for (int n = 0; n < 2; ++n) { const f32x4 v = acc[ai][bj][m][n]; __builtin_nontemporal_store(v, (f32x4*)(outV + off + bj * HALF + n * 16));
                            const unsigned w0 = cvt_pk_bf16(v[0], v[1]), w1 = cvt_pk_bf16(v[2], v[3]); const int e = e0 + bj * HALF + n * 16;
                            vt[(size_t)(e + 0) * 256 + pos] = (bf16_t)(w0 & 0xffffu); vt[(size_t)(e + 1) * 256 + pos] = (bf16_t)(w0 >> 16);
                            vt[(size_t)(e + 2) * 256 + pos] = (bf16_t)(w1 & 0xffffu); vt[(size_t)(e + 3) * 256 + pos] = (bf16_t)(w1 >> 16); } }
        }
    }
};


template <int ACT, bool TAB> struct EpiBf16S {
    static constexpr bool PERM = true, AFTER_DRAIN = false;
    bf16_t* O; int ldc; const float* rsp; const PG8_LAS float* rstab;
    __device__ __forceinline__ void operator()(const f32x4 (&acc)[2][2][4][2], const Unit& u, int wr, int wc, int fr, int fq) const {
        const int row0 = u.pm * BM + wr * 64 + fr, col0 = u.pn * BM + wc * 32 + 8 * fq;
#pragma unroll
        for (int ai = 0; ai < 2; ++ai)
#pragma unroll
            for (int m = 0; m < 4; ++m) { const int row = row0 + ai * HALF + m * 16; bf16_t* rowp = O + (size_t)row * ldc + col0;
                float rs;
                if (TAB) rs = rstab[wr * 64 + fr + ai * HALF + m * 16];
                else { const f32x4 p = *(const f32x4*)(rsp + (size_t)row * 4); rs = 1.0f / sqrtf(((p[0] + p[1]) + (p[2] + p[3])) * (1.0f / 1024.0f) + 1e-6f); }
#pragma unroll
                for (int bj = 0; bj < 2; ++bj) { f32x4 v0 = acc[ai][bj][m][0] * rs, v1 = acc[ai][bj][m][1] * rs;
                    if (ACT == 1) {
#pragma unroll
                        for (int j = 0; j < 4; ++j) { const float a = fmaxf(v0[j], 0.f), b = fmaxf(v1[j], 0.f); v0[j] = a * a; v1[j] = b * b; } }
                    u32x4 w; w.x = cvt_pk_bf16(v0[0], v0[1]); w.y = cvt_pk_bf16(v0[2], v0[3]); w.z = cvt_pk_bf16(v1[0], v1[1]); w.w = cvt_pk_bf16(v1[2], v1[3]);
                    *(u32x4*)(rowp + bj * HALF) = w; } }
    }
};

template <int MODE> struct EpiRes {
    static constexpr bool PERM = true, AFTER_DRAIN = true;
    const float* basef; bf16_t* X; float* outf; const float* g; unsigned* xbuf; unsigned* cnt; float* rsp; unsigned* tmo;
    __device__ __forceinline__ void fused(f32x4 (&acc)[2][2][4][2], const Unit& u, int wr, int wc, int fr, int fq, PG8_LAS unsigned char* lds, int wid, int lane) const {
        PG8_LAS float* P = (PG8_LAS float*)lds;
        PG8_LAS float* S = (PG8_LAS float*)(lds + 4096);
        PG8_LAS float* R = (PG8_LAS float*)(lds + 5120);
        const int col0 = u.pn * BM + wc * 32 + 8 * fq;
        u32x4 pre[4][2][1];
#pragma unroll
        for (int m = 0; m < 4; ++m) { const size_t off = (size_t)(u.pm * BM + wr * 64 + m * 16 + fr) * 1024 + col0;
#pragma unroll
            for (int bj = 0; bj < 2; ++bj) {
                pre[m][bj][0] = *(const u32x4*)(X + off + bj * HALF); } }
#pragma unroll
        for (int ai = 0; ai < 2; ++ai)
#pragma unroll
            for (int m = 0; m < 4; ++m) { float s = 0.f;
#pragma unroll
                for (int bj = 0; bj < 2; ++bj)
#pragma unroll
                    for (int n = 0; n < 2; ++n) { const f32x4 x = acc[ai][bj][m][n]; s += (x[0] * x[0] + x[1] * x[1]) + (x[2] * x[2] + x[3] * x[3]); }
                s += __shfl_xor(s, 16); s += __shfl_xor(s, 32);
                if (fq == 0) P[(ai * HALF + wr * 64 + m * 16 + fr) * 4 + wc] = s; }
        asm volatile("s_waitcnt lgkmcnt(0)" ::: "memory"); __builtin_amdgcn_s_barrier(); asm volatile("" ::: "memory");
        const int row = wid * 32 + (lane & 31);
        if (lane < 32) { const f32x4 p = *(const PG8_LAS f32x4*)(P + row * 4); const float t = (p[0] + p[1]) + (p[2] + p[3]);
            __hip_atomic_store(xbuf + (size_t)(u.pm * BM + row) * 4 + u.pn, __float_as_uint(t), __ATOMIC_RELAXED, __HIP_MEMORY_SCOPE_AGENT); }
        asm volatile("s_waitcnt vmcnt(0)" ::: "memory");
        if (lane == 0) __hip_atomic_fetch_add(cnt + 64 * u.pm, 1u, __ATOMIC_RELAXED, __HIP_MEMORY_SCOPE_AGENT);
        if (wid == 0) { unsigned sp = 0;
            while ((unsigned)__builtin_amdgcn_readfirstlane(__hip_atomic_load(cnt + 64 * u.pm, __ATOMIC_RELAXED, __HIP_MEMORY_SCOPE_AGENT)) < 32u) {
                __builtin_amdgcn_s_sleep(2);
                if ((++sp & 1023u) == 0u) { if (__hip_atomic_load(tmo, __ATOMIC_RELAXED, __HIP_MEMORY_SCOPE_AGENT) != 0u) break; if (sp > (1u << 22)) { if (lane == 0) __hip_atomic_store(tmo, 1u, __ATOMIC_RELAXED, __HIP_MEMORY_SCOPE_AGENT); break; } } }
            }
        asm volatile("s_waitcnt vmcnt(0) lgkmcnt(0)" ::: "memory"); __builtin_amdgcn_s_barrier(); asm volatile("" ::: "memory");
        if (lane < 32) { const unsigned* slot = xbuf + (size_t)(u.pm * BM + row) * 4; float t = 0.f;
#pragma unroll
            for (int k = 0; k < 4; ++k) t += __uint_as_float(__hip_atomic_load(slot + k, __ATOMIC_RELAXED, __HIP_MEMORY_SCOPE_AGENT));
            S[row] = 1.0f / sqrtf(t * (1.0f / 1024.0f) + 1e-6f);
            if (MODE == 1) R[row] = basef[u.pm * BM + row]; }
        asm volatile("s_waitcnt lgkmcnt(0)" ::: "memory"); __builtin_amdgcn_s_barrier(); asm volatile("" ::: "memory");
        f32x4 gv[2][2];
#pragma unroll
        for (int bj = 0; bj < 2; ++bj)
#pragma unroll
            for (int n = 0; n < 2; ++n) gv[bj][n] = *(const f32x4*)(g + col0 + bj * HALF + 4 * n);
#pragma unroll
        for (int ai = 0; ai < 2; ++ai)
#pragma unroll
            for (int m = 0; m < 4; ++m) { const int r = ai * HALF + wr * 64 + m * 16 + fr; const float sr = S[r], rn = MODE == 1 ? R[r] : 1.f; const size_t off = (size_t)(u.pm * BM + r) * 1024 + col0; float q = 0.f;
#pragma unroll
                for (int bj = 0; bj < 2; ++bj) { f32x4 b0, b1;
                    { const u32x4 w = ai == 0 ? pre[m][bj][0] : *(const u32x4*)(X + off + bj * HALF);
                        b0 = (f32x4){__uint_as_float(w.x << 16), __uint_as_float(w.x & 0xffff0000u), __uint_as_float(w.y << 16), __uint_as_float(w.y & 0xffff0000u)};
                        b1 = (f32x4){__uint_as_float(w.z << 16), __uint_as_float(w.z & 0xffff0000u), __uint_as_float(w.w << 16), __uint_as_float(w.w & 0xffff0000u)};
                        if (MODE == 1) { b0 = b0 * rn; b1 = b1 * rn; } }
                    const f32x4 v0 = b0 + acc[ai][bj][m][0] * sr * gv[bj][0], v1 = b1 + acc[ai][bj][m][1] * sr * gv[bj][1];
                    if (MODE == 3) { __builtin_nontemporal_store(v0, (f32x4*)(outf + off + bj * HALF)); __builtin_nontemporal_store(v1, (f32x4*)(outf + off + bj * HALF + 4)); }
                    else { q += ((v0[0] * v0[0] + v0[1] * v0[1]) + (v0[2] * v0[2] + v0[3] * v0[3])) + ((v1[0] * v1[0] + v1[1] * v1[1]) + (v1[2] * v1[2] + v1[3] * v1[3]));
                        u32x4 w; w.x = cvt_pk_bf16(v0[0], v0[1]); w.y = cvt_pk_bf16(v0[2], v0[3]); w.z = cvt_pk_bf16(v1[0], v1[1]); w.w = cvt_pk_bf16(v1[2], v1[3]);
                        *(u32x4*)(X + off + bj * HALF) = w; } }
                if (MODE != 3) { q += __shfl_xor(q, 16); q += __shfl_xor(q, 32); if (fq == 0) P[r * 4 + wc] = q; }
                if (m & 1) asm volatile("" ::: "memory"); }
        if (MODE != 3) {
            asm volatile("s_waitcnt lgkmcnt(0)" ::: "memory"); __builtin_amdgcn_s_barrier(); asm volatile("" ::: "memory");
            if (lane < 32) { const f32x4 p = *(const PG8_LAS f32x4*)(P + row * 4); rsp[(size_t)(u.pm * BM + row) * 4 + u.pn] = (p[0] + p[1]) + (p[2] + p[3]); }
        }
    }
};

template <class Epi, class Sched, bool ALIGN_EPI = false, bool SP2 = false>
__device__ __forceinline__ void gemm_phase(PG8_LAS unsigned char* lds, const Gemm g, const Sched& S, const Epi& E) {
    int tid_ = threadIdx.x; asm volatile("" : "+v"(tid_));
    const int tid = tid_, wid = __builtin_amdgcn_readfirstlane(tid >> 6), lane = tid & 63, wr = wid >> 2, wc = wid & 3, fr = lane & 15, fq = lane >> 4;
    const int K = g.K, nt = K / BK;
    unsigned voffA[2], voffB[2];
#pragma unroll
    for (int i = 0; i < 2; ++i) { int R, C; stage_rc(tid * 16 + i * 8192, R, C); const int Rb = Epi::PERM ? ((R & ~31) + perm32(R & 31)) : R;
        voffA[i] = (unsigned)(R * K + C) * 2u; voffB[i] = (unsigned)(Rb * K + C) * 2u; }
    const size_t kstep = (size_t)(BK * 2);
    const size_t hstep = (size_t)HALF * K * 2;
    const size_t tstep = 2 * hstep;
    const unsigned ldsw = (unsigned)wid * 1024u;
    const int aoff = lds_byte(wr * 64 + fr, fq * 8), boff = lds_byte(wc * 32 + fr, fq * 8);
#define PG8_SA(b, h) (((b) * 2 + (h)) * HTB)
#define PG8_SB(b, h) ((4 + (b) * 2 + (h)) * HTB)
#define PG8_STAGE(bufoff, gbase, voff) do { _Pragma("unroll") for (int _i = 0; _i < 2; ++_i) \
        __builtin_amdgcn_global_load_lds((const unsigned*)((const char*)(gbase) + (voff)[_i]), (PG8_LAS unsigned*)(lds + (bufoff) + ldsw + _i * 8192), 16, 0, 0); } while (0)
#define PG8_LDA(dst, b, h) do { _Pragma("unroll") for (int m = 0; m < 4; ++m) _Pragma("unroll") for (int k = 0; k < 2; ++k) dst[m][k] = *(const PG8_LAS bf16x8*)(lds + PG8_SA(b, h) + aoff + m * 2048 + k * 1024); } while (0)
#define PG8_LDB(dst, b, h) do { _Pragma("unroll") for (int n = 0; n < 2; ++n) _Pragma("unroll") for (int k = 0; k < 2; ++k) dst[n][k] = *(const PG8_LAS bf16x8*)(lds + PG8_SB(b, h) + boff + n * 2048 + k * 1024); } while (0)
#define PG8_MMA(ai, bj, At, Bt) do { __builtin_amdgcn_s_setprio(1); _Pragma("unroll") for (int m = 0; m < 4; ++m) _Pragma("unroll") for (int n = 0; n < 2; ++n) _Pragma("unroll") for (int k = 0; k < 2; ++k) \
        acc[ai][bj][m][n] = __builtin_amdgcn_mfma_f32_16x16x32_bf16(Bt[n][k], At[m][k], acc[ai][bj][m][n], 0, 0, 0); __builtin_amdgcn_s_setprio(0); } while (0)
#define PG8_WAIT_V(n) asm volatile("s_waitcnt vmcnt(" #n ")" ::: "memory")
#define PG8_WAIT_L(n) asm volatile("s_waitcnt lgkmcnt(" #n ")" ::: "memory")
#define PG8_BAR __builtin_amdgcn_s_barrier()
#define PG8_SCHED __builtin_amdgcn_sched_barrier(0)
    Unit cur, nxt; int ui = 0;
    if (!S.next(0, cur)) return;
    f32x4 acc[2][2][4][2];
#pragma unroll
    for (int a = 0; a < 2; ++a)
#pragma unroll
        for (int b = 0; b < 2; ++b)
#pragma unroll
            for (int m = 0; m < 4; ++m)
#pragma unroll
                for (int n = 0; n < 2; ++n) acc[a][b][m][n] = (f32x4){0.f, 0.f, 0.f, 0.f};
    bf16x8 At[4][2], B0[2][2], B1[2][2];
    const char* cA = (const char*)g.A + (size_t)cur.pm * tstep; const char* cB = (const char*)g.Bt + (size_t)cur.pn * tstep;
    S.a_ready(cur);
    if constexpr (SP2) {
        PG8_STAGE(PG8_SB(0, 0), cB, voffB); PG8_STAGE(PG8_SB(0, 1), cB + hstep, voffB); PG8_STAGE(PG8_SA(0, 0), cA, voffA); PG8_STAGE(PG8_SA(0, 1), cA + hstep, voffA);
        if (wr == 1) PG8_BAR;
        PG8_WAIT_V(2); PG8_BAR;
        PG8_STAGE(PG8_SB(1, 0), cB + kstep, voffB); PG8_STAGE(PG8_SA(1, 0), cA + kstep, voffA); PG8_STAGE(PG8_SB(1, 1), cB + hstep + kstep, voffB);
        PG8_WAIT_V(6); PG8_BAR;
    } else {
        PG8_STAGE(PG8_SB(0, 0), cB, voffB); PG8_STAGE(PG8_SA(0, 0), cA, voffA); PG8_STAGE(PG8_SB(0, 1), cB + hstep, voffB); PG8_STAGE(PG8_SA(0, 1), cA + hstep, voffA);
        if (wr == 1) PG8_BAR;
        PG8_WAIT_V(4); PG8_BAR;
        PG8_STAGE(PG8_SB(1, 0), cB + kstep, voffB); PG8_STAGE(PG8_SA(1, 0), cA + kstep, voffA); PG8_STAGE(PG8_SB(1, 1), cB + hstep + kstep, voffB);
        PG8_WAIT_V(6); PG8_BAR;
    }
    for (;;) {
        const bool has_next = S.next(ui + 1, nxt);
        const char* nA = has_next ? (const char*)g.A + (size_t)nxt.pm * tstep : cA; const char* nB = has_next ? (const char*)g.Bt + (size_t)nxt.pn * tstep : cB;
        for (int t = 0; t < nt; t += 2) {
            const bool last = (t == nt - 2);
            const char* a1 = cA + (size_t)(t + 1) * kstep;
            const char* a2 = last ? nA : cA + (size_t)(t + 2) * kstep; const char* b2 = last ? nB : cB + (size_t)(t + 2) * kstep;
            const char* a3 = a2 + kstep; const char* b3 = b2 + kstep;
            if (last && has_next) S.a_ready(nxt);
            if constexpr (SP2) {
            PG8_LDB(B0, 0, 0); PG8_LDB(B1, 0, 1); PG8_SCHED; PG8_LDA(At, 0, 0); PG8_STAGE(PG8_SA(1, 1), a1 + hstep, voffA);
            PG8_WAIT_V(8); PG8_WAIT_L(0); PG8_BAR; PG8_MMA(0, 0, At, B0); PG8_MMA(0, 1, At, B1); PG8_BAR; PG8_SCHED;
            PG8_LDA(At, 0, 1); PG8_STAGE(PG8_SB(0, 0), b2, voffB); PG8_STAGE(PG8_SB(0, 1), b2 + hstep, voffB); PG8_STAGE(PG8_SA(0, 0), a2, voffA);
            PG8_WAIT_V(8); PG8_WAIT_L(0); PG8_BAR; PG8_MMA(1, 0, At, B0); PG8_MMA(1, 1, At, B1); PG8_BAR; PG8_SCHED;
            PG8_LDB(B0, 1, 0); PG8_LDB(B1, 1, 1); PG8_SCHED; PG8_LDA(At, 1, 0); PG8_STAGE(PG8_SA(0, 1), a2 + hstep, voffA);
            PG8_WAIT_V(8); PG8_WAIT_L(0); PG8_BAR; PG8_MMA(0, 0, At, B0); PG8_MMA(0, 1, At, B1); PG8_BAR; PG8_SCHED;
            PG8_LDA(At, 1, 1); PG8_STAGE(PG8_SB(1, 0), b3, voffB); PG8_STAGE(PG8_SB(1, 1), b3 + hstep, voffB); PG8_STAGE(PG8_SA(1, 0), a3, voffA);
            PG8_WAIT_V(8); PG8_WAIT_L(0); PG8_BAR; PG8_MMA(1, 0, At, B0); PG8_MMA(1, 1, At, B1); PG8_BAR; PG8_SCHED;
            } else {
            PG8_LDB(B0, 0, 0); PG8_SCHED; PG8_LDA(At, 0, 0); PG8_STAGE(PG8_SA(1, 1), a1 + hstep, voffA);
            PG8_WAIT_L(8); PG8_BAR; PG8_WAIT_L(0); PG8_MMA(0, 0, At, B0); PG8_BAR; PG8_SCHED;
            PG8_LDB(B1, 0, 1); PG8_STAGE(PG8_SB(0, 0), b2, voffB);
            PG8_BAR; PG8_WAIT_L(0); PG8_MMA(0, 1, At, B1); PG8_BAR;
            PG8_LDA(At, 0, 1); PG8_STAGE(PG8_SA(0, 0), a2, voffA);
            PG8_BAR; PG8_WAIT_L(0); PG8_MMA(1, 0, At, B0); PG8_BAR; PG8_SCHED;
            PG8_STAGE(PG8_SB(0, 1), b2 + hstep, voffB);
            PG8_WAIT_V(6); PG8_BAR; PG8_MMA(1, 1, At, B1); PG8_BAR;
            PG8_LDB(B0, 1, 0); PG8_SCHED; PG8_LDA(At, 1, 0); PG8_STAGE(PG8_SA(0, 1), a2 + hstep, voffA);
            PG8_WAIT_L(8); PG8_BAR; PG8_WAIT_L(0); PG8_MMA(0, 0, At, B0); PG8_BAR; PG8_SCHED;
            PG8_LDB(B1, 1, 1); PG8_STAGE(PG8_SB(1, 0), b3, voffB);
            PG8_BAR; PG8_WAIT_L(0); PG8_MMA(0, 1, At, B1); PG8_BAR;
            PG8_LDA(At, 1, 1); PG8_STAGE(PG8_SA(1, 0), a3, voffA);
            PG8_BAR; PG8_WAIT_L(0); PG8_MMA(1, 0, At, B0); PG8_BAR; PG8_SCHED;
            PG8_STAGE(PG8_SB(1, 1), b3 + hstep, voffB);
            PG8_WAIT_V(6); PG8_BAR; PG8_MMA(1, 1, At, B1); PG8_BAR;
            }
        }
        if constexpr (ALIGN_EPI) { if (wr == 0) PG8_BAR; }
        if constexpr (!Epi::AFTER_DRAIN) { E(acc, cur, wr, wc, fr, fq); S.done(cur); }
        if (!has_next) break;
#pragma unroll
        for (int a = 0; a < 2; ++a)
#pragma unroll
            for (int b = 0; b < 2; ++b)
#pragma unroll
                for (int m = 0; m < 4; ++m)
#pragma unroll
                    for (int n = 0; n < 2; ++n) acc[a][b][m][n] = (f32x4){0.f, 0.f, 0.f, 0.f};
        cur = nxt; cA = nA; cB = nB; ++ui;
        if constexpr (ALIGN_EPI) { if (wr == 1) PG8_BAR; }
    }
    PG8_WAIT_V(0);
    if constexpr (!ALIGN_EPI) { if (wr == 0) PG8_BAR; }
    PG8_BAR;
    if constexpr (Epi::AFTER_DRAIN) { E.fused(acc, cur, wr, wc, fr, fq, lds, wid, lane); S.done(cur); }
#undef PG8_SA
#undef PG8_SB
#undef PG8_STAGE
#undef PG8_LDA
#undef PG8_LDB
#undef PG8_MMA
#undef PG8_WAIT_V
#undef PG8_WAIT_L
#undef PG8_BAR
#undef PG8_SCHED
}
}
constexpr int NWAVES = 8;
constexpr int D = 1024, MP = 16384, MS = 256, M = MP + MS, NIN = 2048, FF = 4096;
constexpr float EPS = 1e-6f;
constexpr size_t OUT_Y = 0, OUT_POOL_P = 17039360, OUT_CONV_P = 17070080, OUT_MK = 17074176, OUT_MV = 18122752, OUT_POOL_S = 19171328, OUT_CONV_S = 19294208, OUT_TOTAL = 19310592;
constexpr size_t MiB = 1u << 20;
constexpr size_t WS_CTL = 0, CTL_ZERO_BYTES = 128 * 1024;
constexpr size_t WS_WDOWN = 1 * MiB, WS_WUP = 9 * MiB, WS_WIN = 17 * MiB, WS_WKV = 21 * MiB, WS_WOUT = 25 * MiB, WS_WQ = 27 * MiB, WS_WCO = 29 * MiB, WS_WP = 31 * MiB;
constexpr size_t WS_HISTU = 31 * MiB + 512 * 1024, WS_HISTV = WS_HISTU + 16 * 15 * 512 * 2, WS_ZERO = 32 * 1024;
constexpr size_t WS_MN = 32 * MiB, WS_KB = 34 * MiB, WS_VT = 36 * MiB, WS_KBS = 38 * MiB, WS_VTS = 46 * MiB;
constexpr size_t WS_XN = 54 * MiB;
constexpr size_t WS_MRG = 87 * MiB;
constexpr size_t WS_AO = 87 * MiB;
constexpr size_t WS_P1 = 120 * MiB;
constexpr size_t WS_QO = 120 * MiB;
constexpr size_t WS_HID = 120 * MiB;
constexpr size_t WS_XB1 = 248 * MiB, WS_XB2 = WS_XB1 + 256 * 1024, WS_XB3 = WS_XB2 + 256 * 1024, WS_RSP1 = WS_XB3 + 256 * 1024, WS_RSP2 = WS_RSP1 + 256 * 1024;
constexpr size_t WS_SXB = 249 * MiB + 512 * 1024, WS_SRSP = WS_SXB + 3 * 32768;
constexpr size_t WS_RNORM = 249 * MiB + 768 * 1024;
constexpr size_t WS_SQO = 250 * MiB, WS_SAO = WS_SQO + 512 * 1024, WS_SRAW = 251 * MiB, WS_SHID = 252 * MiB;
constexpr size_t WS_END = 256 * MiB;
constexpr int CW_TMO = 0, CW_SEAM = 16384, CW_SSEAM = 16384 + 3 * 4096;
static_assert(WS_MRG + (size_t)M * D * 2 <= WS_P1 && WS_HID + (size_t)MP * FF * 2 <= WS_XB1 && WS_SHID + (size_t)MS * FF * 2 <= WS_END, "ws map");
constexpr int CW_BAR = 4096;

constexpr int RING_BYTES = 131072, LDSCTL_OFF = RING_BYTES, MISC_OFF = LDSCTL_OFF + 320, RSTAB_OFF = RING_BYTES + 1024, GGTAB_OFF = RING_BYTES + 2048, STASH_OFF = RING_BYTES + 4096, LDS_BYTES = 147456;

#define GAS __attribute__((address_space(1)))
#define LAS __attribute__((address_space(3)))
typedef unsigned short bf16;
typedef unsigned v4u __attribute__((ext_vector_type(4)));
typedef unsigned v2u __attribute__((ext_vector_type(2)));
typedef float f32x4 __attribute__((ext_vector_type(4)));
typedef float f32x16 __attribute__((ext_vector_type(16)));
typedef float f32x2 __attribute__((ext_vector_type(2)));
typedef short bf16x8 __attribute__((ext_vector_type(8)));
#define LDS_WAIT() asm volatile("s_waitcnt lgkmcnt(0)" ::: "memory")
#define VM_WAIT() asm volatile("s_waitcnt vmcnt(0)" ::: "memory")
__device__ __forceinline__ unsigned f2bf(float f) { unsigned u = __builtin_bit_cast(unsigned, f); return (u + 0x7fffu + ((u >> 16) & 1u)) >> 16; }
__device__ __forceinline__ unsigned pk2(float lo, float hi) { return pg8::cvt_pk_bf16(lo, hi); }
typedef __bf16 bf16n2 __attribute__((ext_vector_type(2)));
__device__ __forceinline__ unsigned pk2c(float lo, float hi) { const bf16n2 v = __builtin_convertvector((f32x2){lo, hi}, bf16n2); return __builtin_bit_cast(unsigned, v); }
__device__ __forceinline__ float bflo(unsigned w) { return __builtin_bit_cast(float, w << 16); }
__device__ __forceinline__ float bfhi(unsigned w) { return __builtin_bit_cast(float, w & 0xffff0000u); }

#define XB_TMO      128
#define XB_XCNT(j)  (256  + 64 * (j))
#define XB_XSUB(j)  (1280 + 64 * (j))
#define XB_XGEN(j)  (2304 + 64 * (j))
#define XB_TOP      3328
#define XB_TOPGEN   3392
#define XCD_BAR_WORDS 3456
#define XB_SPIN_CAP (1u << 22)
__device__ __forceinline__ unsigned xb_ld(unsigned* p)              { return __hip_atomic_load(p, __ATOMIC_RELAXED, __HIP_MEMORY_SCOPE_AGENT); }
__device__ __forceinline__ unsigned xb_add(unsigned* p, unsigned v) { return __hip_atomic_fetch_add(p, v, __ATOMIC_RELAXED, __HIP_MEMORY_SCOPE_AGENT); }
__device__ __forceinline__ unsigned xb_xcc_id() { return (unsigned)__builtin_amdgcn_s_getreg((3 << 11) | 20) & 0xFu; }
#define XB_SPIN(cond, bar) do { unsigned _sp = 0; while (cond) { __builtin_amdgcn_s_sleep(1); \
    if ((++_sp & 255u) == 0u) { if (xb_ld(&(bar)[XB_TMO])) break; if (_sp > XB_SPIN_CAP) { atomicAdd(&(bar)[XB_TMO], 1u); break; } } } } while (0)
struct XcdBarrier { unsigned* bar; unsigned x; volatile LAS unsigned* st; };
__device__ __forceinline__ XcdBarrier xcd_barrier_post(unsigned* bar, volatile LAS unsigned* st) {
    XcdBarrier b; b.bar = bar; b.x = xb_xcc_id(); b.st = st;
    if (threadIdx.x == 0) (void)xb_add(&bar[XB_XCNT(b.x)], 1u);
    return b;
}
__device__ __forceinline__ void xcd_barrier_complete(unsigned* bar, unsigned x, unsigned& nloc, unsigned& nx) {
    const unsigned G = gridDim.x * gridDim.y * gridDim.z;
    unsigned sum, cnt, mine, sp = 0u;
    for (;;) {
        sum = 0u; cnt = 0u; mine = 0u;
#pragma unroll
        for (unsigned j = 0; j < 16; ++j) { const unsigned c = xb_ld(&bar[XB_XCNT(j)]); sum += c; cnt += (c > 0u) ? 1u : 0u; mine = (j == x) ? c : mine; }
        if (sum == G) break;
        __builtin_amdgcn_s_sleep(1);
        if ((++sp & 255u) == 0u) { if (xb_ld(&bar[XB_TMO])) break; if (sp > XB_SPIN_CAP) { atomicAdd(&bar[XB_TMO], 1u); break; } }
    }
    nloc = mine > 0u ? mine : 1u; nx = cnt > 0u ? cnt : 1u;
}
__device__ __forceinline__ void xcd_barrier(const XcdBarrier& b) {
    asm volatile("s_waitcnt vmcnt(0)" ::: "memory");
    __syncthreads();
    if (threadIdx.x == 0) {
        unsigned* bar = b.bar;
        __builtin_amdgcn_s_waitcnt(0);
        unsigned nloc = b.st[0], nx = b.st[1];
        if (nloc == 0u) { xcd_barrier_complete(bar, b.x, nloc, nx); b.st[0] = nloc; b.st[1] = nx; }
        const unsigned old = xb_add(&bar[XB_XSUB(b.x)], 1u);
        const unsigned gen = old / nloc;
        if (old + 1u == (gen + 1u) * nloc) {
            __builtin_amdgcn_fence(__ATOMIC_RELEASE, "agent");
            asm volatile("s_waitcnt vmcnt(0)" ::: "memory");
            const unsigned og = xb_add(&bar[XB_TOP], 1u);
            const unsigned tg = og / nx;
            if (og + 1u == (tg + 1u) * nx) xb_add(&bar[XB_TOPGEN], 1u);
            else XB_SPIN(xb_ld(&bar[XB_TOPGEN]) == tg, bar);
            __builtin_amdgcn_fence(__ATOMIC_ACQUIRE, "agent");
            xb_add(&bar[XB_XGEN(b.x)], 1u);
            asm volatile("s_waitcnt vmcnt(0)" ::: "memory");
        } else {
            XB_SPIN(xb_ld(&bar[XB_XGEN(b.x)]) == gen, bar);
            __builtin_amdgcn_fence(__ATOMIC_ACQUIRE, "agent");
            asm volatile("s_waitcnt vmcnt(0)" ::: "memory");
        }
    }
    __syncthreads();
}

__device__ __forceinline__ void xcd_arrive(const XcdBarrier& b) {
    asm volatile("s_waitcnt vmcnt(0)" ::: "memory");
    __syncthreads();
    if (threadIdx.x == 0) {
        unsigned* bar = b.bar;
        __builtin_amdgcn_s_waitcnt(0);
        unsigned nloc = b.st[0], nx = b.st[1];
        if (nloc == 0u) { xcd_barrier_complete(bar, b.x, nloc, nx); b.st[0] = nloc; b.st[1] = nx; }
        const unsigned old = xb_add(&bar[XB_XSUB(b.x)], 1u);
        const unsigned gen = old / nloc;
        b.st[2] = gen;
        if (old + 1u == (gen + 1u) * nloc) {
            __builtin_amdgcn_fence(__ATOMIC_RELEASE, "agent");
            asm volatile("s_waitcnt vmcnt(0)" ::: "memory");
            (void)xb_add(&bar[XB_TOP], 1u);
        }
    }
}
__device__ __forceinline__ void xcd_wait(const XcdBarrier& b) {
    if (threadIdx.x == 0) {
        unsigned* bar = b.bar; const unsigned need = (b.st[2] + 1u) * b.st[1];
        XB_SPIN((int)(xb_ld(&bar[XB_TOP]) - need) < 0, bar);
        __builtin_amdgcn_fence(__ATOMIC_ACQUIRE, "agent");
        asm volatile("s_waitcnt vmcnt(0)" ::: "memory");
    }
    __syncthreads();
}

#define XB_LSUB(j)  (5120 + 64 * (j))
#define XB_GRP(j)   (6400 + 64 * (j))
#define XB_MIS      7040
__device__ __forceinline__ void xcd_local_barrier(const XcdBarrier& b) {
    asm volatile("s_waitcnt vmcnt(0)" ::: "memory");
    __syncthreads();
    if (threadIdx.x == 0) {
        unsigned* bar = b.bar;
        const unsigned nloc = b.st[0];
        const unsigned old = xb_add(&bar[XB_LSUB(b.x)], 1u);
        const unsigned need = (old / nloc + 1u) * nloc;
        XB_SPIN((int)(xb_ld(&bar[XB_LSUB(b.x)]) - need) < 0, bar);
        __builtin_amdgcn_fence(__ATOMIC_ACQUIRE, "agent");
        asm volatile("s_waitcnt vmcnt(0)" ::: "memory");
    }
    __syncthreads();
}

struct Args { const float* in[27]; float* out; unsigned char* ws; };

__device__ __forceinline__ float wave_sum(float v) {
#pragma unroll
    for (int o = 1; o < 64; o <<= 1) v += __shfl_xor(v, o);
    return v;
}

struct TItem { const float* W; const float* g; const float* gn; bf16* WT; int ldw, K, srccol, dstrow, k0; float sc; int kperm; };
struct TRegs { f32x4 v[8]; float gk[8]; };
__device__ __forceinline__ void t_load(const TItem& t, TRegs& r, int lane) {
    const int rl = lane >> 3, cq = lane & 7;
#pragma unroll
    for (int i = 0; i < 8; ++i) { const int kk = 8 * i + rl; r.v[i] = __builtin_nontemporal_load((const GAS f32x4*)(t.W + (size_t)(t.k0 + kk) * t.ldw + t.srccol + 4 * cq)); r.gk[i] = t.g ? t.g[t.k0 + kk] : 1.f; }
}
__device__ __forceinline__ void t_process(const TItem& t, const TRegs& r, LAS float* scr, int lane) {
    const int rl = lane >> 3, cq = lane & 7;
    f32x4 gn4 = (f32x4){1.f, 1.f, 1.f, 1.f}; if (t.gn) gn4 = *(const GAS f32x4*)(t.gn + t.srccol + 4 * cq);
#pragma unroll
    for (int i = 0; i < 8; ++i) { const int kk = 8 * i + rl; const float m = r.gk[i] * t.sc; LAS float* d = scr + kk * 33 + 4 * cq;
        d[0] = r.v[i].x * m * gn4.x; d[1] = r.v[i].y * m * gn4.y; d[2] = r.v[i].z * m * gn4.z; d[3] = r.v[i].w * m * gn4.w; }
    LDS_WAIT(); asm volatile("" ::: "memory");
    const int c = lane & 7;
    const int lp = t.kperm == 0 ? 8 * c : t.kperm == 1 ? (((c & 6) << 3) | ((c & 1) << 2)) : (((c & 4) << 3) | ((c & 3) << 2));
    const LAS float* s0 = scr + lp * 33; const LAS float* s1 = s0 + (4 << t.kperm) * 33;
#pragma unroll
    for (int j = 0; j < 4; ++j) { const int n = (lane >> 3) + 8 * j;
        float e[8];
#pragma unroll
        for (int q = 0; q < 8; ++q) e[q] = (q < 4 ? s0 : s1)[(q & 3) * 33 + n];
        v4u o; o.x = pk2(e[0], e[1]); o.y = pk2(e[2], e[3]); o.z = pk2(e[4], e[5]); o.w = pk2(e[6], e[7]);
        *(GAS v4u*)(t.WT + (size_t)(t.dstrow + n) * t.K + t.k0 + 8 * c) = o; }
    LDS_WAIT(); asm volatile("" ::: "memory");
}
__device__ __forceinline__ void rms_row_to_bf16(const float* xrow, bf16* orow, float* n0, int lane) {
    const GAS f32x4* xr = (const GAS f32x4*)xrow + lane;
    f32x4 v[4]; float s = 0.f;
#pragma unroll
    for (int j = 0; j < 4; ++j) { v[j] = __builtin_nontemporal_load(xr + 64 * j); s += (v[j].x * v[j].x + v[j].y * v[j].y) + (v[j].z * v[j].z + v[j].w * v[j].w); }
    const float rs = 1.f / sqrtf(wave_sum(s) * (1.f / D) + EPS);
    if (lane == 0 && n0) *n0 = 1.f / rs;
    GAS v2u* o8 = (GAS v2u*)orow + lane;
#pragma unroll
    for (int j = 0; j < 4; ++j) { v2u w; w.x = pk2(v[j].x * rs, v[j].y * rs); w.y = pk2(v[j].z * rs, v[j].w * rs); o8[64 * j] = w; }
}
__device__ __forceinline__ void rms_rows2_to_bf16(const float* x0, bf16* o0, const float* x1, bf16* o1, float* n0, float* n1, int lane) {
    const GAS f32x4* a0 = (const GAS f32x4*)x0 + lane; const GAS f32x4* a1 = (const GAS f32x4*)x1 + lane;
    f32x4 v[4], w[4]; float s = 0.f, t = 0.f;
#pragma unroll
    for (int j = 0; j < 4; ++j) { v[j] = __builtin_nontemporal_load(a0 + 64 * j); w[j] = __builtin_nontemporal_load(a1 + 64 * j); }
#pragma unroll
    for (int j = 0; j < 4; ++j) { s += (v[j].x * v[j].x + v[j].y * v[j].y) + (v[j].z * v[j].z + v[j].w * v[j].w); t += (w[j].x * w[j].x + w[j].y * w[j].y) + (w[j].z * w[j].z + w[j].w * w[j].w); }
    const float rs = 1.f / sqrtf(wave_sum(s) * (1.f / D) + EPS), rt_ = 1.f / sqrtf(wave_sum(t) * (1.f / D) + EPS);
    GAS v2u* p0 = (GAS v2u*)o0 + lane; GAS v2u* p1 = (GAS v2u*)o1 + lane;
    if (lane == 0) { if (n0) *n0 = 1.f / rs; if (n1) *n1 = 1.f / rt_; }
#pragma unroll
    for (int j = 0; j < 4; ++j) { v2u u; u.x = pk2(v[j].x * rs, v[j].y * rs); u.y = pk2(v[j].z * rs, v[j].w * rs); p0[64 * j] = u;
        v2u z; z.x = pk2(w[j].x * rt_, w[j].y * rt_); z.y = pk2(w[j].z * rt_, w[j].w * rt_); p1[64 * j] = z; }
}
__device__ __forceinline__ const float* xrow_ptr(const Args& a, int row) { return row < MP ? a.in[0] + (size_t)row * D : a.in[1] + (size_t)(row - MP) * D; }

constexpr int I_IN = 16 * 64, I_KV = 16 * 64, I_WP = 4 * 2 * 4, N_EARLY = I_IN + I_KV + I_WP;
constexpr int I_OUT = 16 * 32, I_Q = 16 * 32, I_CO = 16 * 32, I_UP = 16 * 128, I_DN = 64 * 32, I_VS = 64 * 4 * 8, N_ITEMS = N_EARLY + I_OUT + I_Q + I_CO + I_UP + I_DN + I_VS;
constexpr int DN_LO = N_EARLY + I_OUT + I_Q + I_CO + I_UP, DN_HI = DN_LO + I_DN;
__device__ __forceinline__ TItem p0_item(const Args& a, int it) {
    unsigned char* ws = a.ws; TItem t; t.g = nullptr; t.gn = nullptr; t.sc = 1.f; t.kperm = 0;
    int r = it;
    if (r < I_IN) { const int kb = r / 64, nb = r % 64, n0 = 32 * nb; int src;
        if (n0 < 1024) src = n0; else { const int j = (n0 - 1024) >> 8, o = (n0 - 1024) & 255; src = o < 128 ? 1024 + 128 * j + o : 1536 + 128 * j + (o - 128); }
        t.W = a.in[8]; t.ldw = NIN; t.K = D; t.srccol = src; t.WT = (bf16*)(ws + WS_WIN); t.dstrow = n0; t.k0 = 64 * kb; t.g = a.in[7]; return t; } r -= I_IN;
    if (r < I_KV) { const int kb = r / 64, nb = r % 64, n0 = 32 * nb;
        t.W = n0 < 1024 ? a.in[17] : a.in[18]; t.ldw = D; t.K = D; t.srccol = n0 & 1023; t.WT = (bf16*)(ws + WS_WKV); t.dstrow = n0; t.k0 = 64 * kb; t.g = a.in[16]; return t; } r -= I_KV;
    if (r < I_WP) { const int gi = r / 8, kb = (r % 8) / 4, nb = r % 4;
        t.W = a.in[9] + gi * 16384; t.ldw = 128; t.K = 128; t.srccol = 32 * nb; t.WT = (bf16*)(ws + WS_WP) + gi * 16384; t.dstrow = 32 * nb; t.k0 = 64 * kb; t.gn = a.in[10] + gi * 128; t.kperm = 2; return t; } r -= I_WP;
    if (r < I_OUT) { t.W = a.in[14]; t.ldw = D; t.K = D; t.srccol = 32 * (r % 32); t.WT = (bf16*)(ws + WS_WOUT); t.dstrow = t.srccol; t.k0 = 64 * (r / 32);
        t.g = t.k0 < 512 ? a.in[12] : a.in[13] - 512; return t; } r -= I_OUT;
    if (r < I_Q) { t.W = a.in[20]; t.ldw = D; t.K = D; t.srccol = 32 * (r % 32); t.WT = (bf16*)(ws + WS_WQ); t.dstrow = t.srccol; t.k0 = 64 * (r / 32); t.g = a.in[19]; t.sc = 0.0625f; return t; } r -= I_Q;
    if (r < I_CO) { t.W = a.in[21]; t.ldw = D; t.K = D; t.srccol = 32 * (r % 32); t.WT = (bf16*)(ws + WS_WCO); t.dstrow = t.srccol; t.k0 = 64 * (r / 32); return t; } r -= I_CO;
    if (r < I_UP) { t.W = a.in[24]; t.ldw = FF; t.K = D; t.srccol = 32 * (r % 128); t.WT = (bf16*)(ws + WS_WUP); t.dstrow = t.srccol; t.k0 = 64 * (r / 128); t.g = a.in[23]; return t; } r -= I_UP;
    if (r < I_DN) { t.W = a.in[25]; t.ldw = D; t.K = FF; t.srccol = 32 * (r % 32); t.WT = (bf16*)(ws + WS_WDOWN); t.dstrow = t.srccol; t.k0 = 64 * (r / 32); return t; } r -= I_DN;
    { const int sbh = r / 32, kb = (r % 32) / 8, nb = r % 8, sb = sbh >> 2, h = sbh & 3;
        t.W = a.in[5] + (size_t)sb * 262144 + h * 256; t.ldw = 1024; t.K = 256; t.srccol = 32 * nb; t.WT = (bf16*)(ws + WS_VTS) + (size_t)sbh * 65536; t.dstrow = 32 * nb; t.k0 = 64 * kb; t.kperm = 1; return t; }
}
__device__ __forceinline__ void p0_items(const Args& a, LAS float* scr, int lo, int hi, int gw, int NGW, int lane) {
    int it = lo + gw; TItem cur; TRegs rc;
    if (it < hi) { cur = p0_item(a, it); t_load(cur, rc, lane); }
    while (it < hi) {
        const int nx = it + NGW; TItem nxt = cur; TRegs rn = rc;
        if (nx < hi) { nxt = p0_item(a, nx); t_load(nxt, rn, lane); }
        t_process(cur, rc, scr, lane);
        cur = nxt; rc = rn; it = nx;
    }
}
__device__ __forceinline__ void p0_prologue(const Args& a, LAS unsigned char* lds, int gw, int NGW, int wave, int lane_) {
    int lane = lane_; asm volatile("" : "+v"(lane));
    unsigned char* ws = a.ws;
    p0_items(a, (LAS float*)(lds + wave * 16384), 0, N_EARLY, gw, NGW, lane);
    float* rn = (float*)(ws + WS_RNORM);
    for (int m = gw; m < M + 1024; m += 2 * NGW) {
        const int m2 = m + NGW;
        const float* r0 = m < M ? xrow_ptr(a, m) : a.in[6] + (size_t)(m - M) * D; bf16* o0 = m < M ? (bf16*)(ws + WS_XN) + (size_t)m * D : (bf16*)(ws + WS_MN) + (size_t)(m - M) * D;
        if (m2 < M + 1024) {
            const float* r1 = m2 < M ? xrow_ptr(a, m2) : a.in[6] + (size_t)(m2 - M) * D; bf16* o1 = m2 < M ? (bf16*)(ws + WS_XN) + (size_t)m2 * D : (bf16*)(ws + WS_MN) + (size_t)(m2 - M) * D;
            rms_rows2_to_bf16(r0, o0, r1, o1, m < MP ? rn + m : nullptr, m2 < MP ? rn + m2 : nullptr, lane);
        } else rms_row_to_bf16(r0, o0, m < MP ? rn + m : nullptr, lane);
    }
    { GAS v4u* dst = (GAS v4u*)(ws + WS_HISTU); constexpr int NU = 16 * 15 * 512 / 8, NV = 16 * 2 * 512 / 8;
      for (int i = gw * 64 + lane; i < NU + NV; i += NGW * 64) { const GAS f32x4* src = i < NU ? (const GAS f32x4*)a.in[2] + 2 * i : (const GAS f32x4*)a.in[3] + 2 * (i - NU); const f32x4 p = src[0], q = src[1];
          v4u o; o.x = pk2(p.x, p.y); o.y = pk2(p.z, p.w); o.z = pk2(q.x, q.y); o.w = pk2(q.z, q.w); dst[i] = o; } }
}
__device__ __forceinline__ void p2_late(const Args& a, LAS unsigned char* lds, int gw, int NGW, int wave, int lane_) {
    int lane = lane_; asm volatile("" : "+v"(lane));
    unsigned char* ws = a.ws;
    p0_items(a, (LAS float*)(lds + wave * 16384), N_EARLY, DN_LO, gw, NGW, lane);
    p0_items(a, (LAS float*)(lds + wave * 16384), DN_HI, N_ITEMS, gw, NGW, lane);
    { const GAS f32x4* src = (const GAS f32x4*)a.in[4]; GAS v4u* dst = (GAS v4u*)(ws + WS_KBS); const size_t n = (size_t)16 * 256 * 1024 / 8, st = (size_t)NGW * 64;
      for (size_t i = (size_t)gw * 64 + lane; i < n; i += 4 * st) { f32x4 p[4], q[4];
#pragma unroll
          for (int k = 0; k < 4; ++k) if (i + k * st < n) { p[k] = __builtin_nontemporal_load(src + 2 * (i + k * st)); q[k] = __builtin_nontemporal_load(src + 2 * (i + k * st) + 1); }
#pragma unroll
          for (int k = 0; k < 4; ++k) if (i + k * st < n) { v4u o; o.x = pk2(p[k].x, p[k].y); o.y = pk2(p[k].z, p[k].w); o.z = pk2(q[k].x, q[k].y); o.w = pk2(q[k].z, q[k].w); dst[i + k * st] = o; } } }
}

__device__ __forceinline__ void load8(const bf16* p, float (&f)[8]) { const v4u w = *(const GAS v4u*)p; f[0] = bflo(w.x); f[1] = bfhi(w.x); f[2] = bflo(w.y); f[3] = bfhi(w.y); f[4] = bflo(w.z); f[5] = bfhi(w.z); f[6] = bflo(w.w); f[7] = bfhi(w.w); }
__device__ __forceinline__ void load8f(const float* p, float (&f)[8]) { const f32x4 a = *(const GAS f32x4*)p, b = *(const GAS f32x4*)(p + 4); f[0] = a.x; f[1] = a.y; f[2] = a.z; f[3] = a.w; f[4] = b.x; f[5] = b.y; f[6] = b.z; f[7] = b.w; }
__device__ __forceinline__ void acc8(const v4u w, float (&s)[8]) { s[0] += bflo(w.x); s[1] += bfhi(w.x); s[2] += bflo(w.y); s[3] += bfhi(w.y); s[4] += bflo(w.z); s[5] += bfhi(w.z); s[6] += bflo(w.w); s[7] += bfhi(w.w); }
__device__ __forceinline__ void mixer_stage_wp(LAS unsigned char* lds, const bf16* WPt, int wave, int lane) {
    const GAS char* gb = (const GAS char*)WPt + (size_t)wave * 16384;
    const unsigned rl4 = (unsigned)lane >> 4, l15 = (unsigned)lane & 15u;
#pragma unroll
    for (int n = 0; n < 16; ++n) { const unsigned rl = 4u * n + rl4;
        __builtin_amdgcn_global_load_lds((const GAS unsigned*)(gb + rl * 256u + ((l15 ^ (rl & 15u)) << 4)), (LAS unsigned*)(lds + (wave * 16 + n) * 1024), 16, 0, 0); }
}
__device__ __forceinline__ unsigned off_b(unsigned row, unsigned ch) { return 256u * row + 16u * (ch ^ (((row & 3u) << 2) | ((row >> 2) & 3u))); }
template <int GI> __device__ __forceinline__ void pool_issue(const Args& a, LAS unsigned char* tile, int row0, int nblk, bool sample, int lane) {
    constexpr int W = 2 << GI;
    const unsigned fr = lane & 15, fq = lane >> 4;
    const int nrows = 16 * nblk + W - 1, t0 = sample ? 0 : (row0 & 4095), sb = (row0 >> 4) & 15;
    const GAS char* wsb = (const GAS char*)a.ws;
#pragma unroll
    for (int n = 0; n < 16; ++n) if (n < 4 * nblk + 4) {
        const int r = 4 * n + (int)fq, tt = t0 - (W - 1) + r;
        unsigned o;
        if (r >= nrows) o = (unsigned)WS_ZERO;
        else if (tt >= 0) o = (unsigned)WS_P1 + (unsigned)(row0 - (W - 1) + r) * 3072u + (unsigned)(GI * 256);
        else o = sample ? (unsigned)WS_HISTU + (unsigned)(sb * 15 + 15 + tt) * 1024u + (unsigned)(GI * 256) : (unsigned)WS_ZERO;
        const unsigned lc = fr ^ ((fq << 2) | (unsigned)(n & 3));
        __builtin_amdgcn_global_load_lds((const GAS unsigned*)(wsb + o + (lc << 4)), (LAS unsigned*)(tile + n * 1024), 16, 0, 0); }
}
template <int GI> __device__ __forceinline__ void pool_compute(const Args& a, LAS unsigned char* lds, LAS unsigned char* tile, int row0, int nblk, bool sample, int lane) {
    constexpr int W = 2 << GI;
    const int fr = lane & 15, fq = lane >> 4;
    bf16x8 wf[4][8];
    { const bf16* wp = (const bf16*)(a.ws + WS_WP) + GI * 16384 + (size_t)fr * 128 + fq * 8;
#pragma unroll
      for (int ks = 0; ks < 4; ++ks)
#pragma unroll
          for (int db = 0; db < 8; ++db) wf[ks][db] = *(const GAS bf16x8*)(wp + db * 2048 + ks * 32); }
    const unsigned tb = (unsigned)(size_t)tile, qq = (unsigned)(lane & 15) >> 2, pp = (unsigned)lane & 3u;
    bf16x8 cfg;
    { float cw[8]; int fr_ = fr, r8 = 8 * fq; asm volatile("" : "+v"(fr_), "+v"(r8));
#pragma unroll
      for (int jj = 0; jj < 8; ++jj) { const int r = r8 + jj; cw[jj] = ((r >= fr_ && r <= fr_ + W - 1) ? (1.f / W) : 0.f) - (r == fr_ + W - 1 ? 1.f : 0.f); }
      v4u pc; pc.x = pk2(cw[0], cw[1]); pc.y = pk2(cw[2], cw[3]); pc.z = pk2(cw[4], cw[5]); pc.w = pk2(cw[6], cw[7]); cfg = __builtin_bit_cast(bf16x8, pc); }
    asm volatile("s_waitcnt vmcnt(0)" ::: "memory");
#pragma unroll 1
    for (int i = 0; i < nblk; ++i) {
        const int row = row0 + 16 * i + fr, t = sample ? fr : (row & 4095);
        const float inv = sample ? (1.f / W) : 1.f / (float)(t + 1 < W ? t + 1 : W);
        bf16x8 cf = cfg;
        if (!sample && ((row0 + 16 * i) & 4095) == 0) {
          float cw[8];
          int fr_ = fr, r8 = 8 * fq; asm volatile("" : "+v"(fr_), "+v"(r8));
#pragma unroll
          for (int jj = 0; jj < 8; ++jj) { const int r = r8 + jj; cw[jj] = ((r >= fr_ && r <= fr_ + W - 1) ? inv : 0.f) - (r == fr_ + W - 1 ? 1.f : 0.f); }
          v4u pc; pc.x = pk2(cw[0], cw[1]); pc.y = pk2(cw[2], cw[3]); pc.z = pk2(cw[4], cw[5]); pc.w = pk2(cw[6], cw[7]); cf = __builtin_bit_cast(bf16x8, pc); }
        v4u pa[4];
#pragma unroll
        for (int cb = 0; cb < 8; cb += 2) {
            unsigned ad[4];
#pragma unroll
            for (int k = 0; k < 4; ++k) { const unsigned c_ = cb + (k >> 1), tt = k & 1; ad[k] = tb + 4096u * i + off_b(8u * fq + 4u * tt + qq, 2u * c_ + (pp >> 1)) + 8u * (pp & 1u); }
            v2u r0, r1, r2, r3;
            asm volatile("ds_read_b64_tr_b16 %0, %4\n\tds_read_b64_tr_b16 %1, %5\n\tds_read_b64_tr_b16 %2, %6\n\tds_read_b64_tr_b16 %3, %7\n\ts_waitcnt lgkmcnt(0)"
                         : "=&v"(r0), "=&v"(r1), "=&v"(r2), "=&v"(r3) : "v"(ad[0]), "v"(ad[1]), "v"(ad[2]), "v"(ad[3]) : "memory");
            v4u f0; f0.x = r0.x; f0.y = r0.y; f0.z = r1.x; f0.w = r1.y;
            v4u f1; f1.x = r2.x; f1.y = r2.y; f1.z = r3.x; f1.w = r3.y;
            const pg8::f32x4 p0 = __builtin_amdgcn_mfma_f32_16x16x32_bf16(__builtin_bit_cast(bf16x8, f0), cf, (pg8::f32x4){0.f, 0.f, 0.f, 0.f}, 0, 0, 0);
            const pg8::f32x4 p1 = __builtin_amdgcn_mfma_f32_16x16x32_bf16(__builtin_bit_cast(bf16x8, f1), cf, (pg8::f32x4){0.f, 0.f, 0.f, 0.f}, 0, 0, 0);
            pa[cb >> 1].x = pk2c(p0[0], p0[1]); pa[cb >> 1].y = pk2c(p0[2], p0[3]); pa[cb >> 1].z = pk2c(p1[0], p1[1]); pa[cb >> 1].w = pk2c(p1[2], p1[3]);
        }
        pg8::f32x4 acc[8];
#pragma unroll
        for (int db = 0; db < 8; ++db) acc[db] = (pg8::f32x4){0.f, 0.f, 0.f, 0.f};
#pragma unroll
        for (int ks = 0; ks < 4; ++ks) { const bf16x8 pf = __builtin_bit_cast(bf16x8, pa[ks]);
#pragma unroll
            for (int db = 0; db < 8; ++db) acc[db] = __builtin_amdgcn_mfma_f32_16x16x32_bf16(wf[ks][db], pf, acc[db], 0, 0, 0); }
        float ss = 0.f;
#pragma unroll
        for (int db = 0; db < 8; ++db) ss += (acc[db][0] * acc[db][0] + acc[db][1] * acc[db][1]) + (acc[db][2] * acc[db][2] + acc[db][3] * acc[db][3]);
        ss += __shfl_xor(ss, 16); ss += __shfl_xor(ss, 32);
        const float rs = 1.f / sqrtf(ss * (1.f / 128.f) + EPS);
        bf16* MRG = (bf16*)(a.ws + WS_MRG);
#pragma unroll
        for (int db = 0; db < 8; ++db) { const f32x4 o = acc[db] * rs;
            v2u w; w.x = pk2(o[0], o[1]); w.y = pk2(o[2], o[3]); *(GAS v2u*)(MRG + (size_t)row * D + GI * 128 + 16 * db + 4 * fq) = w; }
    }
}
__device__ __forceinline__ f32x2 up2(unsigned w) { f32x2 r; r.x = bflo(w); r.y = bfhi(w); return r; }
__device__ __forceinline__ unsigned pk2v(f32x2 v) { const bf16n2 b = __builtin_convertvector(v, bf16n2); return __builtin_bit_cast(unsigned, b); }
template <int CTRL> __device__ __forceinline__ float dpp_f(float v) { return __builtin_bit_cast(float, __builtin_amdgcn_update_dpp(0, __builtin_bit_cast(int, v), CTRL, 0xf, 0xf, true)); }
__device__ __forceinline__ void conv_half(const Args& a, int row0, int half, bool sample, int lane) {
    const bf16* P1 = (const bf16*)(a.ws + WS_P1); bf16* MRG = (bf16*)(a.ws + WS_MRG);
    const int ch = 8 * lane, i0 = 8 * half;
    const bf16* histv = sample ? (const bf16*)(a.ws + WS_HISTV) + (size_t)(((row0 >> 4) & 15) * 2 + 2) * 512 : (const bf16*)(a.ws + WS_ZERO);
    const int hstep = sample ? 512 : 0, t0 = sample ? 0 : (row0 & 4095);
    v4u xv[10], xb[8];
#pragma unroll
    for (int k = 0; k < 10; ++k) { const int i = i0 + k - 2; const bf16* p = (t0 + i >= 0) ? P1 + (size_t)(row0 + i) * 1536 + 1024 : histv + (ptrdiff_t)i * hstep; xv[k] = *(const GAS v4u*)(p + ch); }
#pragma unroll
    for (int k = 0; k < 8; ++k) xb[k] = *(const GAS v4u*)(P1 + (size_t)(row0 + i0 + k) * 1536 + 512 + ch);
    f32x2 w0[4], w1[4], w2[4];
#pragma unroll
    for (int q = 0; q < 4; ++q) { w0[q] = *(const GAS f32x2*)(a.in[11] + ch + 2 * q); w1[q] = *(const GAS f32x2*)(a.in[11] + 512 + ch + 2 * q); w2[q] = *(const GAS f32x2*)(a.in[11] + 1024 + ch + 2 * q); }
    f32x2 va[4], vb[4], vc[4];
#pragma unroll
    for (int q = 0; q < 4; ++q) { va[q] = up2(xv[0][q]); vb[q] = up2(xv[1][q]); }
#pragma unroll
    for (int k = 0; k < 8; ++k) {
        f32x2 y[4]; f32x2 s2 = {0.f, 0.f};
#pragma unroll
        for (int q = 0; q < 4; ++q) { vc[q] = up2(xv[k + 2][q]); const f32x2 bg = up2(xb[k][q]);
            f32x2 cv = w0[q] * va[q]; cv = __builtin_elementwise_fma(w1[q], vb[q], cv); cv = __builtin_elementwise_fma(w2[q], vc[q], cv);
            y[q] = bg * cv; s2 = __builtin_elementwise_fma(y[q], y[q], s2); }
        float ss = s2.x + s2.y;
        ss += dpp_f<0xB1>(ss); ss += dpp_f<0x4E>(ss); ss += dpp_f<0x141>(ss);
        const float rs = 1.f / sqrtf(ss * (1.f / 64.f) + EPS);
        v4u o;
#pragma unroll
        for (int q = 0; q < 4; ++q) { const f32x2 r2 = {rs, rs}; o[q] = pk2v(y[q] * r2); }
        *(GAS v4u*)(MRG + (size_t)(row0 + i0 + k) * D + 512 + ch) = o;
#pragma unroll
        for (int q = 0; q < 4; ++q) { va[q] = vb[q]; vb[q] = vc[q]; }
    }
}
__device__ __forceinline__ void unpack8(const v4u w, float (&f)[8]) { f[0] = bflo(w.x); f[1] = bfhi(w.x); f[2] = bflo(w.y); f[3] = bfhi(w.y); f[4] = bflo(w.z); f[5] = bfhi(w.z); f[6] = bflo(w.w); f[7] = bfhi(w.w); }
__device__ __forceinline__ int mixer_blk(int xg, int bl) { return xg < 0 ? bl : (bl < 128 ? xg * 128 + bl : 1024 + xg * 2 + (bl - 128)); }
template <int GI> __device__ __forceinline__ void mixer_wave(const Args& a, LAS unsigned char* lds, int xg, int j, int nj, int wave, int lane) {
    LAS unsigned char* tile = lds + wave * 16384;
    if (xg >= 0 && nj == 56) {
        int bl0 = -1, nblk = 0;
        if (j < 42) { bl0 = 3 * j; nblk = 3; } else if (j == 42) { bl0 = 126; nblk = 2; } else if (j < 45) { bl0 = 128 + (j - 43); nblk = 1; }
        const int row0 = bl0 >= 0 ? mixer_blk(xg, bl0) * 16 : 0; const bool sample = row0 >= MP;
        if (nblk) pool_issue<GI>(a, tile, row0, nblk, sample, lane);
        int c0 = -1, c1 = -1;
        if (j >= 45) { c0 = 2 * (j - 45); c1 = c0 + 1; } else if (j <= 42) c0 = 22 + j;
        if (c0 >= 0) { const int h = 4 * c0 + GI, r0 = mixer_blk(xg, h >> 1) * 16; conv_half(a, r0, h & 1, r0 >= MP, lane); }
        if (c1 >= 0) { const int h = 4 * c1 + GI, r0 = mixer_blk(xg, h >> 1) * 16; conv_half(a, r0, h & 1, r0 >= MP, lane); }
        asm volatile("" ::: "memory");
        if (nblk) pool_compute<GI>(a, lds, tile, row0, nblk, sample, lane);
    } else {
        const int nb = xg >= 0 ? 130 : M / 16;
        for (int bl = j; bl < nb; bl += nj) { const int row0 = mixer_blk(xg, bl) * 16;
            pool_issue<GI>(a, tile, row0, 1, row0 >= MP, lane); pool_compute<GI>(a, lds, tile, row0, 1, row0 >= MP, lane); }
        for (int h = j * 4 + GI; h < 2 * nb; h += nj * 4) { const int r0 = mixer_blk(xg, h >> 1) * 16; conv_half(a, r0, h & 1, r0 >= MP, lane); }
    }
}
__device__ __forceinline__ void mixer_all(const Args& a, LAS unsigned char* lds, int xg, int cu, int ncu, int wave, int lane_) {
    int lane = lane_; asm volatile("" : "+v"(lane));
    const int gi = wave & 3, j = cu * 2 + (wave >> 2), nj = ncu * 2;
    if (gi == 0) mixer_wave<0>(a, lds, xg, j, nj, wave, lane);
    else if (gi == 1) mixer_wave<1>(a, lds, xg, j, nj, wave, lane);
    else if (gi == 2) mixer_wave<2>(a, lds, xg, j, nj, wave, lane);
    else mixer_wave<3>(a, lds, xg, j, nj, wave, lane);
}

__device__ __forceinline__ void resid_row(const float* base, const float* raw, const float* g, float* xo, bf16* xn, int lane_) {
    int lane = lane_; asm volatile("" : "+v"(lane));
    const GAS f32x4* rr = (const GAS f32x4*)raw + lane; const GAS f32x4* bb = (const GAS f32x4*)base + lane; const GAS f32x4* gg = (const GAS f32x4*)g + lane;
    f32x4 v[4]; float s = 0.f;
#pragma unroll
    for (int j = 0; j < 4; ++j) { v[j] = rr[64 * j]; s += (v[j].x * v[j].x + v[j].y * v[j].y) + (v[j].z * v[j].z + v[j].w * v[j].w); }
    const float rs = 1.f / sqrtf(wave_sum(s) * (1.f / D) + EPS);
    float s2 = 0.f;
#pragma unroll
    for (int j = 0; j < 4; ++j) { v[j] = bb[64 * j] + v[j] * rs * gg[64 * j]; s2 += (v[j].x * v[j].x + v[j].y * v[j].y) + (v[j].z * v[j].z + v[j].w * v[j].w); }
    GAS f32x4* oo = (GAS f32x4*)xo + lane;
#pragma unroll
    for (int j = 0; j < 4; ++j) oo[64 * j] = v[j];
    if (xn) { const float r2 = 1.f / sqrtf(wave_sum(s2) * (1.f / D) + EPS); GAS v2u* o8 = (GAS v2u*)xn + lane;
#pragma unroll
        for (int j = 0; j < 4; ++j) { v2u w; w.x = pk2(v[j].x * r2, v[j].y * r2); w.y = pk2(v[j].z * r2, v[j].w * r2); o8[64 * j] = w; } }
}

#define MFMA32(a, b, c) __builtin_amdgcn_mfma_f32_32x32x16_bf16((a), (b), (c), 0, 0, 0)
__device__ __forceinline__ bf16x8 pack8(const f32x16& x, int s) {
    v4u p; p.x = pk2(x[8 * s], x[8 * s + 1]); p.y = pk2(x[8 * s + 2], x[8 * s + 3]); p.z = pk2(x[8 * s + 4], x[8 * s + 5]); p.w = pk2(x[8 * s + 6], x[8 * s + 7]);
    return __builtin_bit_cast(bf16x8, p);
}
__device__ __forceinline__ void attn_stage(LAS unsigned char* lds, const bf16* G, unsigned pitch  , int wave, int lane) {
    const GAS char* gb = (const GAS char*)G + (size_t)wave * 32 * pitch;
    const unsigned hi = (unsigned)lane >> 5, l31 = (unsigned)lane & 31u;
#pragma unroll
    for (int n = 0; n < 16; ++n) { const unsigned rl = 2u * n + hi;
        const unsigned off = rl * pitch + ((l31 ^ (rl & 15u)) << 4);
        __builtin_amdgcn_global_load_lds((const GAS unsigned*)(gb + off), (LAS unsigned*)(lds + (wave * 16 + n) * 1024), 16, 0, 0); }
}
__device__ __forceinline__ void attn_unit(LAS unsigned char* lds, const bf16* Qb, bf16* Ob, unsigned qoff, const bf16* Kg, const bf16* VTg, bool store, int wave, int lane_) {
    int lane = lane_; asm volatile("" : "+v"(lane));
    const int r = lane & 31, h = lane >> 5;
    attn_stage(lds, Kg, 2048u, wave, lane);
    const GAS char* qp = (const GAS char*)Qb;
    const unsigned qo = qoff + 16u * h;
    const unsigned x = (unsigned)(h ^ (r & 15));
    const LAS unsigned char* fo[8]; const LAS unsigned char* fo2[8];
#pragma unroll
    for (int k = 0; k < 8; ++k) { fo[k] = lds + ((unsigned)r * 512u + (((unsigned)(2 * k) ^ x) * 16u)); fo2[k] = fo[k] + 65536; asm volatile("" : "+v"(fo2[k])); }
    bf16x8 qf[8];
#pragma unroll
    for (int k = 0; k < 8; ++k) qf[k] = *(const GAS bf16x8*)(qp + qo + 32 * k);
    asm volatile("s_waitcnt vmcnt(0)" ::: "memory"); __syncthreads();
    f32x16 s[8];
#pragma unroll
    for (int mb = 0; mb < 8; ++mb)
#pragma unroll
        for (int i = 0; i < 16; ++i) s[mb][i] = 0.f;
#pragma unroll
    for (int hf = 0; hf < 2; ++hf) {
        if (hf == 1) {
#pragma unroll
            for (int k = 0; k < 8; ++k) qf[k] = *(const GAS bf16x8*)(qp + qo + 256 + 32 * k);
        }
        bf16x8 kc[8], kn[8];
#pragma unroll
        for (int k = 0; k < 8; ++k) kc[k] = *(const LAS bf16x8*)(fo[k] + hf * 256);
#pragma unroll
        for (int mb = 0; mb < 8; ++mb) {
            if (mb < 7) {
#pragma unroll
                for (int k = 0; k < 8; ++k) kn[k] = *(const LAS bf16x8*)((mb + 1 < 4 ? fo[k] : fo2[k]) + (((mb + 1) & 3) * 16384 + hf * 256)); }
            __builtin_amdgcn_s_setprio(1);
#pragma unroll
            for (int k = 0; k < 8; ++k) s[mb] = MFMA32(kc[k], qf[k], s[mb]);
            __builtin_amdgcn_s_setprio(0);
#pragma unroll
            for (int k = 0; k < 8; ++k) kc[k] = kn[k];
            asm volatile("" ::: "memory");
        }
    }
    asm volatile("s_waitcnt lgkmcnt(0)" ::: "memory"); __syncthreads();
    { int lane2 = lane; asm volatile("" : "+v"(lane2)); attn_stage(lds, VTg, 512u, wave, lane2); }
    float mx = -3.0e38f;
#pragma unroll
    for (int mb = 0; mb < 8; ++mb)
#pragma unroll
        for (int i = 0; i < 16; ++i) mx = fmaxf(mx, s[mb][i]);
    mx = fmaxf(mx, __shfl_xor(mx, 32));
    float sum = 0.f;
#pragma unroll
    for (int mb = 0; mb < 8; ++mb)
#pragma unroll
        for (int i = 0; i < 16; ++i) { const float p = __builtin_amdgcn_exp2f((s[mb][i] - mx) * 1.44269504089f); s[mb][i] = p; sum += p; }
    sum += __shfl_xor(sum, 32);
    const float inv = 1.f / sum;
    bf16x8 pf[8][2];
#pragma unroll
    for (int mb = 0; mb < 8; ++mb) { pf[mb][0] = pack8(s[mb], 0); pf[mb][1] = pack8(s[mb], 1); }
    asm volatile("s_waitcnt vmcnt(0)" ::: "memory"); __syncthreads();
    GAS char* op = (GAS char*)Ob;
    bf16x8 vc[8], vn[8];
#pragma unroll
    for (int k = 0; k < 8; ++k) vc[k] = *(const LAS bf16x8*)(fo[k]);
#pragma unroll
    for (int eb = 0; eb < 8; ++eb) {
        f32x16 o;
#pragma unroll
        for (int i = 0; i < 16; ++i) o[i] = 0.f;
#pragma unroll
        for (int hv = 0; hv < 2; ++hv) {
            const int nstep = 2 * eb + hv + 1;
            if (nstep < 16) { const int neb = nstep >> 1, nhv = nstep & 1;
#pragma unroll
                for (int k = 0; k < 8; ++k) vn[k] = *(const LAS bf16x8*)((neb < 4 ? fo[k] : fo2[k]) + ((neb & 3) * 16384 + nhv * 256)); }
            __builtin_amdgcn_s_setprio(1);
#pragma unroll
            for (int k = 0; k < 8; ++k) o = MFMA32(vc[k], pf[4 * hv + (k >> 1)][k & 1], o);
            __builtin_amdgcn_s_setprio(0);
#pragma unroll
            for (int k = 0; k < 8; ++k) vc[k] = vn[k];
            asm volatile("" ::: "memory");
        }
        if (store) {
#pragma unroll
            for (int g = 0; g < 4; ++g) { v2u w; w.x = pk2(o[4 * g] * inv, o[4 * g + 1] * inv); w.y = pk2(o[4 * g + 2] * inv, o[4 * g + 3] * inv);
                *(GAS v2u*)(op + qoff + 8u * h + (64 * eb + 16 * g)) = w; }
        }
    }
    asm volatile("s_waitcnt lgkmcnt(0)" ::: "memory"); __syncthreads();
}

__device__ __forceinline__ void attn_unit_small(LAS unsigned char* lds, const bf16* Qb, bf16* Ob, const bf16* Kg, const bf16* VTg, int wave, int lane_) {
    int lane = lane_; asm volatile("" : "+v"(lane));
    const int r = lane & 31, h = lane >> 5;
    const GAS char* qp = (const GAS char*)Qb; const GAS char* kp = (const GAS char*)Kg + (size_t)wave * 65536; const GAS char* vp = (const GAS char*)VTg + (size_t)wave * 16384;
    const unsigned qo = (unsigned)(r & 15) * 2048u + 16u * h, ko = (unsigned)r * 2048u + 16u * h, vo = (unsigned)r * 512u + 16u * h;
    bf16x8 qf[16], kf[16], vf[16];
#pragma unroll
    for (int ks = 0; ks < 16; ++ks) { qf[ks] = *(const GAS bf16x8*)(qp + qo + 32 * ks); kf[ks] = *(const GAS bf16x8*)(kp + ko + 32 * ks); }
#pragma unroll
    for (int c = 0; c < 16; ++c) vf[c] = *(const GAS bf16x8*)(vp + vo + 32 * c);
    f32x16 s;
#pragma unroll
    for (int i = 0; i < 16; ++i) s[i] = 0.f;
#pragma unroll
    for (int ks = 0; ks < 16; ++ks) s = MFMA32(kf[ks], qf[ks], s);
    LAS float* red = (LAS float*)lds;
    LAS unsigned char* pbuf = lds + 4096;
    float mx = s[0];
#pragma unroll
    for (int i = 1; i < 16; ++i) mx = fmaxf(mx, s[i]);
    mx = fmaxf(mx, __shfl_xor(mx, 32));
    if (h == 0) red[wave * 32 + r] = mx;
    asm volatile("s_waitcnt lgkmcnt(0)" ::: "memory"); __syncthreads();
#pragma unroll
    for (int w = 0; w < 8; ++w) mx = fmaxf(mx, red[w * 32 + r]);
    float sum = 0.f;
#pragma unroll
    for (int i = 0; i < 16; ++i) { const float p = __builtin_amdgcn_exp2f((s[i] - mx) * 1.44269504089f); s[i] = p; sum += p; }
    sum += __shfl_xor(sum, 32);
    if (h == 0) red[256 + wave * 32 + r] = sum;
    *(LAS bf16x8*)(pbuf + (wave * 2 + 0) * 1024 + lane * 16) = pack8(s, 0);
    *(LAS bf16x8*)(pbuf + (wave * 2 + 1) * 1024 + lane * 16) = pack8(s, 1);
    asm volatile("s_waitcnt lgkmcnt(0)" ::: "memory"); __syncthreads();
    float tot = 0.f;
#pragma unroll
    for (int w = 0; w < 8; ++w) tot += red[256 + w * 32 + r];
    const float inv = 1.f / tot;
    f32x16 o;
#pragma unroll
    for (int i = 0; i < 16; ++i) o[i] = 0.f;
#pragma unroll
    for (int c = 0; c < 16; ++c) { const bf16x8 pf = *(const LAS bf16x8*)(pbuf + c * 1024 + lane * 16); o = MFMA32(vf[c], pf, o); }
    if (r < 16) { GAS char* op = (GAS char*)Ob + (unsigned)r * 2048u + 8u * h + 64u * wave;
#pragma unroll
        for (int g = 0; g < 4; ++g) { v2u w2; w2.x = pk2(o[4 * g] * inv, o[4 * g + 1] * inv); w2.y = pk2(o[4 * g + 2] * inv, o[4 * g + 3] * inv); *(GAS v2u*)(op + 16 * g) = w2; } }
    asm volatile("s_waitcnt lgkmcnt(0)" ::: "memory"); __syncthreads();
}

template <int NT, int KCH>
__device__ __forceinline__ void micro_gemm(LAS unsigned char* lds, const bf16* A, int lda, const bf16* Bt, int ldb, const int (&cb)[NT], int wave, int lane_, int tid_, float (&val)[NT][2]) {
    int lane = lane_, tid = tid_; asm volatile("" : "+v"(lane), "+v"(tid));
    constexpr int KB = (KCH > 8 && NT == 1) ? 16 : 8;
    const int r = lane & 31, h = lane >> 5;
    const GAS char* ap = (const GAS char*)A; const GAS char* bp = (const GAS char*)Bt;
    const unsigned ao = ((unsigned)r * lda + wave * (KCH * 16) + 8 * h) * 2u, bo = ((unsigned)r * ldb + wave * (KCH * 16) + 8 * h) * 2u;
    f32x16 acc[NT];
#pragma unroll
    for (int nt = 0; nt < NT; ++nt)
#pragma unroll
        for (int i = 0; i < 16; ++i) acc[nt][i] = 0.f;
#pragma unroll 1
    for (int kc = 0; kc < KCH; kc += KB) {
        bf16x8 af[KB], bfr[NT][KB];
#pragma unroll
        for (int i = 0; i < KB; ++i) af[i] = *(const GAS bf16x8*)(ap + ao + (kc + i) * 32);
#pragma unroll
        for (int nt = 0; nt < NT; ++nt)
#pragma unroll
            for (int i = 0; i < KB; ++i) bfr[nt][i] = *(const GAS bf16x8*)(bp + (size_t)cb[nt] * ldb * 2 + bo + (kc + i) * 32);
#pragma unroll
        for (int nt = 0; nt < NT; ++nt)
#pragma unroll
            for (int i = 0; i < KB; ++i) acc[nt] = MFMA32(af[i], bfr[nt][i], acc[nt]);
    }
    LAS float* part = (LAS float*)lds;
#pragma unroll
    for (int nt = 0; nt < NT; ++nt)
#pragma unroll
        for (int i = 0; i < 16; ++i) part[(wave * NT + nt) * 1024 + ((i & 3) + 8 * (i >> 2) + 4 * h) * 32 + r] = acc[nt][i];
    __syncthreads();
#pragma unroll
    for (int nt = 0; nt < NT; ++nt) { float s0 = 0.f, s1 = 0.f;
#pragma unroll
        for (int w = 0; w < 8; ++w) { const f32x2 p = *(const LAS f32x2*)(part + (w * NT + nt) * 1024 + 2 * tid); s0 += p.x; s1 += p.y; }
        val[nt][0] = s0; val[nt][1] = s1; }
}
__device__ __forceinline__ void micro_gemm_lds(LAS unsigned char* lds, const bf16* A, int lda, const bf16* Bt, int ldb, int cb0, int wave, int lane_, int tid_, float (&val)[1][2]) {
    int lane = lane_, tid = tid_; asm volatile("" : "+v"(lane), "+v"(tid));
    const int r = lane & 31, h = lane >> 5;
    LAS unsigned char* reg = lds + wave * 16384;
    __syncthreads();
    { const unsigned rq = (unsigned)lane >> 4, pc = (unsigned)lane & 15u;
      const GAS char* ap = (const GAS char*)A + wave * 256; const GAS char* bp = (const GAS char*)(Bt + (size_t)cb0 * ldb) + wave * 256;
#pragma unroll
      for (int n = 0; n < 8; ++n) { const unsigned row = 4u * n + rq, lc = pc ^ (row & 15u);
          __builtin_amdgcn_global_load_lds((const GAS unsigned*)(ap + row * (unsigned)(lda * 2) + lc * 16u), (LAS unsigned*)(reg + n * 1024), 16, 0, 0); }
#pragma unroll
      for (int n = 0; n < 8; ++n) { const unsigned row = 4u * n + rq, lc = pc ^ (row & 15u);
          __builtin_amdgcn_global_load_lds((const GAS unsigned*)(bp + row * (unsigned)(ldb * 2) + lc * 16u), (LAS unsigned*)(reg + 8192 + n * 1024), 16, 0, 0); } }
    f32x16 acc;
#pragma unroll
    for (int i = 0; i < 16; ++i) acc[i] = 0.f;
    const LAS unsigned char* fa = reg + r * 256; const unsigned x = (unsigned)(r & 15);
    asm volatile("s_waitcnt vmcnt(0)" ::: "memory");
    bf16x8 af[8], bfr[8];
#pragma unroll
    for (int i = 0; i < 8; ++i) { const unsigned pcx = ((unsigned)(2 * i + h) ^ x) * 16u; af[i] = *(const LAS bf16x8*)(fa + pcx); bfr[i] = *(const LAS bf16x8*)(fa + 8192 + pcx); }
#pragma unroll
    for (int i = 0; i < 8; ++i) acc = MFMA32(af[i], bfr[i], acc);
    asm volatile("s_waitcnt lgkmcnt(0)" ::: "memory");
    LAS float* part = (LAS float*)reg;
#pragma unroll
    for (int i = 0; i < 16; ++i) part[((i & 3) + 8 * (i >> 2) + 4 * h) * 32 + r] = acc[i];
    __syncthreads();
    float s0 = 0.f, s1 = 0.f;
#pragma unroll
    for (int w = 0; w < 8; ++w) { const f32x2 p = *(const LAS f32x2*)((const LAS float*)(lds + w * 16384) + 2 * tid); s0 += p.x; s1 += p.y; }
    val[0][0] = s0; val[0][1] = s1;
}
__device__ __forceinline__ void sample_gemm1_piece(const Args& a, LAS unsigned char* lds, int p, int wave, int lane, int tid_) {
    int tid = tid_; asm volatile("" : "+v"(tid));
    const int rg = p & 7, cp = p >> 3; int cb[2];
    if (cp < 16) { cb[0] = 64 * cp; cb[1] = 64 * cp + 32; } else { const int q = cp - 16; cb[0] = 1024 + 256 * (q >> 2) + 32 * (q & 3); cb[1] = cb[0] + 128; }
    float val[2][2];
    micro_gemm<2, 8>(lds, (const bf16*)(a.ws + WS_XN) + (size_t)(MP + 32 * rg) * D, D, (const bf16*)(a.ws + WS_WIN), D, cb, wave, lane, tid, val);
    const int rs_ = 32 * rg + (tid >> 4), row = MP + rs_, t = rs_ & 15, sb = rs_ >> 4, c2 = 2 * (tid & 15);
    bf16* P1 = (bf16*)(a.ws + WS_P1) + (size_t)row * 1536;
    if (cp < 16) {
#pragma unroll
        for (int nt = 0; nt < 2; ++nt) { const int col = cb[nt] + c2; *(GAS unsigned*)(P1 + col) = pk2(val[nt][0], val[nt][1]);
            if (cp < 8 && t >= 1) *(GAS f32x2*)(a.out + OUT_POOL_S + (size_t)(sb * 15 + t - 1) * 512 + col) = (f32x2){val[nt][0], val[nt][1]}; }
    } else {
        const int ch = 32 * (cp - 16) + c2; const float v0 = val[0][0] * val[1][0], v1 = val[0][1] * val[1][1];
        *(GAS unsigned*)(P1 + 1024 + ch) = pk2(v0, v1);
        if (t >= 14) *(GAS f32x2*)(a.out + OUT_CONV_S + (size_t)(sb * 2 + t - 14) * 512 + ch) = (f32x2){v0, v1};
    }
    __syncthreads();
}
struct SampleX { unsigned* xbuf; unsigned* cnt; float* rsp; unsigned* tmo; };
template <int NT, int KCH, int MODE>
__device__ __forceinline__ void sample_gemm_piece(LAS unsigned char* lds, const bf16* A, int K, const bf16* Bt, bf16* C, int ldc, const float* rsp, int p, int wave, int lane, int tid_) {
    int tid = tid_; asm volatile("" : "+v"(tid));
    const int rg = p & 7, cp = p >> 3; int cb[NT];
#pragma unroll
    for (int nt = 0; nt < NT; ++nt) cb[nt] = 32 * NT * cp + 32 * nt;
    const int rl = 32 * rg + (tid >> 4); const size_t row = MP + rl; const int c2 = 2 * (tid & 15);
    f32x4 pr[8];
    if (rsp) { const GAS f32x4* pp = (const GAS f32x4*)(rsp + (size_t)rl * 32);
#pragma unroll
        for (int k = 0; k < 8; ++k) pr[k] = pp[k]; }
    float val[NT][2];
    if constexpr (NT == 1 && KCH == 8) micro_gemm_lds(lds, A + (size_t)(MP + 32 * rg) * K, K, Bt, K, cb[0], wave, lane, tid, val);
    else micro_gemm<NT, KCH>(lds, A + (size_t)(MP + 32 * rg) * K, K, Bt, K, cb, wave, lane, tid, val);
    float rs = 1.f;
    if (rsp) { f32x4 t = pr[0];
#pragma unroll
        for (int k = 1; k < 8; ++k) t = t + pr[k];
        rs = 1.f / sqrtf(((t[0] + t[1]) + (t[2] + t[3])) * (1.f / D) + EPS); }
#pragma unroll
    for (int nt = 0; nt < NT; ++nt) {
        float v0 = val[nt][0] * rs, v1 = val[nt][1] * rs;
        if (MODE == 2) { v0 = fmaxf(v0, 0.f); v0 *= v0; v1 = fmaxf(v1, 0.f); v1 *= v1; }
        *(GAS unsigned*)(C + row * ldc + cb[nt] + c2) = pk2(v0, v1);
    }
    __syncthreads();
}
template <int KCH>
__device__ __forceinline__ void sample_fused_A(LAS unsigned char* lds, const bf16* A, int K, const bf16* Bt, const SampleX& sx, int p, int wave, int lane, int tid_) {
    int tid = tid_; asm volatile("" : "+v"(tid));
    const int rg = p & 7, cp = p >> 3; int cb[1] = {32 * cp};
    float val[1][2];
    if constexpr (KCH == 8) micro_gemm_lds(lds, A + (size_t)(MP + 32 * rg) * K, K, Bt, K, cb[0], wave, lane, tid, val);
    else micro_gemm<1, KCH>(lds, A + (size_t)(MP + 32 * rg) * K, K, Bt, K, cb, wave, lane, tid, val);
    const int rl = 32 * rg + (tid >> 4);
    float s = val[0][0] * val[0][0] + val[0][1] * val[0][1];
    s += __shfl_xor(s, 1); s += __shfl_xor(s, 2); s += __shfl_xor(s, 4); s += __shfl_xor(s, 8);
    if ((tid & 15) == 0) __hip_atomic_store(sx.xbuf + (size_t)rl * 32 + cp, __float_as_uint(s), __ATOMIC_RELAXED, __HIP_MEMORY_SCOPE_AGENT);
    *(LAS f32x2*)(lds + STASH_OFF + tid * 8) = (f32x2){val[0][0], val[0][1]};
    asm volatile("s_waitcnt vmcnt(0) lgkmcnt(0)" ::: "memory"); __syncthreads();
    if (tid == 0) __hip_atomic_fetch_add(sx.cnt + 64 * rg, 1u, __ATOMIC_RELAXED, __HIP_MEMORY_SCOPE_AGENT);
}
template <bool FINAL>
__device__ __forceinline__ void sample_fused_B(LAS unsigned char* lds, const float* base, const float* g, float* Y, bf16* X, const SampleX& sx, int p, int wave, int lane, int tid_) {
    int tid = tid_; asm volatile("" : "+v"(tid));
    const int rg = p & 7, cp = p >> 3;
    const int rl = 32 * rg + (tid >> 4); const int col = 32 * cp + 2 * (tid & 15);
    const f32x2 bs = *(const GAS f32x2*)(base + (size_t)rl * D + col), gv = *(const GAS f32x2*)(g + col);
    if (wave == 0) { unsigned sp = 0;
        while ((unsigned)__builtin_amdgcn_readfirstlane(__hip_atomic_load(sx.cnt + 64 * rg, __ATOMIC_RELAXED, __HIP_MEMORY_SCOPE_AGENT)) < 32u) {
            __builtin_amdgcn_s_sleep(2);
            if ((++sp & 1023u) == 0u) { if (__hip_atomic_load(sx.tmo, __ATOMIC_RELAXED, __HIP_MEMORY_SCOPE_AGENT) != 0u) break; if (sp > (1u << 22)) { if (lane == 0) __hip_atomic_store(sx.tmo, 1u, __ATOMIC_RELAXED, __HIP_MEMORY_SCOPE_AGENT); break; } } }
        }
    __syncthreads();
    float tot = 0.f;
    { const unsigned* slot = sx.xbuf + (size_t)rl * 32;
#pragma unroll
      for (int k = 0; k < 32; ++k) tot += __uint_as_float(__hip_atomic_load(slot + k, __ATOMIC_RELAXED, __HIP_MEMORY_SCOPE_AGENT)); }
    const f32x2 val = *(const LAS f32x2*)(lds + STASH_OFF + tid * 8);
    const float rs = 1.f / sqrtf(tot * (1.f / D) + EPS);
    const float x0 = bs[0] + val[0] * rs * gv[0], x1 = bs[1] + val[1] * rs * gv[1];
    *(GAS f32x2*)(Y + (size_t)rl * D + col) = (f32x2){x0, x1};
    if (!FINAL) {
        *(GAS unsigned*)(X + (size_t)rl * D + col) = pk2(x0, x1);
        float q = x0 * x0 + x1 * x1;
        q += __shfl_xor(q, 1); q += __shfl_xor(q, 2); q += __shfl_xor(q, 4); q += __shfl_xor(q, 8);
        if ((tid & 15) == 0) sx.rsp[(size_t)rl * 32 + cp] = q;
    }
    __syncthreads();
}
template <int KCH, bool FINAL>
__device__ __forceinline__ void sample_fused_piece(LAS unsigned char* lds, const bf16* A, int K, const bf16* Bt, const float* base, const float* g, float* Y, bf16* X, const SampleX& sx, int p, int wave, int lane, int tid) {
    sample_fused_A<KCH>(lds, A, K, Bt, sx, p, wave, lane, tid);
    sample_fused_B<FINAL>(lds, base, g, Y, X, sx, p, wave, lane, tid);
}

__global__ void __launch_bounds__(NWAVES * 64, 2) enc_fwd(Args args) {
    extern __shared__ __attribute__((aligned(16))) unsigned char lds_raw[];
    LAS unsigned char* lds = (LAS unsigned char*)lds_raw;
    volatile LAS unsigned* MISC = (volatile LAS unsigned*)(lds + MISC_OFF);
    const int tid = threadIdx.x, lane = tid & 63, wave = __builtin_amdgcn_readfirstlane(tid >> 6);
    const int G = gridDim.x; const int bx = blockIdx.x; const int vcu = (G % 8 == 0) ? (bx % 8) * (G / 8) + bx / 8 : bx;
    const int gw = vcu * NWAVES + wave, NGW = G * NWAVES;
    unsigned char* ws = args.ws;
    unsigned* ctl = (unsigned*)(ws + WS_CTL);
    for (int u = tid; u < (LDS_BYTES - LDSCTL_OFF) / 4; u += NWAVES * 64) ((LAS unsigned*)(lds + LDSCTL_OFF))[u] = 0u;
    __syncthreads();
    XcdBarrier bar = xcd_barrier_post(ctl + CW_BAR, MISC + 8);
#define GRID_BAR() do { xcd_arrive(bar); xcd_wait(bar); } while (0)
    if (tid == 0) { unsigned* gp = ctl + CW_BAR + XB_GRP(bx & 7); const unsigned me = bar.x + 1u;
        const unsigned prev = atomicCAS(gp, 0u, me);
        if (prev != 0u && prev != me) __hip_atomic_store(ctl + CW_BAR + XB_MIS, 1u, __ATOMIC_RELAXED, __HIP_MEMORY_SCOPE_AGENT); }
    bf16* XN = (bf16*)(ws + WS_XN);
    float* Y = args.out + OUT_Y;

    p0_prologue(args, lds, gw, NGW, wave, lane);
    GRID_BAR();

    const bool localok = G == 256 && __hip_atomic_load(ctl + CW_BAR + XB_MIS, __ATOMIC_RELAXED, __HIP_MEMORY_SCOPE_AGENT) == 0u;
#define LOCAL_BAR() do { if (localok) xcd_local_barrier(bar); else GRID_BAR(); } while (0)
    if (bx & 1) for (int p = bx; p < 256; p += G) sample_gemm1_piece(args, lds, p, wave, lane, tid);
    { pg8::Gemm g{XN, (const bf16*)(ws + WS_WIN), MP, NIN, D}; pg8::StaticOrder S; S.init(MP, NIN, G, bx);
      pg8::Epi1 E{(bf16*)(ws + WS_P1), args.out + OUT_POOL_P, args.out + OUT_CONV_P, args.out + OUT_POOL_S, args.out + OUT_CONV_S};
      pg8::gemm_phase<pg8::Epi1, pg8::StaticOrder, true, true>(lds, g, S, E); }
    if (!(bx & 1)) for (int p = bx; p < 256; p += G) sample_gemm1_piece(args, lds, p, wave, lane, tid);
    GRID_BAR();

    if (bx < 32 && G > 32) {
      pg8::Gemm g{(const bf16*)(ws + WS_MN), (const bf16*)(ws + WS_WKV), 1024, 2048, D}; pg8::StaticOrder S; S.init(1024, 2048, 32, bx);
      pg8::EpiKV E{args.out + OUT_MK, args.out + OUT_MV, (bf16*)(ws + WS_KB), (bf16*)(ws + WS_VT)};
      pg8::gemm_phase<pg8::EpiKV, pg8::StaticOrder, true, true>(lds, g, S, E);
    } else {
      const int gw2 = (bx - 32) * NWAVES + wave, NGW2 = (G - 32) * NWAVES;
      if (G == 256) mixer_all(args, lds, bx & 7, (bx - 32) >> 3, 28, wave, lane);
      else mixer_all(args, lds, -1, bx - 32, G - 32, wave, lane);
      if (G == 256) { const int lw = ((bx - 32) >> 3) * NWAVES + wave, xg = bx & 7, NV = (180 + 2 * 44) * 8;
          if (lw < 180) p2_late(args, lds, lw * 8 + xg, NV, wave, lane);
          else { p2_late(args, lds, (180 + 2 * (lw - 180)) * 8 + xg, NV, wave, lane); p2_late(args, lds, (181 + 2 * (lw - 180)) * 8 + xg, NV, wave, lane); } }
      else { __syncthreads(); p2_late(args, lds, gw2, NGW2, wave, lane); }
    }
    GRID_BAR();

    bf16* SQO = (bf16*)(ws + WS_SQO) - (size_t)MP * D; bf16* SAO = (bf16*)(ws + WS_SAO) - (size_t)MP * D; bf16* SHID = (bf16*)(ws + WS_SHID) - (size_t)MP * FF;
    unsigned* tmo = ctl + CW_TMO;
    float* Ys = Y + (size_t)MP * D; bf16* XNs = XN + (size_t)MP * D;
    const SampleX sx0{(unsigned*)(ws + WS_SXB), ctl + CW_SSEAM, (float*)(ws + WS_SRSP), tmo};
    const SampleX sx1{(unsigned*)(ws + WS_SXB + 32768), ctl + CW_SSEAM + 512, (float*)(ws + WS_SRSP + 32768), tmo};
    const SampleX sx2{(unsigned*)(ws + WS_SXB + 65536), ctl + CW_SSEAM + 1024, nullptr, tmo};

    { pg8::Gemm g{(const bf16*)(ws + WS_MRG), (const bf16*)(ws + WS_WOUT), MP, D, D}; pg8::StaticOrder S; S.init(MP, D, G, bx);
      pg8::EpiRes<1> E{(const float*)(ws + WS_RNORM), XN, nullptr, args.in[15], (unsigned*)(ws + WS_XB1), ctl + CW_SEAM, (float*)(ws + WS_RSP1), tmo};
      if (G == 256) sample_fused_A<8>(lds, (const bf16*)(ws + WS_MRG), D, (const bf16*)(ws + WS_WOUT), sx0, bx, wave, lane, tid);
      pg8::gemm_phase<pg8::EpiRes<1>, pg8::StaticOrder, false, true>(lds, g, S, E); }
    if (G == 256) sample_fused_B<false>(lds, args.in[1], args.in[15], Ys, XNs, sx0, bx, wave, lane, tid);
    else for (int p = bx; p < 256; p += G) sample_fused_piece<8, false>(lds, (const bf16*)(ws + WS_MRG), D, (const bf16*)(ws + WS_WOUT), args.in[1], args.in[15], Ys, XNs, sx0, p, wave, lane, tid);
    LOCAL_BAR();
    if (bx & 1) for (int p = bx; p < 256; p += G) sample_gemm_piece<1, 8, 1>(lds, XN, D, (const bf16*)(ws + WS_WQ), SQO, D, sx0.rsp, p, wave, lane, tid);
    { pg8::Gemm g{XN, (const bf16*)(ws + WS_WQ), MP, D, D}; pg8::StaticOrder S; S.init(MP, D, G, bx);
      pg8::EpiBf16S<0, false> E{(bf16*)(ws + WS_QO), D, (const float*)(ws + WS_RSP1), nullptr};
      pg8::gemm_phase<pg8::EpiBf16S<0, false>, pg8::StaticOrder, true, true>(lds, g, S, E); }
    if (!(bx & 1)) for (int p = bx; p < 256; p += G) sample_gemm_piece<1, 8, 1>(lds, XN, D, (const bf16*)(ws + WS_WQ), SQO, D, sx0.rsp, p, wave, lane, tid);
    LOCAL_BAR();
    { const bf16* QO = (const bf16*)(ws + WS_QO); bf16* AO = (bf16*)(ws + WS_AO);
      pg8::StaticOrder SA; SA.init(MP, D, G, bx); pg8::Unit au;
      for (int i = 0; SA.next(i, au); ++i) {
          const int hd = au.pn, b = au.pm >> 4; const size_t qb = (size_t)(au.pm * 256 + wave * 32) * D + hd * 256;
          int ln = lane; asm volatile("" : "+v"(ln));
          attn_unit(lds, QO + qb, AO + qb, (unsigned)(ln & 31) * 2048u, (const bf16*)(ws + WS_KB) + (size_t)b * 256 * 1024 + hd * 256, (const bf16*)(ws + WS_VT) + (size_t)(b * 4 + hd) * 65536, true, wave, ln);
      } }
    if (G == 256 && bx >= 64) { int ln = lane; asm volatile("" : "+v"(ln));
        p0_items(args, (LAS float*)(lds + wave * 16384), DN_LO, DN_HI, (bx - 64) * NWAVES + wave, 192 * NWAVES, ln); }
    else if (G != 256) { int ln = lane; asm volatile("" : "+v"(ln)); p0_items(args, (LAS float*)(lds + wave * 16384), DN_LO, DN_HI, gw, NGW, ln); }
    for (int u = bx; u < 64; u += G) {
        const int sb = 2 * (u & 7) + (u >> 5), hd = (u >> 3) & 3; const size_t qb = (size_t)(MP + sb * 16) * D + hd * 256;
        attn_unit_small(lds, SQO + qb, SAO + qb, (const bf16*)(ws + WS_KBS) + (size_t)sb * 256 * 1024 + hd * 256, (const bf16*)(ws + WS_VTS) + (size_t)(sb * 4 + hd) * 65536, wave, lane);
    }
    GRID_BAR();
    { pg8::Gemm g{(const bf16*)(ws + WS_AO), (const bf16*)(ws + WS_WCO), MP, D, D}; pg8::StaticOrder S; S.init(MP, D, G, bx);
      pg8::EpiRes<2> E{nullptr, XN, nullptr, args.in[22], (unsigned*)(ws + WS_XB2), ctl + CW_SEAM + 4096, (float*)(ws + WS_RSP2), tmo};
      if (G == 256) sample_fused_A<8>(lds, SAO, D, (const bf16*)(ws + WS_WCO), sx1, bx, wave, lane, tid);
      pg8::gemm_phase<pg8::EpiRes<2>, pg8::StaticOrder, false, true>(lds, g, S, E); }
    if (G == 256) sample_fused_B<false>(lds, Ys, args.in[22], Ys, XNs, sx1, bx, wave, lane, tid);
    else for (int p = bx; p < 256; p += G) sample_fused_piece<8, false>(lds, SAO, D, (const bf16*)(ws + WS_WCO), Ys, args.in[22], Ys, XNs, sx1, p, wave, lane, tid);
    LOCAL_BAR();
    if (bx & 1) for (int p = bx; p < 256; p += G) sample_gemm_piece<4, 8, 2>(lds, XN, D, (const bf16*)(ws + WS_WUP), SHID, FF, sx1.rsp, p, wave, lane, tid);
    { pg8::Gemm g{XN, (const bf16*)(ws + WS_WUP), MP, FF, D}; pg8::StaticOrder S; S.init(MP, FF, G, bx);
      LAS float* rstab = (LAS float*)(lds + RSTAB_OFF);
      { pg8::Unit u0; if (S.next(0, u0) && tid < 256) { const f32x4 p = *(const GAS f32x4*)((const float*)(ws + WS_RSP2) + (size_t)(u0.pm * 256 + tid) * 4);
            rstab[tid] = 1.0f / sqrtf(((p[0] + p[1]) + (p[2] + p[3])) * (1.0f / 1024.0f) + EPS); } }
      __syncthreads();
      pg8::EpiBf16S<1, true> E{(bf16*)(ws + WS_HID), FF, (const float*)(ws + WS_RSP2), rstab};
      pg8::gemm_phase<pg8::EpiBf16S<1, true>, pg8::StaticOrder, true, true>(lds, g, S, E); }
    if (!(bx & 1)) for (int p = bx; p < 256; p += G) sample_gemm_piece<4, 8, 2>(lds, XN, D, (const bf16*)(ws + WS_WUP), SHID, FF, sx1.rsp, p, wave, lane, tid);
    LOCAL_BAR();
    { pg8::Gemm g{(const bf16*)(ws + WS_HID), (const bf16*)(ws + WS_WDOWN), MP, D, FF}; pg8::StaticOrder S; S.init(MP, D, G, bx);
      pg8::EpiRes<3> E{nullptr, XN, Y, args.in[26], (unsigned*)(ws + WS_XB3), ctl + CW_SEAM + 8192, nullptr, tmo};
      if (G == 256 && (bx & 1)) sample_fused_A<32>(lds, SHID, FF, (const bf16*)(ws + WS_WDOWN), sx2, bx, wave, lane, tid);
      pg8::gemm_phase<pg8::EpiRes<3>, pg8::StaticOrder, false, true>(lds, g, S, E); }
    if (G == 256 && !(bx & 1)) { __syncthreads(); sample_fused_A<32>(lds, SHID, FF, (const bf16*)(ws + WS_WDOWN), sx2, bx, wave, lane, tid); }
    if (G == 256) sample_fused_B<true>(lds, Ys, args.in[26], Ys, nullptr, sx2, bx, wave, lane, tid);
    else for (int p = bx; p < 256; p += G) sample_fused_piece<32, true>(lds, SHID, FF, (const bf16*)(ws + WS_WDOWN), Ys, args.in[26], Ys, nullptr, sx2, p, wave, lane, tid);
}

extern "C" void kernel_launch(void* const* d_in, const int* in_sizes, int n_in, void* d_out, int out_size, void* d_ws, size_t ws_size, hipStream_t stream) {
    static int grid = 0;
    if (grid == 0) {
        if (n_in != 27 || (size_t)out_size != OUT_TOTAL || ws_size < WS_END) { fprintf(stderr, "kernel_launch: unexpected sizes n_in %d out %d ws %zu\n", n_in, out_size, ws_size); grid = -1; return; }
        int dev = 0, cus = 0, per_cu = 0;
        if (hipGetDevice(&dev) != hipSuccess || hipDeviceGetAttribute(&cus, hipDeviceAttributeMultiprocessorCount, dev) != hipSuccess) { grid = -1; return; }
        if (hipFuncSetAttribute((const void*)enc_fwd, hipFuncAttributeMaxDynamicSharedMemorySize, LDS_BYTES) != hipSuccess) { fprintf(stderr, "kernel_launch: hipFuncSetAttribute failed\n"); grid = -1; return; }
        if (hipOccupancyMaxActiveBlocksPerMultiprocessor(&per_cu, (const void*)enc_fwd, NWAVES * 64, LDS_BYTES) != hipSuccess || per_cu < 1) { fprintf(stderr, "kernel_launch: occupancy query says %d blocks/CU\n", per_cu); per_cu = 1; }
        (void)hipGetLastError();
        grid = cus;
    }
    if (grid < 0) return;
    (void)hipMemsetAsync((char*)d_ws + WS_CTL, 0, CTL_ZERO_BYTES, stream);
    Args a{};
    for (int i = 0; i < 27; ++i) a.in[i] = (const float*)d_in[i];
    a.out = (float*)d_out; a.ws = (unsigned char*)d_ws;
    hipLaunchKernelGGL(enc_fwd, dim3(grid), dim3(NWAVES * 64), LDS_BYTES, stream, a);
}
```

```cpp
#include <hip/hip_runtime.h>
#include <cstdio>
#include <cstdint>

namespace pg8 {
#define PG8_LAS __attribute__((address_space(3)))
typedef unsigned short bf16_t;
typedef short bf16x8 __attribute__((ext_vector_type(8)));
typedef float f32x4 __attribute__((ext_vector_type(4)));
typedef unsigned u32x4 __attribute__((ext_vector_type(4)));
typedef unsigned u32x2 __attribute__((ext_vector_type(2)));
constexpr int BM = 256, BK = 64, HALF = 128, HTB = HALF * BK * 2  , STAGE_BYTES = 8 * HTB, NXCD = 8, WGM = 8;

__host__ __device__ __forceinline__ int lds_byte(int r, int c) { const int st = (r >> 4) * 2 + (c >> 5), rr = r & 15, cc = c & 31, ob = rr * 64 + cc * 2; return st * 1024 + (ob ^ (((ob >> 9) & 1) << 5)); }
__host__ __device__ __forceinline__ void stage_rc(int b, int& R, int& C) { const int st = b / 1024, sb = b % 1024, swz = sb ^ (((sb >> 9) & 1) << 5); R = (st >> 1) * 16 + swz / 64; C = (st & 1) * 32 + (swz % 64) / 2; }
__host__ __device__ __forceinline__ int perm32(int rho) { const int n = rho >> 4, i = rho & 15; return 8 * (i >> 2) + 4 * n + (i & 3); }

struct Unit { int pm, pn; };
struct Gemm { const bf16_t* A; const bf16_t* Bt; int M, N, K; };

struct StaticOrder {
    int nM, nN, nwg, G, c;
    __host__ __device__ void init(int M, int N, int G_, int c_) { nM = M / BM; nN = N / BM; nwg = nM * nN; G = G_; c = c_; }
    __host__ __device__ __forceinline__ bool next(int i, Unit& u) const {
        const long L = (long)i * G + c; if (L >= nwg) return false;
        int wgid = (int)L; { const int q = nwg / NXCD, r = nwg % NXCD, xcd = wgid % NXCD, off = wgid / NXCD; wgid = (xcd < r ? xcd * (q + 1) : r * (q + 1) + (xcd - r) * q) + off; }
        const int nig = WGM * nN, gid = wgid / nig, fm = gid * WGM, gsz = (nM - fm) < WGM ? (nM - fm) : WGM;
        u.pm = fm + ((wgid % nig) % gsz); u.pn = (wgid % nig) / gsz; return true;
    }
    __device__ __forceinline__ void a_ready(const Unit&) const {}
    __device__ __forceinline__ void done(const Unit&) const {}
};

__device__ __forceinline__ unsigned cvt_pk_bf16(float lo, float hi) { unsigned r; asm volatile("v_cvt_pk_bf16_f32 %0, %1, %2" : "=v"(r) : "v"(lo), "v"(hi)); return r; }

struct EpiF32 {
    static constexpr bool PERM = false, AFTER_DRAIN = false;
    float* C; int ldc;
    __device__ __forceinline__ void operator()(const f32x4 (&acc)[2][2][4][2], const Unit& u, int wr, int wc, int fr, int fq) const {
        const int row0 = u.pm * BM + wr * 64 + fr, col0 = u.pn * BM + wc * 32 + 4 * fq;
#pragma unroll
        for (int ai = 0; ai < 2; ++ai)
#pragma unroll
            for (int m = 0; m < 4; ++m) { float* rowp = C + (size_t)(row0 + ai * HALF + m * 16) * ldc + col0;
#pragma unroll
                for (int bj = 0; bj < 2; ++bj)
#pragma unroll
                    for (int n = 0; n < 2; ++n) *(f32x4*)(rowp + bj * HALF + n * 16) = acc[ai][bj][m][n]; }
    }
};
template <int ACT> struct EpiBf16 {
    static constexpr bool PERM = true, AFTER_DRAIN = false;
    bf16_t* O; int ldc;
    __device__ __forceinline__ void operator()(const f32x4 (&acc)[2][2][4][2], const Unit& u, int wr, int wc, int fr, int fq) const {
        const int row0 = u.pm * BM + wr * 64 + fr, col0 = u.pn * BM + wc * 32 + 8 * fq;
#pragma unroll
        for (int ai = 0; ai < 2; ++ai)
#pragma unroll
            for (int m = 0; m < 4; ++m) { bf16_t* rowp = O + (size_t)(row0 + ai * HALF + m * 16) * ldc + col0;
#pragma unroll
                for (int bj = 0; bj < 2; ++bj) { f32x4 v0 = acc[ai][bj][m][0], v1 = acc[ai][bj][m][1];
                    if (ACT == 1) {
#pragma unroll
                        for (int j = 0; j < 4; ++j) { const float a = fmaxf(v0[j], 0.f), b = fmaxf(v1[j], 0.f); v0[j] = a * a; v1[j] = b * b; } }
                    u32x4 w; w.x = cvt_pk_bf16(v0[0], v0[1]); w.y = cvt_pk_bf16(v0[2], v0[3]); w.z = cvt_pk_bf16(v1[0], v1[1]); w.w = cvt_pk_bf16(v1[2], v1[3]);
                    *(u32x4*)(rowp + bj * HALF) = w; } }
    }
};
struct Epi1 {
    static constexpr bool PERM = true, AFTER_DRAIN = false;
    bf16_t* P1; float* pool_p; float* conv_p; float* pool_s; float* conv_s;
    __device__ __forceinline__ void operator()(const f32x4 (&acc)[2][2][4][2], const Unit& u, int wr, int wc, int fr, int fq) const {
        const int row0 = u.pm * BM + wr * 64 + fr;
        const bool sample = (u.pm == 64), tailp = ((u.pm & 15) == 15) && !sample;
        if (u.pn < 4) {
            const int col0 = u.pn * BM + wc * 32 + 8 * fq;
#pragma unroll
            for (int ai = 0; ai < 2; ++ai)
#pragma unroll
                for (int m = 0; m < 4; ++m) { const int row = row0 + ai * HALF + m * 16; bf16_t* rowp = P1 + (size_t)row * 1536 + col0;
#pragma unroll
                    for (int bj = 0; bj < 2; ++bj) { const f32x4 v0 = acc[ai][bj][m][0], v1 = acc[ai][bj][m][1];
                        u32x4 w; w.x = cvt_pk_bf16(v0[0], v0[1]); w.y = cvt_pk_bf16(v0[2], v0[3]); w.z = cvt_pk_bf16(v1[0], v1[1]); w.w = cvt_pk_bf16(v1[2], v1[3]);
                        *(u32x4*)(rowp + bj * HALF) = w;
                        if (u.pn < 2) {
                            float* dst = nullptr;
                            if (sample) { const int t = row & 15, sb = (row >> 4) & 15; if (t >= 1) dst = pool_s + ((size_t)(sb * 15 + t - 1) * 512 + col0 + bj * HALF); }
                            else if (tailp) { const int t = row & 4095, b = row >> 12; if (t >= 4081) dst = pool_p + ((size_t)(b * 15 + t - 4081) * 512 + col0 + bj * HALF); }
                            if (dst) { *(f32x4*)dst = v0; *(f32x4*)(dst + 4) = v1; }
                        } } }
        } else {
            const int ch0 = (u.pn - 4) * 128 + wc * 32 + 8 * fq;
#pragma unroll
            for (int ai = 0; ai < 2; ++ai)
#pragma unroll
                for (int m = 0; m < 4; ++m) { const int row = row0 + ai * HALF + m * 16;
                    const f32x4 v0 = acc[ai][0][m][0] * acc[ai][1][m][0], v1 = acc[ai][0][m][1] * acc[ai][1][m][1];
                    u32x4 w; w.x = cvt_pk_bf16(v0[0], v0[1]); w.y = cvt_pk_bf16(v0[2], v0[3]); w.z = cvt_pk_bf16(v1[0], v1[1]); w.w = cvt_pk_bf16(v1[2], v1[3]);
                    *(u32x4*)(P1 + (size_t)row * 1536 + 1024 + ch0) = w;
                    float* dst = nullptr;
                    if (sample) { const int t = row & 15, sb = (row >> 4) & 15; if (t >= 14) dst = conv_s + ((size_t)(sb * 2 + t - 14) * 512 + ch0); }
                    else if (tailp) { const int t = row & 4095, b = row >> 12; if (t >= 4094) dst = conv_p + ((size_t)(b * 2 + t - 4094) * 512 + ch0); }
                    if (dst) { *(f32x4*)dst = v0; *(f32x4*)(dst + 4) = v1; } }
        }
    }
};
struct EpiKV {
    static constexpr bool PERM = false, AFTER_DRAIN = false;
    float* outK; float* outV; bf16_t* KB; bf16_t* VT;
    __device__ __forceinline__ void operator()(const f32x4 (&acc)[2][2][4][2], const Unit& u, int wr, int wc, int fr, int fq) const {
        const int row0 = u.pm * BM + wr * 64 + fr;
        if (u.pn < 4) {
            const int col0 = u.pn * BM + wc * 32 + 4 * fq;
#pragma unroll
            for (int ai = 0; ai < 2; ++ai)
#pragma unroll
                for (int m = 0; m < 4; ++m) { const size_t off = (size_t)(row0 + ai * HALF + m * 16) * 1024 + col0;
#pragma unroll
                    for (int bj = 0; bj < 2; ++bj)
#pragma unroll
                        for (int n = 0; n < 2; ++n) { const f32x4 v = acc[ai][bj][m][n]; __builtin_nontemporal_store(v, (f32x4*)(outK + off + bj * HALF + n * 16));
                            u32x2 w; w.x = cvt_pk_bf16(v[0], v[1]); w.y = cvt_pk_bf16(v[2], v[3]); *(u32x2*)(KB + off + bj * HALF + n * 16) = w; } }
        } else {
            const int h = u.pn - 4, e0 = wc * 32 + 4 * fq;
            bf16_t* vt = VT + (size_t)(u.pm * 4 + h) * 65536;
#pragma unroll
            for (int ai = 0; ai < 2; ++ai)
#pragma unroll
                for (int m = 0; m < 4; ++m) { const int mrow = wr * 64 + fr + ai * HALF + m * 16;
                    const int pos = (mrow & ~12) | ((mrow & 4) << 1) | ((mrow & 8) >> 1);
                    const size_t off = (size_t)(u.pm * BM + mrow) * 1024 + h * 256 + e0;
#pragma unroll
                    for (int bj = 0; bj < 2; ++bj)
#pragma unroll
                        for (int n = 0; n < 2; ++n) { const f32x4 v = acc[ai][bj][m][n]; __builtin_nontemporal_store(v, (f32x4*)(outV + off + bj * HALF + n * 16));
                            const unsigned w0 = cvt_pk_bf16(v[0], v[1]), w1 = cvt_pk_bf16(v[2], v[3]); const int e = e0 + bj * HALF + n * 16;
                            vt[(size_t)(e + 0) * 256 + pos] = (bf16_t)(w0 & 0xffffu); vt[(size_t)(e + 1) * 256 + pos] = (bf16_t)(w0 >> 16);
                            vt[(size_t)(e + 2) * 256 + pos] = (bf16_t)(w1 & 0xffffu); vt[(size_t)(e + 3) * 256 + pos] = (bf16_t)(w1 >> 16); } }
        }
    }
};


template <int ACT, bool TAB> struct EpiBf16S {
    static constexpr bool PERM = true, AFTER_DRAIN = false;
    bf16_t* O; int ldc; const float* rsp; const PG8_LAS float* rstab;
    __device__ __forceinline__ void operator()(const f32x4 (&acc)[2][2][4][2], const Unit& u, int wr, int wc, int fr, int fq) const {
        const int row0 = u.pm * BM + wr * 64 + fr, col0 = u.pn * BM + wc * 32 + 8 * fq;
#pragma unroll
        for (int ai = 0; ai < 2; ++ai)
#pragma unroll
            for (int m = 0; m < 4; ++m) { const int row = row0 + ai * HALF + m * 16; bf16_t* rowp = O + (size_t)row * ldc + col0;
                float rs;
                if (TAB) rs = rstab[wr * 64 + fr + ai * HALF + m * 16];
                else { const f32x4 p = *(const f32x4*)(rsp + (size_t)row * 4); rs = 1.0f / sqrtf(((p[0] + p[1]) + (p[2] + p[3])) * (1.0f / 1024.0f) + 1e-6f); }
#pragma unroll
                for (int bj = 0; bj < 2; ++bj) { f32x4 v0 = acc[ai][bj][m][0] * rs, v1 = acc[ai][bj][m][1] * rs;
                    if (ACT == 1) {
#pragma unroll
                        for (int j = 0; j < 4; ++j) { const float a = fmaxf(v0[j], 0.f), b = fmaxf(v1[j], 0.f); v0[j] = a * a; v1[j] = b * b; } }
                    u32x4 w; w.x = cvt_pk_bf16(v0[0], v0[1]); w.y = cvt_pk_bf16(v0[2], v0[3]); w.z = cvt_pk_bf16(v1[0], v1[1]); w.w = cvt_pk_bf16(v1[2], v1[3]);
                    *(u32x4*)(rowp + bj * HALF) = w; } }
    }
};

template <int MODE> struct EpiRes {
    static constexpr bool PERM = true, AFTER_DRAIN = true;
    const float* basef; bf16_t* X; float* outf; const float* g; unsigned* xbuf; unsigned* cnt; float* rsp; unsigned* tmo;
    __device__ __forceinline__ void fused(f32x4 (&acc)[2][2][4][2], const Unit& u, int wr, int wc, int fr, int fq, PG8_LAS unsigned char* lds, int wid, int lane) const {
        PG8_LAS float* P = (PG8_LAS float*)lds;
        PG8_LAS float* S = (PG8_LAS float*)(lds + 4096);
        PG8_LAS float* R = (PG8_LAS float*)(lds + 5120);
        const int col0 = u.pn * BM + wc * 32 + 8 * fq;
        u32x4 pre[4][2][1];
#pragma unroll
        for (int m = 0; m < 4; ++m) { const size_t off = (size_t)(u.pm * BM + wr * 64 + m * 16 + fr) * 1024 + col0;
#pragma unroll
            for (int bj = 0; bj < 2; ++bj) {
                pre[m][bj][0] = *(const u32x4*)(X + off + bj * HALF); } }
#pragma unroll
        for (int ai = 0; ai < 2; ++ai)
#pragma unroll
            for (int m = 0; m < 4; ++m) { float s = 0.f;
#pragma unroll
                for (int bj = 0; bj < 2; ++bj)
#pragma unroll
                    for (int n = 0; n < 2; ++n) { const f32x4 x = acc[ai][bj][m][n]; s += (x[0] * x[0] + x[1] * x[1]) + (x[2] * x[2] + x[3] * x[3]); }
                s += __shfl_xor(s, 16); s += __shfl_xor(s, 32);
                if (fq == 0) P[(ai * HALF + wr * 64 + m * 16 + fr) * 4 + wc] = s; }
        asm volatile("s_waitcnt lgkmcnt(0)" ::: "memory"); __builtin_amdgcn_s_barrier(); asm volatile("" ::: "memory");
        const int row = wid * 32 + (lane & 31);
        if (lane < 32) { const f32x4 p = *(const PG8_LAS f32x4*)(P + row * 4); const float t = (p[0] + p[1]) + (p[2] + p[3]);
            __hip_atomic_store(xbuf + (size_t)(u.pm * BM + row) * 4 + u.pn, __float_as_uint(t), __ATOMIC_RELAXED, __HIP_MEMORY_SCOPE_AGENT); }
        asm volatile("s_waitcnt vmcnt(0)" ::: "memory");
        if (lane == 0) __hip_atomic_fetch_add(cnt + 64 * u.pm, 1u, __ATOMIC_RELAXED, __HIP_MEMORY_SCOPE_AGENT);
        if (wid == 0) { unsigned sp = 0;
            while ((unsigned)__builtin_amdgcn_readfirstlane(__hip_atomic_load(cnt + 64 * u.pm, __ATOMIC_RELAXED, __HIP_MEMORY_SCOPE_AGENT)) < 32u) {
                __builtin_amdgcn_s_sleep(2);
                if ((++sp & 1023u) == 0u) { if (__hip_atomic_load(tmo, __ATOMIC_RELAXED, __HIP_MEMORY_SCOPE_AGENT) != 0u) break; if (sp > (1u << 22)) { if (lane == 0) __hip_atomic_store(tmo, 1u, __ATOMIC_RELAXED, __HIP_MEMORY_SCOPE_AGENT); break; } } }
            }
        asm volatile("s_waitcnt vmcnt(0) lgkmcnt(0)" ::: "memory"); __builtin_amdgcn_s_barrier(); asm volatile("" ::: "memory");
        if (lane < 32) { const unsigned* slot = xbuf + (size_t)(u.pm * BM + row) * 4; float t = 0.f;
#pragma unroll
            for (int k = 0; k < 4; ++k) t += __uint_as_float(__hip_atomic_load(slot + k, __ATOMIC_RELAXED, __HIP_MEMORY_SCOPE_AGENT));
            S[row] = 1.0f / sqrtf(t * (1.0f / 1024.0f) + 1e-6f);
            if (MODE == 1) R[row] = basef[u.pm * BM + row]; }
        asm volatile("s_waitcnt lgkmcnt(0)" ::: "memory"); __builtin_amdgcn_s_barrier(); asm volatile("" ::: "memory");
        f32x4 gv[2][2];
#pragma unroll
        for (int bj = 0; bj < 2; ++bj)
#pragma unroll
            for (int n = 0; n < 2; ++n) gv[bj][n] = *(const f32x4*)(g + col0 + bj * HALF + 4 * n);
#pragma unroll
        for (int ai = 0; ai < 2; ++ai)
#pragma unroll
            for (int m = 0; m < 4; ++m) { const int r = ai * HALF + wr * 64 + m * 16 + fr; const float sr = S[r], rn = MODE == 1 ? R[r] : 1.f; const size_t off = (size_t)(u.pm * BM + r) * 1024 + col0; float q = 0.f;
#pragma unroll
                for (int bj = 0; bj < 2; ++bj) { f32x4 b0, b1;
                    { const u32x4 w = ai == 0 ? pre[m][bj][0] : *(const u32x4*)(X + off + bj * HALF);
                        b0 = (f32x4){__uint_as_float(w.x << 16), __uint_as_float(w.x & 0xffff0000u), __uint_as_float(w.y << 16), __uint_as_float(w.y & 0xffff0000u)};
                        b1 = (f32x4){__uint_as_float(w.z << 16), __uint_as_float(w.z & 0xffff0000u), __uint_as_float(w.w << 16), __uint_as_float(w.w & 0xffff0000u)};
                        if (MODE == 1) { b0 = b0 * rn; b1 = b1 * rn; } }
                    const f32x4 v0 = b0 + acc[ai][bj][m][0] * sr * gv[bj][0], v1 = b1 + acc[ai][bj][m][1] * sr * gv[bj][1];
                    if (MODE == 3) { __builtin_nontemporal_store(v0, (f32x4*)(outf + off + bj * HALF)); __builtin_nontemporal_store(v1, (f32x4*)(outf + off + bj * HALF + 4)); }
                    else { q += ((v0[0] * v0[0] + v0[1] * v0[1]) + (v0[2] * v0[2] + v0[3] * v0[3])) + ((v1[0] * v1[0] + v1[1] * v1[1]) + (v1[2] * v1[2] + v1[3] * v1[3]));
                        u32x4 w; w.x = cvt_pk_bf16(v0[0], v0[1]); w.y = cvt_pk_bf16(v0[2], v0[3]); w.z = cvt_pk_bf16(v1[0], v1[1]); w.w = cvt_pk_bf16(v1[2], v1[3]);
                        *(u32x4*)(X + off + bj * HALF) = w; } }
                if (MODE != 3) { q += __shfl_xor(q, 16); q += __shfl_xor(q, 32); if (fq == 0) P[r * 4 + wc] = q; }
                if (m & 1) asm volatile("" ::: "memory"); }
        if (MODE != 3) {
            asm volatile("s_waitcnt lgkmcnt(0)" ::: "memory"); __builtin_amdgcn_s_barrier(); asm volatile("" ::: "memory");
            if (lane < 32) { const f32x4 p = *(const PG8_LAS f32x4*)(P + row * 4); rsp[(size_t)(u.pm * BM + row) * 4 + u.pn] = (p[0] + p[1]) + (p[2] + p[3]); }
        }
    }
};

template <class Epi, class Sched, bool ALIGN_EPI = false, bool SP2 = false>
__device__ __forceinline__ void gemm_phase(PG8_LAS unsigned char* lds, const Gemm g, const Sched& S, const Epi& E) {
    int tid_ = threadIdx.x; asm volatile("" : "+v"(tid_));
    const int tid = tid_, wid = __builtin_amdgcn_readfirstlane(tid >> 6), lane = tid & 63, wr = wid >> 2, wc = wid & 3, fr = lane & 15, fq = lane >> 4;
    const int K = g.K, nt = K / BK;
    unsigned voffA[2], voffB[2];
#pragma unroll
    for (int i = 0; i < 2; ++i) { int R, C; stage_rc(tid * 16 + i * 8192, R, C); const int Rb = Epi::PERM ? ((R & ~31) + perm32(R & 31)) : R;
        voffA[i] = (unsigned)(R * K + C) * 2u; voffB[i] = (unsigned)(Rb * K + C) * 2u; }
    const size_t kstep = (size_t)(BK * 2);
    const size_t hstep = (size_t)HALF * K * 2;
    const size_t tstep = 2 * hstep;
    const unsigned ldsw = (unsigned)wid * 1024u;
    const int aoff = lds_byte(wr * 64 + fr, fq * 8), boff = lds_byte(wc * 32 + fr, fq * 8);
#define PG8_SA(b, h) (((b) * 2 + (h)) * HTB)
#define PG8_SB(b, h) ((4 + (b) * 2 + (h)) * HTB)
#define PG8_STAGE(bufoff, gbase, voff) do { _Pragma("unroll") for (int _i = 0; _i < 2; ++_i) \
        __builtin_amdgcn_global_load_lds((const unsigned*)((const char*)(gbase) + (voff)[_i]), (PG8_LAS unsigned*)(lds + (bufoff) + ldsw + _i * 8192), 16, 0, 0); } while (0)
#define PG8_LDA(dst, b, h) do { _Pragma("unroll") for (int m = 0; m < 4; ++m) _Pragma("unroll") for (int k = 0; k < 2; ++k) dst[m][k] = *(const PG8_LAS bf16x8*)(lds + PG8_SA(b, h) + aoff + m * 2048 + k * 1024); } while (0)
#define PG8_LDB(dst, b, h) do { _Pragma("unroll") for (int n = 0; n < 2; ++n) _Pragma("unroll") for (int k = 0; k < 2; ++k) dst[n][k] = *(const PG8_LAS bf16x8*)(lds + PG8_SB(b, h) + boff + n * 2048 + k * 1024); } while (0)
#define PG8_MMA(ai, bj, At, Bt) do { __builtin_amdgcn_s_setprio(1); _Pragma("unroll") for (int m = 0; m < 4; ++m) _Pragma("unroll") for (int n = 0; n < 2; ++n) _Pragma("unroll") for (int k = 0; k < 2; ++k) \
        acc[ai][bj][m][n] = __builtin_amdgcn_mfma_f32_16x16x32_bf16(Bt[n][k], At[m][k], acc[ai][bj][m][n], 0, 0, 0); __builtin_amdgcn_s_setprio(0); } while (0)
#define PG8_WAIT_V(n) asm volatile("s_waitcnt vmcnt(" #n ")" ::: "memory")
#define PG8_WAIT_L(n) asm volatile("s_waitcnt lgkmcnt(" #n ")" ::: "memory")
#define PG8_BAR __builtin_amdgcn_s_barrier()
#define PG8_SCHED __builtin_amdgcn_sched_barrier(0)
    Unit cur, nxt; int ui = 0;
    if (!S.next(0, cur)) return;
    f32x4 acc[2][2][4][2];
#pragma unroll
    for (int a = 0; a < 2; ++a)
#pragma unroll
        for (int b = 0; b < 2; ++b)
#pragma unroll
            for (int m = 0; m < 4; ++m)
#pragma unroll
                for (int n = 0; n < 2; ++n) acc[a][b][m][n] = (f32x4){0.f, 0.f, 0.f, 0.f};
    bf16x8 At[4][2], B0[2][2], B1[2][2];
    const char* cA = (const char*)g.A + (size_t)cur.pm * tstep; const char* cB = (const char*)g.Bt + (size_t)cur.pn * tstep;
    S.a_ready(cur);
    if constexpr (SP2) {
        PG8_STAGE(PG8_SB(0, 0), cB, voffB); PG8_STAGE(PG8_SB(0, 1), cB + hstep, voffB); PG8_STAGE(PG8_SA(0, 0), cA, voffA); PG8_STAGE(PG8_SA(0, 1), cA + hstep, voffA);
        if (wr == 1) PG8_BAR;
        PG8_WAIT_V(2); PG8_BAR;
        PG8_STAGE(PG8_SB(1, 0), cB + kstep, voffB); PG8_STAGE(PG8_SA(1, 0), cA + kstep, voffA); PG8_STAGE(PG8_SB(1, 1), cB + hstep + kstep, voffB);
        PG8_WAIT_V(6); PG8_BAR;
    } else {
        PG8_STAGE(PG8_SB(0, 0), cB, voffB); PG8_STAGE(PG8_SA(0, 0), cA, voffA); PG8_STAGE(PG8_SB(0, 1), cB + hstep, voffB); PG8_STAGE(PG8_SA(0, 1), cA + hstep, voffA);
        if (wr == 1) PG8_BAR;
        PG8_WAIT_V(4); PG8_BAR;
        PG8_STAGE(PG8_SB(1, 0), cB + kstep, voffB); PG8_STAGE(PG8_SA(1, 0), cA + kstep, voffA); PG8_STAGE(PG8_SB(1, 1), cB + hstep + kstep, voffB);
        PG8_WAIT_V(6); PG8_BAR;
    }
    for (;;) {
        const bool has_next = S.next(ui + 1, nxt);
        const char* nA = has_next ? (const char*)g.A + (size_t)nxt.pm * tstep : cA; const char* nB = has_next ? (const char*)g.Bt + (size_t)nxt.pn * tstep : cB;
        for (int t = 0; t < nt; t += 2) {
            const bool last = (t == nt - 2);
            const char* a1 = cA + (size_t)(t + 1) * kstep;
            const char* a2 = last ? nA : cA + (size_t)(t + 2) * kstep; const char* b2 = last ? nB : cB + (size_t)(t + 2) * kstep;
            const char* a3 = a2 + kstep; const char* b3 = b2 + kstep;
            if (last && has_next) S.a_ready(nxt);
            if constexpr (SP2) {
            PG8_LDB(B0, 0, 0); PG8_LDB(B1, 0, 1); PG8_SCHED; PG8_LDA(At, 0, 0); PG8_STAGE(PG8_SA(1, 1), a1 + hstep, voffA);
            PG8_WAIT_V(8); PG8_WAIT_L(0); PG8_BAR; PG8_MMA(0, 0, At, B0); PG8_MMA(0, 1, At, B1); PG8_BAR; PG8_SCHED;
            PG8_LDA(At, 0, 1); PG8_STAGE(PG8_SB(0, 0), b2, voffB); PG8_STAGE(PG8_SB(0, 1), b2 + hstep, voffB); PG8_STAGE(PG8_SA(0, 0), a2, voffA);
            PG8_WAIT_V(8); PG8_WAIT_L(0); PG8_BAR; PG8_MMA(1, 0, At, B0); PG8_MMA(1, 1, At, B1); PG8_BAR; PG8_SCHED;
            PG8_LDB(B0, 1, 0); PG8_LDB(B1, 1, 1); PG8_SCHED; PG8_LDA(At, 1, 0); PG8_STAGE(PG8_SA(0, 1), a2 + hstep, voffA);
            PG8_WAIT_V(8); PG8_WAIT_L(0); PG8_BAR; PG8_MMA(0, 0, At, B0); PG8_MMA(0, 1, At, B1); PG8_BAR; PG8_SCHED;
            PG8_LDA(At, 1, 1); PG8_STAGE(PG8_SB(1, 0), b3, voffB); PG8_STAGE(PG8_SB(1, 1), b3 + hstep, voffB); PG8_STAGE(PG8_SA(1, 0), a3, voffA);
            PG8_WAIT_V(8); PG8_WAIT_L(0); PG8_BAR; PG8_MMA(1, 0, At, B0); PG8_MMA(1, 1, At, B1); PG8_BAR; PG8_SCHED;
            } else {
            PG8_LDB(B0, 0, 0); PG8_SCHED; PG8_LDA(At, 0, 0); PG8_STAGE(PG8_SA(1, 1), a1 + hstep, voffA);
            PG8_WAIT_L(8); PG8_BAR; PG8_WAIT_L(0); PG8_MMA(0, 0, At, B0); PG8_BAR; PG8_SCHED;
            PG8_LDB(B1, 0, 1); PG8_STAGE(PG8_SB(0, 0), b2, voffB);
            PG8_BAR; PG8_WAIT_L(0); PG8_MMA(0, 1, At, B1); PG8_BAR;
            PG8_LDA(At, 0, 1); PG8_STAGE(PG8_SA(0, 0), a2, voffA);
            PG8_BAR; PG8_WAIT_L(0); PG8_MMA(1, 0, At, B0); PG8_BAR; PG8_SCHED;
            PG8_STAGE(PG8_SB(0, 1), b2 + hstep, voffB);
            PG8_WAIT_V(6); PG8_BAR; PG8_MMA(1, 1, At, B1); PG8_BAR;
            PG8_LDB(B0, 1, 0); PG8_SCHED; PG8_LDA(At, 1, 0); PG8_STAGE(PG8_SA(0, 1), a2 + hstep, voffA);
            PG8_WAIT_L(8); PG8_BAR; PG8_WAIT_L(0); PG8_MMA(0, 0, At, B0); PG8_BAR; PG8_SCHED;
            PG8_LDB(B1, 1, 1); PG8_STAGE(PG8_SB(1, 0), b3, voffB);
            PG8_BAR; PG8_WAIT_L(0); PG8_MMA(0, 1, At, B1); PG8_BAR;
            PG8_LDA(At, 1, 1); PG8_STAGE(PG8_SA(1, 0), a3, voffA);
            PG8_BAR; PG8_WAIT_L(0); PG8_MMA(1, 0, At, B0); PG8_BAR; PG8_SCHED;
            PG8_STAGE(PG8_SB(1, 1), b3 + hstep, voffB);
            PG8_WAIT_V(6); PG8_BAR; PG8_MMA(1, 1, At, B1); PG8_BAR;
            }
        }
        if constexpr (ALIGN_EPI) { if (wr == 0) PG8_BAR; }
        if constexpr (!Epi::AFTER_DRAIN) { E(acc, cur, wr, wc, fr, fq); S.done(cur); }
        if (!has_next) break;
#pragma unroll
        for (int a = 0; a < 2; ++a)
#pragma unroll
            for (int b = 0; b < 2; ++b)
#pragma unroll
                for (int m = 0; m < 4; ++m)
#pragma unroll
                    for (int n = 0; n < 2; ++n) acc[a][b][m][n] = (f32x4){0.f, 0.f, 0.f, 0.f};
        cur = nxt; cA = nA; cB = nB; ++ui;
        if constexpr (ALIGN_EPI) { if (wr == 1) PG8_BAR; }
    }
    PG8_WAIT_V(0);
    if constexpr (!ALIGN_EPI) { if (wr == 0) PG8_BAR; }
    PG8_BAR;
    if constexpr (Epi::AFTER_DRAIN) { E.fused(acc, cur, wr, wc, fr, fq, lds, wid, lane); S.done(cur); }
#undef PG8_SA
#undef PG8_SB
#undef PG8_STAGE
#undef PG8_LDA
#undef PG8_LDB
#undef PG8_MMA
#undef PG8_WAIT_V
#undef PG8_WAIT_L
#undef PG8_BAR
#undef PG8_SCHED
}
}
constexpr int NWAVES = 8;
constexpr int D = 1024, MP = 16384, MS = 256, M = MP + MS, NIN = 2048, FF = 4096;
constexpr float EPS = 1e-6f;
constexpr size_t OUT_Y = 0, OUT_POOL_P = 17039360, OUT_CONV_P = 17070080, OUT_MK = 17074176, OUT_MV = 18122752, OUT_POOL_S = 19171328, OUT_CONV_S = 19294208, OUT_TOTAL = 19310592;
constexpr size_t MiB = 1u << 20;
constexpr size_t WS_CTL = 0, CTL_ZERO_BYTES = 128 * 1024;
constexpr size_t WS_WDOWN = 1 * MiB, WS_WUP = 9 * MiB, WS_WIN = 17 * MiB, WS_WKV = 21 * MiB, WS_WOUT = 25 * MiB, WS_WQ = 27 * MiB, WS_WCO = 29 * MiB, WS_WP = 31 * MiB;
constexpr size_t WS_HISTU = 31 * MiB + 512 * 1024, WS_HISTV = WS_HISTU + 16 * 15 * 512 * 2, WS_ZERO = 32 * 1024;
constexpr size_t WS_MN = 32 * MiB, WS_KB = 34 * MiB, WS_VT = 36 * MiB, WS_KBS = 38 * MiB, WS_VTS = 46 * MiB;
constexpr size_t WS_XN = 54 * MiB;
constexpr size_t WS_MRG = 87 * MiB;
constexpr size_t WS_AO = 87 * MiB;
constexpr size_t WS_P1 = 120 * MiB;
constexpr size_t WS_QO = 120 * MiB;
constexpr size_t WS_HID = 120 * MiB;
constexpr size_t WS_XB1 = 248 * MiB, WS_XB2 = WS_XB1 + 256 * 1024, WS_XB3 = WS_XB2 + 256 * 1024, WS_RSP1 = WS_XB3 + 256 * 1024, WS_RSP2 = WS_RSP1 + 256 * 1024;
constexpr size_t WS_SXB = 249 * MiB + 512 * 1024, WS_SRSP = WS_SXB + 3 * 32768;
constexpr size_t WS_RNORM = 249 * MiB + 768 * 1024;
constexpr size_t WS_SQO = 250 * MiB, WS_SAO = WS_SQO + 512 * 1024, WS_SRAW = 251 * MiB, WS_SHID = 252 * MiB;
constexpr size_t WS_END = 256 * MiB;
constexpr int CW_TMO = 0, CW_SEAM = 16384, CW_SSEAM = 16384 + 3 * 4096;
static_assert(WS_MRG + (size_t)M * D * 2 <= WS_P1 && WS_HID + (size_t)MP * FF * 2 <= WS_XB1 && WS_SHID + (size_t)MS * FF * 2 <= WS_END, "ws map");
constexpr int CW_BAR = 4096;

constexpr int RING_BYTES = 131072, LDSCTL_OFF = RING_BYTES, MISC_OFF = LDSCTL_OFF + 320, RSTAB_OFF = RING_BYTES + 1024, GGTAB_OFF = RING_BYTES + 2048, STASH_OFF = RING_BYTES + 4096, LDS_BYTES = 147456;

#define GAS __attribute__((address_space(1)))
#define LAS __attribute__((address_space(3)))
typedef unsigned short bf16;
typedef unsigned v4u __attribute__((ext_vector_type(4)));
typedef unsigned v2u __attribute__((ext_vector_type(2)));
typedef float f32x4 __attribute__((ext_vector_type(4)));
typedef float f32x16 __attribute__((ext_vector_type(16)));
typedef float f32x2 __attribute__((ext_vector_type(2)));
typedef short bf16x8 __attribute__((ext_vector_type(8)));
#define LDS_WAIT() asm volatile("s_waitcnt lgkmcnt(0)" ::: "memory")
#define VM_WAIT() asm volatile("s_waitcnt vmcnt(0)" ::: "memory")
__device__ __forceinline__ unsigned f2bf(float f) { unsigned u = __builtin_bit_cast(unsigned, f); return (u + 0x7fffu + ((u >> 16) & 1u)) >> 16; }
__device__ __forceinline__ unsigned pk2(float lo, float hi) { return pg8::cvt_pk_bf16(lo, hi); }
typedef __bf16 bf16n2 __attribute__((ext_vector_type(2)));
__device__ __forceinline__ unsigned pk2c(float lo, float hi) { const bf16n2 v = __builtin_convertvector((f32x2){lo, hi}, bf16n2); return __builtin_bit_cast(unsigned, v); }
__device__ __forceinline__ float bflo(unsigned w) { return __builtin_bit_cast(float, w << 16); }
__device__ __forceinline__ float bfhi(unsigned w) { return __builtin_bit_cast(float, w & 0xffff0000u); }

#define XB_TMO      128
#define XB_XCNT(j)  (256  + 64 * (j))
#define XB_XSUB(j)  (1280 + 64 * (j))
#define XB_XGEN(j)  (2304 + 64 * (j))
#define XB_TOP      3328
#define XB_TOPGEN   3392
#define XCD_BAR_WORDS 3456
#define XB_SPIN_CAP (1u << 22)
__device__ __forceinline__ unsigned xb_ld(unsigned* p)              { return __hip_atomic_load(p, __ATOMIC_RELAXED, __HIP_MEMORY_SCOPE_AGENT); }
__device__ __forceinline__ unsigned xb_add(unsigned* p, unsigned v) { return __hip_atomic_fetch_add(p, v, __ATOMIC_RELAXED, __HIP_MEMORY_SCOPE_AGENT); }
__device__ __forceinline__ unsigned xb_xcc_id() { return (unsigned)__builtin_amdgcn_s_getreg((3 << 11) | 20) & 0xFu; }
#define XB_SPIN(cond, bar) do { unsigned _sp = 0; while (cond) { __builtin_amdgcn_s_sleep(1); \
    if ((++_sp & 255u) == 0u) { if (xb_ld(&(bar)[XB_TMO])) break; if (_sp > XB_SPIN_CAP) { atomicAdd(&(bar)[XB_TMO], 1u); break; } } } } while (0)
struct XcdBarrier { unsigned* bar; unsigned x; volatile LAS unsigned* st; };
__device__ __forceinline__ XcdBarrier xcd_barrier_post(unsigned* bar, volatile LAS unsigned* st) {
    XcdBarrier b; b.bar = bar; b.x = xb_xcc_id(); b.st = st;
    if (threadIdx.x == 0) (void)xb_add(&bar[XB_XCNT(b.x)], 1u);
    return b;
}
__device__ __forceinline__ void xcd_barrier_complete(unsigned* bar, unsigned x, unsigned& nloc, unsigned& nx) {
    const unsigned G = gridDim.x * gridDim.y * gridDim.z;
    unsigned sum, cnt, mine, sp = 0u;
    for (;;) {
        sum = 0u; cnt = 0u; mine = 0u;
#pragma unroll
        for (unsigned j = 0; j < 16; ++j) { const unsigned c = xb_ld(&bar[XB_XCNT(j)]); sum += c; cnt += (c > 0u) ? 1u : 0u; mine = (j == x) ? c : mine; }
        if (sum == G) break;
        __builtin_amdgcn_s_sleep(1);
        if ((++sp & 255u) == 0u) { if (xb_ld(&bar[XB_TMO])) break; if (sp > XB_SPIN_CAP) { atomicAdd(&bar[XB_TMO], 1u); break; } }
    }
    nloc = mine > 0u ? mine : 1u; nx = cnt > 0u ? cnt : 1u;
}
__device__ __forceinline__ void xcd_barrier(const XcdBarrier& b) {
    asm volatile("s_waitcnt vmcnt(0)" ::: "memory");
    __syncthreads();
    if (threadIdx.x == 0) {
        unsigned* bar = b.bar;
        __builtin_amdgcn_s_waitcnt(0);
        unsigned nloc = b.st[0], nx = b.st[1];
        if (nloc == 0u) { xcd_barrier_complete(bar, b.x, nloc, nx); b.st[0] = nloc; b.st[1] = nx; }
        const unsigned old = xb_add(&bar[XB_XSUB(b.x)], 1u);
        const unsigned gen = old / nloc;
        if (old + 1u == (gen + 1u) * nloc) {
            __builtin_amdgcn_fence(__ATOMIC_RELEASE, "agent");
            asm volatile("s_waitcnt vmcnt(0)" ::: "memory");
            const unsigned og = xb_add(&bar[XB_TOP], 1u);
            const unsigned tg = og / nx;
            if (og + 1u == (tg + 1u) * nx) xb_add(&bar[XB_TOPGEN], 1u);
            else XB_SPIN(xb_ld(&bar[XB_TOPGEN]) == tg, bar);
            __builtin_amdgcn_fence(__ATOMIC_ACQUIRE, "agent");
            xb_add(&bar[XB_XGEN(b.x)], 1u);
            asm volatile("s_waitcnt vmcnt(0)" ::: "memory");
        } else {
            XB_SPIN(xb_ld(&bar[XB_XGEN(b.x)]) == gen, bar);
            __builtin_amdgcn_fence(__ATOMIC_ACQUIRE, "agent");
            asm volatile("s_waitcnt vmcnt(0)" ::: "memory");
        }
    }
    __syncthreads();
}

__device__ __forceinline__ void xcd_arrive(const XcdBarrier& b) {
    asm volatile("s_waitcnt vmcnt(0)" ::: "memory");
    __syncthreads();
    if (threadIdx.x == 0) {
        unsigned* bar = b.bar;
        __builtin_amdgcn_s_waitcnt(0);
        unsigned nloc = b.st[0], nx = b.st[1];
        if (nloc == 0u) { xcd_barrier_complete(bar, b.x, nloc, nx); b.st[0] = nloc; b.st[1] = nx; }
        const unsigned old = xb_add(&bar[XB_XSUB(b.x)], 1u);
        const unsigned gen = old / nloc;
        b.st[2] = gen;
        if (old + 1u == (gen + 1u) * nloc) {
            __builtin_amdgcn_fence(__ATOMIC_RELEASE, "agent");
            asm volatile("s_waitcnt vmcnt(0)" ::: "memory");
            (void)xb_add(&bar[XB_TOP], 1u);
        }
    }
}
__device__ __forceinline__ void xcd_wait(const XcdBarrier& b) {
    if (threadIdx.x == 0) {
        unsigned* bar = b.bar; const unsigned need = (b.st[2] + 1u) * b.st[1];
        XB_SPIN((int)(xb_ld(&bar[XB_TOP]) - need) < 0, bar);
        __builtin_amdgcn_fence(__ATOMIC_ACQUIRE, "agent");
        asm volatile("s_waitcnt vmcnt(0)" ::: "memory");
    }
    __syncthreads();
}

#define XB_LSUB(j)  (5120 + 64 * (j))
#define XB_GRP(j)   (6400 + 64 * (j))
#define XB_MIS      7040
__device__ __forceinline__ void xcd_local_barrier(const XcdBarrier& b) {
    asm volatile("s_waitcnt vmcnt(0)" ::: "memory");
    __syncthreads();
    if (threadIdx.x == 0) {
        unsigned* bar = b.bar;
        const unsigned nloc = b.st[0];
        const unsigned old = xb_add(&bar[XB_LSUB(b.x)], 1u);
        const unsigned need = (old / nloc + 1u) * nloc;
        XB_SPIN((int)(xb_ld(&bar[XB_LSUB(b.x)]) - need) < 0, bar);
        __builtin_amdgcn_fence(__ATOMIC_ACQUIRE, "agent");
        asm volatile("s_waitcnt vmcnt(0)" ::: "memory");
    }
    __syncthreads();
}

struct Args { const float* in[27]; float* out; unsigned char* ws; };

__device__ __forceinline__ float wave_sum(float v) {
#pragma unroll
    for (int o = 1; o < 64; o <<= 1) v += __shfl_xor(v, o);
    return v;
}

struct TItem { const float* W; const float* g; const float* gn; bf16* WT; int ldw, K, srccol, dstrow, k0; float sc; int kperm; };
struct TRegs { f32x4 v[8]; float gk[8]; };
__device__ __forceinline__ void t_load(const TItem& t, TRegs& r, int lane) {
    const int rl = lane >> 3, cq = lane & 7;
#pragma unroll
    for (int i = 0; i < 8; ++i) { const int kk = 8 * i + rl; r.v[i] = __builtin_nontemporal_load((const GAS f32x4*)(t.W + (size_t)(t.k0 + kk) * t.ldw + t.srccol + 4 * cq)); r.gk[i] = t.g ? t.g[t.k0 + kk] : 1.f; }
}
__device__ __forceinline__ void t_process(const TItem& t, const TRegs& r, LAS float* scr, int lane) {
    const int rl = lane >> 3, cq = lane & 7;
    f32x4 gn4 = (f32x4){1.f, 1.f, 1.f, 1.f}; if (t.gn) gn4 = *(const GAS f32x4*)(t.gn + t.srccol + 4 * cq);
#pragma unroll
    for (int i = 0; i < 8; ++i) { const int kk = 8 * i + rl; const float m = r.gk[i] * t.sc; LAS float* d = scr + kk * 33 + 4 * cq;
        d[0] = r.v[i].x * m * gn4.x; d[1] = r.v[i].y * m * gn4.y; d[2] = r.v[i].z * m * gn4.z; d[3] = r.v[i].w * m * gn4.w; }
    LDS_WAIT(); asm volatile("" ::: "memory");
    const int c = lane & 7;
    const int lp = t.kperm == 0 ? 8 * c : t.kperm == 1 ? (((c & 6) << 3) | ((c & 1) << 2)) : (((c & 4) << 3) | ((c & 3) << 2));
    const LAS float* s0 = scr + lp * 33; const LAS float* s1 = s0 + (4 << t.kperm) * 33;
#pragma unroll
    for (int j = 0; j < 4; ++j) { const int n = (lane >> 3) + 8 * j;
        float e[8];
#pragma unroll
        for (int q = 0; q < 8; ++q) e[q] = (q < 4 ? s0 : s1)[(q & 3) * 33 + n];
        v4u o; o.x = pk2(e[0], e[1]); o.y = pk2(e[2], e[3]); o.z = pk2(e[4], e[5]); o.w = pk2(e[6], e[7]);
        *(GAS v4u*)(t.WT + (size_t)(t.dstrow + n) * t.K + t.k0 + 8 * c) = o; }
    LDS_WAIT(); asm volatile("" ::: "memory");
}
__device__ __forceinline__ void rms_row_to_bf16(const float* xrow, bf16* orow, float* n0, int lane) {
    const GAS f32x4* xr = (const GAS f32x4*)xrow + lane;
    f32x4 v[4]; float s = 0.f;
#pragma unroll
    for (int j = 0; j < 4; ++j) { v[j] = __builtin_nontemporal_load(xr + 64 * j); s += (v[j].x * v[j].x + v[j].y * v[j].y) + (v[j].z * v[j].z + v[j].w * v[j].w); }
    const float rs = 1.f / sqrtf(wave_sum(s) * (1.f / D) + EPS);
    if (lane == 0 && n0) *n0 = 1.f / rs;
    GAS v2u* o8 = (GAS v2u*)orow + lane;
#pragma unroll
    for (int j = 0; j < 4; ++j) { v2u w; w.x = pk2(v[j].x * rs, v[j].y * rs); w.y = pk2(v[j].z * rs, v[j].w * rs); o8[64 * j] = w; }
}
__device__ __forceinline__ void rms_rows2_to_bf16(const float* x0, bf16* o0, const float* x1, bf16* o1, float* n0, float* n1, int lane) {
    const GAS f32x4* a0 = (const GAS f32x4*)x0 + lane; const GAS f32x4* a1 = (const GAS f32x4*)x1 + lane;
    f32x4 v[4], w[4]; float s = 0.f, t = 0.f;
#pragma unroll
    for (int j = 0; j < 4; ++j) { v[j] = __builtin_nontemporal_load(a0 + 64 * j); w[j] = __builtin_nontemporal_load(a1 + 64 * j); }
#pragma unroll
    for (int j = 0; j < 4; ++j) { s += (v[j].x * v[j].x + v[j].y * v[j].y) + (v[j].z * v[j].z + v[j].w * v[j].w); t += (w[j].x * w[j].x + w[j].y * w[j].y) + (w[j].z * w[j].z + w[j].w * w[j].w); }
    const float rs = 1.f / sqrtf(wave_sum(s) * (1.f / D) + EPS), rt_ = 1.f / sqrtf(wave_sum(t) * (1.f / D) + EPS);
    GAS v2u* p0 = (GAS v2u*)o0 + lane; GAS v2u* p1 = (GAS v2u*)o1 + lane;
    if (lane == 0) { if (n0) *n0 = 1.f / rs; if (n1) *n1 = 1.f / rt_; }
#pragma unroll
    for (int j = 0; j < 4; ++j) { v2u u; u.x = pk2(v[j].x * rs, v[j].y * rs); u.y = pk2(v[j].z * rs, v[j].w * rs); p0[64 * j] = u;
        v2u z; z.x = pk2(w[j].x * rt_, w[j].y * rt_); z.y = pk2(w[j].z * rt_, w[j].w * rt_); p1[64 * j] = z; }
}
__device__ __forceinline__ const float* xrow_ptr(const Args& a, int row) { return row < MP ? a.in[0] + (size_t)row * D : a.in[1] + (size_t)(row - MP) * D; }

constexpr int I_IN = 16 * 64, I_KV = 16 * 64, I_WP = 4 * 2 * 4, N_EARLY = I_IN + I_KV + I_WP;
constexpr int I_OUT = 16 * 32, I_Q = 16 * 32, I_CO = 16 * 32, I_UP = 16 * 128, I_DN = 64 * 32, I_VS = 64 * 4 * 8, N_ITEMS = N_EARLY + I_OUT + I_Q + I_CO + I_UP + I_DN + I_VS;
constexpr int DN_LO = N_EARLY + I_OUT + I_Q + I_CO + I_UP, DN_HI = DN_LO + I_DN;
__device__ __forceinline__ TItem p0_item(const Args& a, int it) {
    unsigned char* ws = a.ws; TItem t; t.g = nullptr; t.gn = nullptr; t.sc = 1.f; t.kperm = 0;
    int r = it;
    if (r < I_IN) { const int kb = r / 64, nb = r % 64, n0 = 32 * nb; int src;
        if (n0 < 1024) src = n0; else { const int j = (n0 - 1024) >> 8, o = (n0 - 1024) & 255; src = o < 128 ? 1024 + 128 * j + o : 1536 + 128 * j + (o - 128); }
        t.W = a.in[8]; t.ldw = NIN; t.K = D; t.srccol = src; t.WT = (bf16*)(ws + WS_WIN); t.dstrow = n0; t.k0 = 64 * kb; t.g = a.in[7]; return t; } r -= I_IN;
    if (r < I_KV) { const int kb = r / 64, nb = r % 64, n0 = 32 * nb;
        t.W = n0 < 1024 ? a.in[17] : a.in[18]; t.ldw = D; t.K = D; t.srccol = n0 & 1023; t.WT = (bf16*)(ws + WS_WKV); t.dstrow = n0; t.k0 = 64 * kb; t.g = a.in[16]; return t; } r -= I_KV;
    if (r < I_WP) { const int gi = r / 8, kb = (r % 8) / 4, nb = r % 4;
        t.W = a.in[9] + gi * 16384; t.ldw = 128; t.K = 128; t.srccol = 32 * nb; t.WT = (bf16*)(ws + WS_WP) + gi * 16384; t.dstrow = 32 * nb; t.k0 = 64 * kb; t.gn = a.in[10] + gi * 128; t.kperm = 2; return t; } r -= I_WP;
    if (r < I_OUT) { t.W = a.in[14]; t.ldw = D; t.K = D; t.srccol = 32 * (r % 32); t.WT = (bf16*)(ws + WS_WOUT); t.dstrow = t.srccol; t.k0 = 64 * (r / 32);
        t.g = t.k0 < 512 ? a.in[12] : a.in[13] - 512; return t; } r -= I_OUT;
    if (r < I_Q) { t.W = a.in[20]; t.ldw = D; t.K = D; t.srccol = 32 * (r % 32); t.WT = (bf16*)(ws + WS_WQ); t.dstrow = t.srccol; t.k0 = 64 * (r / 32); t.g = a.in[19]; t.sc = 0.0625f; return t; } r -= I_Q;
    if (r < I_CO) { t.W = a.in[21]; t.ldw = D; t.K = D; t.srccol = 32 * (r % 32); t.WT = (bf16*)(ws + WS_WCO); t.dstrow = t.srccol; t.k0 = 64 * (r / 32); return t; } r -= I_CO;
    if (r < I_UP) { t.W = a.in[24]; t.ldw = FF; t.K = D; t.srccol = 32 * (r % 128); t.WT = (bf16*)(ws + WS_WUP); t.dstrow = t.srccol; t.k0 = 64 * (r / 128); t.g = a.in[23]; return t; } r -= I_UP;
    if (r < I_DN) { t.W = a.in[25]; t.ldw = D; t.K = FF; t.srccol = 32 * (r % 32); t.WT = (bf16*)(ws + WS_WDOWN); t.dstrow = t.srccol; t.k0 = 64 * (r / 32); return t; } r -= I_DN;
    { const int sbh = r / 32, kb = (r % 32) / 8, nb = r % 8, sb = sbh >> 2, h = sbh & 3;
        t.W = a.in[5] + (size_t)sb * 262144 + h * 256; t.ldw = 1024; t.K = 256; t.srccol = 32 * nb; t.WT = (bf16*)(ws + WS_VTS) + (size_t)sbh * 65536; t.dstrow = 32 * nb; t.k0 = 64 * kb; t.kperm = 1; return t; }
}
__device__ __forceinline__ void p0_items(const Args& a, LAS float* scr, int lo, int hi, int gw, int NGW, int lane) {
    int it = lo + gw; TItem cur; TRegs rc;
    if (it < hi) { cur = p0_item(a, it); t_load(cur, rc, lane); }
    while (it < hi) {
        const int nx = it + NGW; TItem nxt = cur; TRegs rn = rc;
        if (nx < hi) { nxt = p0_item(a, nx); t_load(nxt, rn, lane); }
        t_process(cur, rc, scr, lane);
        cur = nxt; rc = rn; it = nx;
    }
}
__device__ __forceinline__ void p0_prologue(const Args& a, LAS unsigned char* lds, int gw, int NGW, int wave, int lane_) {
    int lane = lane_; asm volatile("" : "+v"(lane));
    unsigned char* ws = a.ws;
    p0_items(a, (LAS float*)(lds + wave * 16384), 0, N_EARLY, gw, NGW, lane);
    float* rn = (float*)(ws + WS_RNORM);
    for (int m = gw; m < M + 1024; m += 2 * NGW) {
        const int m2 = m + NGW;
        const float* r0 = m < M ? xrow_ptr(a, m) : a.in[6] + (size_t)(m - M) * D; bf16* o0 = m < M ? (bf16*)(ws + WS_XN) + (size_t)m * D : (bf16*)(ws + WS_MN) + (size_t)(m - M) * D;
        if (m2 < M + 1024) {
            const float* r1 = m2 < M ? xrow_ptr(a, m2) : a.in[6] + (size_t)(m2 - M) * D; bf16* o1 = m2 < M ? (bf16*)(ws + WS_XN) + (size_t)m2 * D : (bf16*)(ws + WS_MN) + (size_t)(m2 - M) * D;
            rms_rows2_to_bf16(r0, o0, r1, o1, m < MP ? rn + m : nullptr, m2 < MP ? rn + m2 : nullptr, lane);
        } else rms_row_to_bf16(r0, o0, m < MP ? rn + m : nullptr, lane);
    }
    { GAS v4u* dst = (GAS v4u*)(ws + WS_HISTU); constexpr int NU = 16 * 15 * 512 / 8, NV = 16 * 2 * 512 / 8;
      for (int i = gw * 64 + lane; i < NU + NV; i += NGW * 64) { const GAS f32x4* src = i < NU ? (const GAS f32x4*)a.in[2] + 2 * i : (const GAS f32x4*)a.in[3] + 2 * (i - NU); const f32x4 p = src[0], q = src[1];
          v4u o; o.x = pk2(p.x, p.y); o.y = pk2(p.z, p.w); o.z = pk2(q.x, q.y); o.w = pk2(q.z, q.w); dst[i] = o; } }
}
__device__ __forceinline__ void p2_late(const Args& a, LAS unsigned char* lds, int gw, int NGW, int wave, int lane_) {
    int lane = lane_; asm volatile("" : "+v"(lane));
    unsigned char* ws = a.ws;
    p0_items(a, (LAS float*)(lds + wave * 16384), N_EARLY, DN_LO, gw, NGW, lane);
    p0_items(a, (LAS float*)(lds + wave * 16384), DN_HI, N_ITEMS, gw, NGW, lane);
    { const GAS f32x4* src = (const GAS f32x4*)a.in[4]; GAS v4u* dst = (GAS v4u*)(ws + WS_KBS); const size_t n = (size_t)16 * 256 * 1024 / 8, st = (size_t)NGW * 64;
      for (size_t i = (size_t)gw * 64 + lane; i < n; i += 4 * st) { f32x4 p[4], q[4];
#pragma unroll
          for (int k = 0; k < 4; ++k) if (i + k * st < n) { p[k] = __builtin_nontemporal_load(src + 2 * (i + k * st)); q[k] = __builtin_nontemporal_load(src + 2 * (i + k * st) + 1); }
#pragma unroll
          for (int k = 0; k < 4; ++k) if (i + k * st < n) { v4u o; o.x = pk2(p[k].x, p[k].y); o.y = pk2(p[k].z, p[k].w); o.z = pk2(q[k].x, q[k].y); o.w = pk2(q[k].z, q[k].w); dst[i + k * st] = o; } } }
}

__device__ __forceinline__ void load8(const bf16* p, float (&f)[8]) { const v4u w = *(const GAS v4u*)p; f[0] = bflo(w.x); f[1] = bfhi(w.x); f[2] = bflo(w.y); f[3] = bfhi(w.y); f[4] = bflo(w.z); f[5] = bfhi(w.z); f[6] = bflo(w.w); f[7] = bfhi(w.w); }
__device__ __forceinline__ void load8f(const float* p, float (&f)[8]) { const f32x4 a = *(const GAS f32x4*)p, b = *(const GAS f32x4*)(p + 4); f[0] = a.x; f[1] = a.y; f[2] = a.z; f[3] = a.w; f[4] = b.x; f[5] = b.y; f[6] = b.z; f[7] = b.w; }
__device__ __forceinline__ void acc8(const v4u w, float (&s)[8]) { s[0] += bflo(w.x); s[1] += bfhi(w.x); s[2] += bflo(w.y); s[3] += bfhi(w.y); s[4] += bflo(w.z); s[5] += bfhi(w.z); s[6] += bflo(w.w); s[7] += bfhi(w.w); }
__device__ __forceinline__ void mixer_stage_wp(LAS unsigned char* lds, const bf16* WPt, int wave, int lane) {
    const GAS char* gb = (const GAS char*)WPt + (size_t)wave * 16384;
    const unsigned rl4 = (unsigned)lane >> 4, l15 = (unsigned)lane & 15u;
#pragma unroll
    for (int n = 0; n < 16; ++n) { const unsigned rl = 4u * n + rl4;
        __builtin_amdgcn_global_load_lds((const GAS unsigned*)(gb + rl * 256u + ((l15 ^ (rl & 15u)) << 4)), (LAS unsigned*)(lds + (wave * 16 + n) * 1024), 16, 0, 0); }
}
__device__ __forceinline__ unsigned off_b(unsigned row, unsigned ch) { return 256u * row + 16u * (ch ^ (((row & 3u) << 2) | ((row >> 2) & 3u))); }
template <int GI> __device__ __forceinline__ void pool_issue(const Args& a, LAS unsigned char* tile, int row0, int nblk, bool sample, int lane) {
    constexpr int W = 2 << GI;
    const unsigned fr = lane & 15, fq = lane >> 4;
    const int nrows = 16 * nblk + W - 1, t0 = sample ? 0 : (row0 & 4095), sb = (row0 >> 4) & 15;
    const GAS char* wsb = (const GAS char*)a.ws;
#pragma unroll
    for (int n = 0; n < 16; ++n) if (n < 4 * nblk + 4) {
        const int r = 4 * n + (int)fq, tt = t0 - (W - 1) + r;
        unsigned o;
        if (r >= nrows) o = (unsigned)WS_ZERO;
        else if (tt >= 0) o = (unsigned)WS_P1 + (unsigned)(row0 - (W - 1) + r) * 3072u + (unsigned)(GI * 256);
        else o = sample ? (unsigned)WS_HISTU + (unsigned)(sb * 15 + 15 + tt) * 1024u + (unsigned)(GI * 256) : (unsigned)WS_ZERO;
        const unsigned lc = fr ^ ((fq << 2) | (unsigned)(n & 3));
        __builtin_amdgcn_global_load_lds((const GAS unsigned*)(wsb + o + (lc << 4)), (LAS unsigned*)(tile + n * 1024), 16, 0, 0); }
}
template <int GI> __device__ __forceinline__ void pool_compute(const Args& a, LAS unsigned char* lds, LAS unsigned char* tile, int row0, int nblk, bool sample, int lane) {
    constexpr int W = 2 << GI;
    const int fr = lane & 15, fq = lane >> 4;
    bf16x8 wf[4][8];
    { const bf16* wp = (const bf16*)(a.ws + WS_WP) + GI * 16384 + (size_t)fr * 128 + fq * 8;
#pragma unroll
      for (int ks = 0; ks < 4; ++ks)
#pragma unroll
          for (int db = 0; db < 8; ++db) wf[ks][db] = *(const GAS bf16x8*)(wp + db * 2048 + ks * 32); }
    const unsigned tb = (unsigned)(size_t)tile, qq = (unsigned)(lane & 15) >> 2, pp = (unsigned)lane & 3u;
    bf16x8 cfg;
    { float cw[8]; int fr_ = fr, r8 = 8 * fq; asm volatile("" : "+v"(fr_), "+v"(r8));
#pragma unroll
      for (int jj = 0; jj < 8; ++jj) { const int r = r8 + jj; cw[jj] = ((r >= fr_ && r <= fr_ + W - 1) ? (1.f / W) : 0.f) - (r == fr_ + W - 1 ? 1.f : 0.f); }
      v4u pc; pc.x = pk2(cw[0], cw[1]); pc.y = pk2(cw[2], cw[3]); pc.z = pk2(cw[4], cw[5]); pc.w = pk2(cw[6], cw[7]); cfg = __builtin_bit_cast(bf16x8, pc); }
    asm volatile("s_waitcnt vmcnt(0)" ::: "memory");
#pragma unroll 1
    for (int i = 0; i < nblk; ++i) {
        const int row = row0 + 16 * i + fr, t = sample ? fr : (row & 4095);
        const float inv = sample ? (1.f / W) : 1.f / (float)(t + 1 < W ? t + 1 : W);
        bf16x8 cf = cfg;
        if (!sample && ((row0 + 16 * i) & 4095) == 0) {
          float cw[8];
          int fr_ = fr, r8 = 8 * fq; asm volatile("" : "+v"(fr_), "+v"(r8));
#pragma unroll
          for (int jj = 0; jj < 8; ++jj) { const int r = r8 + jj; cw[jj] = ((r >= fr_ && r <= fr_ + W - 1) ? inv : 0.f) - (r == fr_ + W - 1 ? 1.f : 0.f); }
          v4u pc; pc.x = pk2(cw[0], cw[1]); pc.y = pk2(cw[2], cw[3]); pc.z = pk2(cw[4], cw[5]); pc.w = pk2(cw[6], cw[7]); cf = __builtin_bit_cast(bf16x8, pc); }
        v4u pa[4];
#pragma unroll
        for (int cb = 0; cb < 8; cb += 2) {
            unsigned ad[4];
#pragma unroll
            for (int k = 0; k < 4; ++k) { const unsigned c_ = cb + (k >> 1), tt = k & 1; ad[k] = tb + 4096u * i + off_b(8u * fq + 4u * tt + qq, 2u * c_ + (pp >> 1)) + 8u * (pp & 1u); }
            v2u r0, r1, r2, r3;
            asm volatile("ds_read_b64_tr_b16 %0, %4\n\tds_read_b64_tr_b16 %1, %5\n\tds_read_b64_tr_b16 %2, %6\n\tds_read_b64_tr_b16 %3, %7\n\ts_waitcnt lgkmcnt(0)"
                         : "=&v"(r0), "=&v"(r1), "=&v"(r2), "=&v"(r3) : "v"(ad[0]), "v"(ad[1]), "v"(ad[2]), "v"(ad[3]) : "memory");
            v4u f0; f0.x = r0.x; f0.y = r0.y; f0.z = r1.x; f0.w = r1.y;
            v4u f1; f1.x = r2.x; f1.y = r2.y; f1.z = r3.x; f1.w = r3.y;
            const pg8::f32x4 p0 = __builtin_amdgcn_mfma_f32_16x16x32_bf16(__builtin_bit_cast(bf16x8, f0), cf, (pg8::f32x4){0.f, 0.f, 0.f, 0.f}, 0, 0, 0);
            const pg8::f32x4 p1 = __builtin_amdgcn_mfma_f32_16x16x32_bf16(__builtin_bit_cast(bf16x8, f1), cf, (pg8::f32x4){0.f, 0.f, 0.f, 0.f}, 0, 0, 0);
            pa[cb >> 1].x = pk2c(p0[0], p0[1]); pa[cb >> 1].y = pk2c(p0[2], p0[3]); pa[cb >> 1].z = pk2c(p1[0], p1[1]); pa[cb >> 1].w = pk2c(p1[2], p1[3]);
        }
        pg8::f32x4 acc[8];
#pragma unroll
        for (int db = 0; db < 8; ++db) acc[db] = (pg8::f32x4){0.f, 0.f, 0.f, 0.f};
#pragma unroll
        for (int ks = 0; ks < 4; ++ks) { const bf16x8 pf = __builtin_bit_cast(bf16x8, pa[ks]);
#pragma unroll
            for (int db = 0; db < 8; ++db) acc[db] = __builtin_amdgcn_mfma_f32_16x16x32_bf16(wf[ks][db], pf, acc[db], 0, 0, 0); }
        float ss = 0.f;
#pragma unroll
        for (int db = 0; db < 8; ++db) ss += (acc[db][0] * acc[db][0] + acc[db][1] * acc[db][1]) + (acc[db][2] * acc[db][2] + acc[db][3] * acc[db][3]);
        ss += __shfl_xor(ss, 16); ss += __shfl_xor(ss, 32);
        const float rs = 1.f / sqrtf(ss * (1.f / 128.f) + EPS);
        bf16* MRG = (bf16*)(a.ws + WS_MRG);
#pragma unroll
        for (int db = 0; db < 8; ++db) { const f32x4 o = acc[db] * rs;
            v2u w; w.x = pk2(o[0], o[1]); w.y = pk2(o[2], o[3]); *(GAS v2u*)(MRG + (size_t)row * D + GI * 128 + 16 * db + 4 * fq) = w; }
    }
}
__device__ __forceinline__ f32x2 up2(unsigned w) { f32x2 r; r.x = bflo(w); r.y = bfhi(w); return r; }
__device__ __forceinline__ unsigned pk2v(f32x2 v) { const bf16n2 b = __builtin_convertvector(v, bf16n2); return __builtin_bit_cast(unsigned, b); }
template <int CTRL> __device__ __forceinline__ float dpp_f(float v) { return __builtin_bit_cast(float, __builtin_amdgcn_update_dpp(0, __builtin_bit_cast(int, v), CTRL, 0xf, 0xf, true)); }
__device__ __forceinline__ void conv_half(const Args& a, int row0, int half, bool sample, int lane) {
    const bf16* P1 = (const bf16*)(a.ws + WS_P1); bf16* MRG = (bf16*)(a.ws + WS_MRG);
    const int ch = 8 * lane, i0 = 8 * half;
    const bf16* histv = sample ? (const bf16*)(a.ws + WS_HISTV) + (size_t)(((row0 >> 4) & 15) * 2 + 2) * 512 : (const bf16*)(a.ws + WS_ZERO);
    const int hstep = sample ? 512 : 0, t0 = sample ? 0 : (row0 & 4095);
    v4u xv[10], xb[8];
#pragma unroll
    for (int k = 0; k < 10; ++k) { const int i = i0 + k - 2; const bf16* p = (t0 + i >= 0) ? P1 + (size_t)(row0 + i) * 1536 + 1024 : histv + (ptrdiff_t)i * hstep; xv[k] = *(const GAS v4u*)(p + ch); }
#pragma unroll
    for (int k = 0; k < 8; ++k) xb[k] = *(const GAS v4u*)(P1 + (size_t)(row0 + i0 + k) * 1536 + 512 + ch);
    f32x2 w0[4], w1[4], w2[4];
#pragma unroll
    for (int q = 0; q < 4; ++q) { w0[q] = *(const GAS f32x2*)(a.in[11] + ch + 2 * q); w1[q] = *(const GAS f32x2*)(a.in[11] + 512 + ch + 2 * q); w2[q] = *(const GAS f32x2*)(a.in[11] + 1024 + ch + 2 * q); }
    f32x2 va[4], vb[4], vc[4];
#pragma unroll
    for (int q = 0; q < 4; ++q) { va[q] = up2(xv[0][q]); vb[q] = up2(xv[1][q]); }
#pragma unroll
    for (int k = 0; k < 8; ++k) {
        f32x2 y[4]; f32x2 s2 = {0.f, 0.f};
#pragma unroll
        for (int q = 0; q < 4; ++q) { vc[q] = up2(xv[k + 2][q]); const f32x2 bg = up2(xb[k][q]);
            f32x2 cv = w0[q] * va[q]; cv = __builtin_elementwise_fma(w1[q], vb[q], cv); cv = __builtin_elementwise_fma(w2[q], vc[q], cv);
            y[q] = bg * cv; s2 = __builtin_elementwise_fma(y[q], y[q], s2); }
        float ss = s2.x + s2.y;
        ss += dpp_f<0xB1>(ss); ss += dpp_f<0x4E>(ss); ss += dpp_f<0x141>(ss);
        const float rs = 1.f / sqrtf(ss * (1.f / 64.f) + EPS);
        v4u o;
#pragma unroll
        for (int q = 0; q < 4; ++q) { const f32x2 r2 = {rs, rs}; o[q] = pk2v(y[q] * r2); }
        *(GAS v4u*)(MRG + (size_t)(row0 + i0 + k) * D + 512 + ch) = o;
#pragma unroll
        for (int q = 0; q < 4; ++q) { va[q] = vb[q]; vb[q] = vc[q]; }
    }
}
__device__ __forceinline__ void unpack8(const v4u w, float (&f)[8]) { f[0] = bflo(w.x); f[1] = bfhi(w.x); f[2] = bflo(w.y); f[3] = bfhi(w.y); f[4] = bflo(w.z); f[5] = bfhi(w.z); f[6] = bflo(w.w); f[7] = bfhi(w.w); }
__device__ __forceinline__ int mixer_blk(int xg, int bl) { return xg < 0 ? bl : (bl < 128 ? xg * 128 + bl : 1024 + xg * 2 + (bl - 128)); }
template <int GI> __device__ __forceinline__ void mixer_wave(const Args& a, LAS unsigned char* lds, int xg, int j, int nj, int wave, int lane) {
    LAS unsigned char* tile = lds + wave * 16384;
    if (xg >= 0 && nj == 56) {
        int bl0 = -1, nblk = 0;
        if (j < 42) { bl0 = 3 * j; nblk = 3; } else if (j == 42) { bl0 = 126; nblk = 2; } else if (j < 45) { bl0 = 128 + (j - 43); nblk = 1; }
        const int row0 = bl0 >= 0 ? mixer_blk(xg, bl0) * 16 : 0; const bool sample = row0 >= MP;
        if (nblk) pool_issue<GI>(a, tile, row0, nblk, sample, lane);
        int c0 = -1, c1 = -1;
        if (j >= 45) { c0 = 2 * (j - 45); c1 = c0 + 1; } else if (j <= 42) c0 = 22 + j;
        if (c0 >= 0) { const int h = 4 * c0 + GI, r0 = mixer_blk(xg, h >> 1) * 16; conv_half(a, r0, h & 1, r0 >= MP, lane); }
        if (c1 >= 0) { const int h = 4 * c1 + GI, r0 = mixer_blk(xg, h >> 1) * 16; conv_half(a, r0, h & 1, r0 >= MP, lane); }
        asm volatile("" ::: "memory");
        if (nblk) pool_compute<GI>(a, lds, tile, row0, nblk, sample, lane);
    } else {
        const int nb = xg >= 0 ? 130 : M / 16;
        for (int bl = j; bl < nb; bl += nj) { const int row0 = mixer_blk(xg, bl) * 16;
            pool_issue<GI>(a, tile, row0, 1, row0 >= MP, lane); pool_compute<GI>(a, lds, tile, row0, 1, row0 >= MP, lane); }
        for (int h = j * 4 + GI; h < 2 * nb; h += nj * 4) { const int r0 = mixer_blk(xg, h >> 1) * 16; conv_half(a, r0, h & 1, r0 >= MP, lane); }
    }
}
__device__ __forceinline__ void mixer_all(const Args& a, LAS unsigned char* lds, int xg, int cu, int ncu, int wave, int lane_) {
    int lane = lane_; asm volatile("" : "+v"(lane));
    const int gi = wave & 3, j = cu * 2 + (wave >> 2), nj = ncu * 2;
    if (gi == 0) mixer_wave<0>(a, lds, xg, j, nj, wave, lane);
    else if (gi == 1) mixer_wave<1>(a, lds, xg, j, nj, wave, lane);
    else if (gi == 2) mixer_wave<2>(a, lds, xg, j, nj, wave, lane);
    else mixer_wave<3>(a, lds, xg, j, nj, wave, lane);
}

__device__ __forceinline__ void resid_row(const float* base, const float* raw, const float* g, float* xo, bf16* xn, int lane_) {
    int lane = lane_; asm volatile("" : "+v"(lane));
    const GAS f32x4* rr = (const GAS f32x4*)raw + lane; const GAS f32x4* bb = (const GAS f32x4*)base + lane; const GAS f32x4* gg = (const GAS f32x4*)g + lane;
    f32x4 v[4]; float s = 0.f;
#pragma unroll
    for (int j = 0; j < 4; ++j) { v[j] = rr[64 * j]; s += (v[j].x * v[j].x + v[j].y * v[j].y) + (v[j].z * v[j].z + v[j].w * v[j].w); }
    const float rs = 1.f / sqrtf(wave_sum(s) * (1.f / D) + EPS);
    float s2 = 0.f;
#pragma unroll
    for (int j = 0; j < 4; ++j) { v[j] = bb[64 * j] + v[j] * rs * gg[64 * j]; s2 += (v[j].x * v[j].x + v[j].y * v[j].y) + (v[j].z * v[j].z + v[j].w * v[j].w); }
    GAS f32x4* oo = (GAS f32x4*)xo + lane;
#pragma unroll
    for (int j = 0; j < 4; ++j) oo[64 * j] = v[j];
    if (xn) { const float r2 = 1.f / sqrtf(wave_sum(s2) * (1.f / D) + EPS); GAS v2u* o8 = (GAS v2u*)xn + lane;
#pragma unroll
        for (int j = 0; j < 4; ++j) { v2u w; w.x = pk2(v[j].x * r2, v[j].y * r2); w.y = pk2(v[j].z * r2, v[j].w * r2); o8[64 * j] = w; } }
}

#define MFMA32(a, b, c) __builtin_amdgcn_mfma_f32_32x32x16_bf16((a), (b), (c), 0, 0, 0)
__device__ __forceinline__ bf16x8 pack8(const f32x16& x, int s) {
    v4u p; p.x = pk2(x[8 * s], x[8 * s + 1]); p.y = pk2(x[8 * s + 2], x[8 * s + 3]); p.z = pk2(x[8 * s + 4], x[8 * s + 5]); p.w = pk2(x[8 * s + 6], x[8 * s + 7]);
    return __builtin_bit_cast(bf16x8, p);
}
__device__ __forceinline__ void attn_stage(LAS unsigned char* lds, const bf16* G, unsigned pitch  , int wave, int lane) {
    const GAS char* gb = (const GAS char*)G + (size_t)wave * 32 * pitch;
    const unsigned hi = (unsigned)lane >> 5, l31 = (unsigned)lane & 31u;
#pragma unroll
    for (int n = 0; n < 16; ++n) { const unsigned rl = 2u * n + hi;
        const unsigned off = rl * pitch + ((l31 ^ (rl & 15u)) << 4);
        __builtin_amdgcn_global_load_lds((const GAS unsigned*)(gb + off), (LAS unsigned*)(lds + (wave * 16 + n) * 1024), 16, 0, 0); }
}
__device__ __forceinline__ void attn_unit(LAS unsigned char* lds, const bf16* Qb, bf16* Ob, unsigned qoff, const bf16* Kg, const bf16* VTg, bool store, int wave, int lane_) {
    int lane = lane_; asm volatile("" : "+v"(lane));
    const int r = lane & 31, h = lane >> 5;
    attn_stage(lds, Kg, 2048u, wave, lane);
    const GAS char* qp = (const GAS char*)Qb;
    const unsigned qo = qoff + 16u * h;
    const unsigned x = (unsigned)(h ^ (r & 15));
    const LAS unsigned char* fo[8]; const LAS unsigned char* fo2[8];
#pragma unroll
    for (int k = 0; k < 8; ++k) { fo[k] = lds + ((unsigned)r * 512u + (((unsigned)(2 * k) ^ x) * 16u)); fo2[k] = fo[k] + 65536; asm volatile("" : "+v"(fo2[k])); }
    bf16x8 qf[8];
#pragma unroll
    for (int k = 0; k < 8; ++k) qf[k] = *(const GAS bf16x8*)(qp + qo + 32 * k);
    asm volatile("s_waitcnt vmcnt(0)" ::: "memory"); __syncthreads();
    f32x16 s[8];
#pragma unroll
    for (int mb = 0; mb < 8; ++mb)
#pragma unroll
        for (int i = 0; i < 16; ++i) s[mb][i] = 0.f;
#pragma unroll
    for (int hf = 0; hf < 2; ++hf) {
        if (hf == 1) {
#pragma unroll
            for (int k = 0; k < 8; ++k) qf[k] = *(const GAS bf16x8*)(qp + qo + 256 + 32 * k);
        }
        bf16x8 kc[8], kn[8];
#pragma unroll
        for (int k = 0; k < 8; ++k) kc[k] = *(const LAS bf16x8*)(fo[k] + hf * 256);
#pragma unroll
        for (int mb = 0; mb < 8; ++mb) {
            if (mb < 7) {
#pragma unroll
                for (int k = 0; k < 8; ++k) kn[k] = *(const LAS bf16x8*)((mb + 1 < 4 ? fo[k] : fo2[k]) + (((mb + 1) & 3) * 16384 + hf * 256)); }
            __builtin_amdgcn_s_setprio(1);
#pragma unroll
            for (int k = 0; k < 8; ++k) s[mb] = MFMA32(kc[k], qf[k], s[mb]);
            __builtin_amdgcn_s_setprio(0);
#pragma unroll
            for (int k = 0; k < 8; ++k) kc[k] = kn[k];
            asm volatile("" ::: "memory");
        }
    }
    asm volatile("s_waitcnt lgkmcnt(0)" ::: "memory"); __syncthreads();
    { int lane2 = lane; asm volatile("" : "+v"(lane2)); attn_stage(lds, VTg, 512u, wave, lane2); }
    float mx = -3.0e38f;
#pragma unroll
    for (int mb = 0; mb < 8; ++mb)
#pragma unroll
        for (int i = 0; i < 16; ++i) mx = fmaxf(mx, s[mb][i]);
    mx = fmaxf(mx, __shfl_xor(mx, 32));
    float sum = 0.f;
#pragma unroll
    for (int mb = 0; mb < 8; ++mb)
#pragma unroll
        for (int i = 0; i < 16; ++i) { const float p = __builtin_amdgcn_exp2f((s[mb][i] - mx) * 1.44269504089f); s[mb][i] = p; sum += p; }
    sum += __shfl_xor(sum, 32);
    const float inv = 1.f / sum;
    bf16x8 pf[8][2];
#pragma unroll
    for (int mb = 0; mb < 8; ++mb) { pf[mb][0] = pack8(s[mb], 0); pf[mb][1] = pack8(s[mb], 1); }
    asm volatile("s_waitcnt vmcnt(0)" ::: "memory"); __syncthreads();
    GAS char* op = (GAS char*)Ob;
    bf16x8 vc[8], vn[8];
#pragma unroll
    for (int k = 0; k < 8; ++k) vc[k] = *(const LAS bf16x8*)(fo[k]);
#pragma unroll
    for (int eb = 0; eb < 8; ++eb) {
        f32x16 o;
#pragma unroll
        for (int i = 0; i < 16; ++i) o[i] = 0.f;
#pragma unroll
        for (int hv = 0; hv < 2; ++hv) {
            const int nstep = 2 * eb + hv + 1;
            if (nstep < 16) { const int neb = nstep >> 1, nhv = nstep & 1;
#pragma unroll
                for (int k = 0; k < 8; ++k) vn[k] = *(const LAS bf16x8*)((neb < 4 ? fo[k] : fo2[k]) + ((neb & 3) * 16384 + nhv * 256)); }
            __builtin_amdgcn_s_setprio(1);
#pragma unroll
            for (int k = 0; k < 8; ++k) o = MFMA32(vc[k], pf[4 * hv + (k >> 1)][k & 1], o);
            __builtin_amdgcn_s_setprio(0);
#pragma unroll
            for (int k = 0; k < 8; ++k) vc[k] = vn[k];
            asm volatile("" ::: "memory");
        }
        if (store) {
#pragma unroll
            for (int g = 0; g < 4; ++g) { v2u w; w.x = pk2(o[4 * g] * inv, o[4 * g + 1] * inv); w.y = pk2(o[4 * g + 2] * inv, o[4 * g + 3] * inv);
                *(GAS v2u*)(op + qoff + 8u * h + (64 * eb + 16 * g)) = w; }
        }
    }
    asm volatile("s_waitcnt lgkmcnt(0)" ::: "memory"); __syncthreads();
}

__device__ __forceinline__ void attn_unit_small(LAS unsigned char* lds, const bf16* Qb, bf16* Ob, const bf16* Kg, const bf16* VTg, int wave, int lane_) {
    int lane = lane_; asm volatile("" : "+v"(lane));
    const int r = lane & 31, h = lane >> 5;
    const GAS char* qp = (const GAS char*)Qb; const GAS char* kp = (const GAS char*)Kg + (size_t)wave * 65536; const GAS char* vp = (const GAS char*)VTg + (size_t)wave * 16384;
    const unsigned qo = (unsigned)(r & 15) * 2048u + 16u * h, ko = (unsigned)r * 2048u + 16u * h, vo = (unsigned)r * 512u + 16u * h;
    bf16x8 qf[16], kf[16], vf[16];
#pragma unroll
    for (int ks = 0; ks < 16; ++ks) { qf[ks] = *(const GAS bf16x8*)(qp + qo + 32 * ks); kf[ks] = *(const GAS bf16x8*)(kp + ko + 32 * ks); }
#pragma unroll
    for (int c = 0; c < 16; ++c) vf[c] = *(const GAS bf16x8*)(vp + vo + 32 * c);
    f32x16 s;
#pragma unroll
    for (int i = 0; i < 16; ++i) s[i] = 0.f;
#pragma unroll
    for (int ks = 0; ks < 16; ++ks) s = MFMA32(kf[ks], qf[ks], s);
    LAS float* red = (LAS float*)lds;
    LAS unsigned char* pbuf = lds + 4096;
    float mx = s[0];
#pragma unroll
    for (int i = 1; i < 16; ++i) mx = fmaxf(mx, s[i]);
    mx = fmaxf(mx, __shfl_xor(mx, 32));
    if (h == 0) red[wave * 32 + r] = mx;
    asm volatile("s_waitcnt lgkmcnt(0)" ::: "memory"); __syncthreads();
#pragma unroll
    for (int w = 0; w < 8; ++w) mx = fmaxf(mx, red[w * 32 + r]);
    float sum = 0.f;
#pragma unroll
    for (int i = 0; i < 16; ++i) { const float p = __builtin_amdgcn_exp2f((s[i] - mx) * 1.44269504089f); s[i] = p; sum += p; }
    sum += __shfl_xor(sum, 32);
    if (h == 0) red[256 + wave * 32 + r] = sum;
    *(LAS bf16x8*)(pbuf + (wave * 2 + 0) * 1024 + lane * 16) = pack8(s, 0);
    *(LAS bf16x8*)(pbuf + (wave * 2 + 1) * 1024 + lane * 16) = pack8(s, 1);
    asm volatile("s_waitcnt lgkmcnt(0)" ::: "memory"); __syncthreads();
    float tot = 0.f;
#pragma unroll
    for (int w = 0; w < 8; ++w) tot += red[256 + w * 32 + r];
    const float inv = 1.f / tot;
    f32x16 o;
#pragma unroll
    for (int i = 0; i < 16; ++i) o[i] = 0.f;
#pragma unroll
    for (int c = 0; c < 16; ++c) { const bf16x8 pf = *(const LAS bf16x8*)(pbuf + c * 1024 + lane * 16); o = MFMA32(vf[c], pf, o); }
    if (r < 16) { GAS char* op = (GAS char*)Ob + (unsigned)r * 2048u + 8u * h + 64u * wave;
#pragma unroll
        for (int g = 0; g < 4; ++g) { v2u w2; w2.x = pk2(o[4 * g] * inv, o[4 * g + 1] * inv); w2.y = pk2(o[4 * g + 2] * inv, o[4 * g + 3] * inv); *(GAS v2u*)(op + 16 * g) = w2; } }
    asm volatile("s_waitcnt lgkmcnt(0)" ::: "memory"); __syncthreads();
}

template <int NT, int KCH>
__device__ __forceinline__ void micro_gemm(LAS unsigned char* lds, const bf16* A, int lda, const bf16* Bt, int ldb, const int (&cb)[NT], int wave, int lane_, int tid_, float (&val)[NT][2]) {
    int lane = lane_, tid = tid_; asm volatile("" : "+v"(lane), "+v"(tid));
    constexpr int KB = (KCH > 8 && NT == 1) ? 16 : 8;
    const int r = lane & 31, h = lane >> 5;
    const GAS char* ap = (const GAS char*)A; const GAS char* bp = (const GAS char*)Bt;
    const unsigned ao = ((unsigned)r * lda + wave * (KCH * 16) + 8 * h) * 2u, bo = ((unsigned)r * ldb + wave * (KCH * 16) + 8 * h) * 2u;
    f32x16 acc[NT];
#pragma unroll
    for (int nt = 0; nt < NT; ++nt)
#pragma unroll
        for (int i = 0; i < 16; ++i) acc[nt][i] = 0.f;
#pragma unroll 1
    for (int kc = 0; kc < KCH; kc += KB) {
        bf16x8 af[KB], bfr[NT][KB];
#pragma unroll
        for (int i = 0; i < KB; ++i) af[i] = *(const GAS bf16x8*)(ap + ao + (kc + i) * 32);
#pragma unroll
        for (int nt = 0; nt < NT; ++nt)
#pragma unroll
            for (int i = 0; i < KB; ++i) bfr[nt][i] = *(const GAS bf16x8*)(bp + (size_t)cb[nt] * ldb * 2 + bo + (kc + i) * 32);
#pragma unroll
        for (int nt = 0; nt < NT; ++nt)
#pragma unroll
            for (int i = 0; i < KB; ++i) acc[nt] = MFMA32(af[i], bfr[nt][i], acc[nt]);
    }
    LAS float* part = (LAS float*)lds;
#pragma unroll
    for (int nt = 0; nt < NT; ++nt)
#pragma unroll
        for (int i = 0; i < 16; ++i) part[(wave * NT + nt) * 1024 + ((i & 3) + 8 * (i >> 2) + 4 * h) * 32 + r] = acc[nt][i];
    __syncthreads();
#pragma unroll
    for (int nt = 0; nt < NT; ++nt) { float s0 = 0.f, s1 = 0.f;
#pragma unroll
        for (int w = 0; w < 8; ++w) { const f32x2 p = *(const LAS f32x2*)(part + (w * NT + nt) * 1024 + 2 * tid); s0 += p.x; s1 += p.y; }
        val[nt][0] = s0; val[nt][1] = s1; }
}
__device__ __forceinline__ void micro_gemm_lds(LAS unsigned char* lds, const bf16* A, int lda, const bf16* Bt, int ldb, int cb0, int wave, int lane_, int tid_, float (&val)[1][2]) {
    int lane = lane_, tid = tid_; asm volatile("" : "+v"(lane), "+v"(tid));
    const int r = lane & 31, h = lane >> 5;
    LAS unsigned char* reg = lds + wave * 16384;
    __syncthreads();
    { const unsigned rq = (unsigned)lane >> 4, pc = (unsigned)lane & 15u;
      const GAS char* ap = (const GAS char*)A + wave * 256; const GAS char* bp = (const GAS char*)(Bt + (size_t)cb0 * ldb) + wave * 256;
#pragma unroll
      for (int n = 0; n < 8; ++n) { const unsigned row = 4u * n + rq, lc = pc ^ (row & 15u);
          __builtin_amdgcn_global_load_lds((const GAS unsigned*)(ap + row * (unsigned)(lda * 2) + lc * 16u), (LAS unsigned*)(reg + n * 1024), 16, 0, 0); }
#pragma unroll
      for (int n = 0; n < 8; ++n) { const unsigned row = 4u * n + rq, lc = pc ^ (row & 15u);
          __builtin_amdgcn_global_load_lds((const GAS unsigned*)(bp + row * (unsigned)(ldb * 2) + lc * 16u), (LAS unsigned*)(reg + 8192 + n * 1024), 16, 0, 0); } }
    f32x16 acc;
#pragma unroll
    for (int i = 0; i < 16; ++i) acc[i] = 0.f;
    const LAS unsigned char* fa = reg + r * 256; const unsigned x = (unsigned)(r & 15);
    asm volatile("s_waitcnt vmcnt(0)" ::: "memory");
    bf16x8 af[8], bfr[8];
#pragma unroll
    for (int i = 0; i < 8; ++i) { const unsigned pcx = ((unsigned)(2 * i + h) ^ x) * 16u; af[i] = *(const LAS bf16x8*)(fa + pcx); bfr[i] = *(const LAS bf16x8*)(fa + 8192 + pcx); }
#pragma unroll
    for (int i = 0; i < 8; ++i) acc = MFMA32(af[i], bfr[i], acc);
    asm volatile("s_waitcnt lgkmcnt(0)" ::: "memory");
    LAS float* part = (LAS float*)reg;
#pragma unroll
    for (int i = 0; i < 16; ++i) part[((i & 3) + 8 * (i >> 2) + 4 * h) * 32 + r] = acc[i];
    __syncthreads();
    float s0 = 0.f, s1 = 0.f;
#pragma unroll
    for (int w = 0; w < 8; ++w) { const f32x2 p = *(const LAS f32x2*)((const LAS float*)(lds + w * 16384) + 2 * tid); s0 += p.x; s1 += p.y; }
    val[0][0] = s0; val[0][1] = s1;
}
__device__ __forceinline__ void micro_gemm_lds_k4096(LAS unsigned char* lds, const bf16* A, int lda, const bf16* Bt, int ldb, int cb0, int wave, int lane_, int tid_, float (&val)[1][2]) {
    int lane = lane_, tid = tid_; asm volatile("" : "+v"(lane), "+v"(tid));
    const int r = lane & 31, h = lane >> 5;
    LAS unsigned char* reg = lds + wave * 16384;
    __syncthreads();
    const unsigned rq = (unsigned)lane >> 3, pc = (unsigned)lane & 7u;
    const GAS char* ap = (const GAS char*)A + wave * 128; const GAS char* bp = (const GAS char*)(Bt + (size_t)cb0 * ldb) + wave * 128;
    unsigned ao[4], bo[4];
#pragma unroll
    for (int n = 0; n < 4; ++n) { const unsigned row = 8u * n + rq, lc = pc ^ ((row >> 1) & 7u); ao[n] = row * (unsigned)(lda * 2) + lc * 16u; bo[n] = row * (unsigned)(ldb * 2) + lc * 16u; }
#define MG4K_ISSUE(rd) do { LAS unsigned char* dst_ = reg + ((rd) & 1) * 8192; \
        _Pragma("unroll") for (int n = 0; n < 4; ++n) __builtin_amdgcn_global_load_lds((const GAS unsigned*)(ap + (rd) * 1024 + ao[n]), (LAS unsigned*)(dst_ + n * 1024), 16, 0, 0); \
        _Pragma("unroll") for (int n = 0; n < 4; ++n) __builtin_amdgcn_global_load_lds((const GAS unsigned*)(bp + (rd) * 1024 + bo[n]), (LAS unsigned*)(dst_ + 4096 + n * 1024), 16, 0, 0); } while (0)
    f32x16 acc;
#pragma unroll
    for (int i = 0; i < 16; ++i) acc[i] = 0.f;
    const unsigned x = (unsigned)(r >> 1) & 7u;
    MG4K_ISSUE(0);
#pragma unroll
    for (int rd = 0; rd < 8; ++rd) {
        if (rd < 7) { MG4K_ISSUE(rd + 1); asm volatile("s_waitcnt vmcnt(8)" ::: "memory"); } else asm volatile("s_waitcnt vmcnt(0)" ::: "memory");
        const LAS unsigned char* fa = reg + (rd & 1) * 8192 + r * 128;
        bf16x8 af[4], bfr[4];
#pragma unroll
        for (int i = 0; i < 4; ++i) { const unsigned pcx = ((unsigned)(2 * i + h) ^ x) * 16u; af[i] = *(const LAS bf16x8*)(fa + pcx); bfr[i] = *(const LAS bf16x8*)(fa + 4096 + pcx); }
#pragma unroll
        for (int i = 0; i < 4; ++i) acc = MFMA32(af[i], bfr[i], acc);
        asm volatile("s_waitcnt lgkmcnt(0)" ::: "memory");
    }
#undef MG4K_ISSUE
    LAS float* part = (LAS float*)reg;
#pragma unroll
    for (int i = 0; i < 16; ++i) part[((i & 3) + 8 * (i >> 2) + 4 * h) * 32 + r] = acc[i];
    __syncthreads();
    float s0 = 0.f, s1 = 0.f;
#pragma unroll
    for (int w = 0; w < 8; ++w) { const f32x2 p = *(const LAS f32x2*)((const LAS float*)(lds + w * 16384) + 2 * tid); s0 += p.x; s1 += p.y; }
    val[0][0] = s0; val[0][1] = s1;
}
__device__ __forceinline__ void sample_gemm1_piece(const Args& a, LAS unsigned char* lds, int p, int wave, int lane, int tid_) {
    int tid = tid_; asm volatile("" : "+v"(tid));
    const int rg = p & 7, cp = p >> 3; int cb[2];
    if (cp < 16) { cb[0] = 64 * cp; cb[1] = 64 * cp + 32; } else { const int q = cp - 16; cb[0] = 1024 + 256 * (q >> 2) + 32 * (q & 3); cb[1] = cb[0] + 128; }
    float val[2][2];
    micro_gemm<2, 8>(lds, (const bf16*)(a.ws + WS_XN) + (size_t)(MP + 32 * rg) * D, D, (const bf16*)(a.ws + WS_WIN), D, cb, wave, lane, tid, val);
    const int rs_ = 32 * rg + (tid >> 4), row = MP + rs_, t = rs_ & 15, sb = rs_ >> 4, c2 = 2 * (tid & 15);
    bf16* P1 = (bf16*)(a.ws + WS_P1) + (size_t)row * 1536;
    if (cp < 16) {
#pragma unroll
        for (int nt = 0; nt < 2; ++nt) { const int col = cb[nt] + c2; *(GAS unsigned*)(P1 + col) = pk2(val[nt][0], val[nt][1]);
            if (cp < 8 && t >= 1) *(GAS f32x2*)(a.out + OUT_POOL_S + (size_t)(sb * 15 + t - 1) * 512 + col) = (f32x2){val[nt][0], val[nt][1]}; }
    } else {
        const int ch = 32 * (cp - 16) + c2; const float v0 = val[0][0] * val[1][0], v1 = val[0][1] * val[1][1];
        *(GAS unsigned*)(P1 + 1024 + ch) = pk2(v0, v1);
        if (t >= 14) *(GAS f32x2*)(a.out + OUT_CONV_S + (size_t)(sb * 2 + t - 14) * 512 + ch) = (f32x2){v0, v1};
    }
    __syncthreads();
}
struct SampleX { unsigned* xbuf; unsigned* cnt; float* rsp; unsigned* tmo; };
template <int NT, int KCH, int MODE>
__device__ __forceinline__ void sample_gemm_piece(LAS unsigned char* lds, const bf16* A, int K, const bf16* Bt, bf16* C, int ldc, const float* rsp, int p, int wave, int lane, int tid_) {
    int tid = tid_; asm volatile("" : "+v"(tid));
    const int rg = p & 7, cp = p >> 3; int cb[NT];
#pragma unroll
    for (int nt = 0; nt < NT; ++nt) cb[nt] = 32 * NT * cp + 32 * nt;
    const int rl = 32 * rg + (tid >> 4); const size_t row = MP + rl; const int c2 = 2 * (tid & 15);
    f32x4 pr[8];
    if (rsp) { const GAS f32x4* pp = (const GAS f32x4*)(rsp + (size_t)rl * 32);
#pragma unroll
        for (int k = 0; k < 8; ++k) pr[k] = pp[k]; }
    float val[NT][2];
    if constexpr (NT == 1 && KCH == 8) micro_gemm_lds(lds, A + (size_t)(MP + 32 * rg) * K, K, Bt, K, cb[0], wave, lane, tid, val);
    else micro_gemm<NT, KCH>(lds, A + (size_t)(MP + 32 * rg) * K, K, Bt, K, cb, wave, lane, tid, val);
    float rs = 1.f;
    if (rsp) { f32x4 t = pr[0];
#pragma unroll
        for (int k = 1; k < 8; ++k) t = t + pr[k];
        rs = 1.f / sqrtf(((t[0] + t[1]) + (t[2] + t[3])) * (1.f / D) + EPS); }
#pragma unroll
    for (int nt = 0; nt < NT; ++nt) {
        float v0 = val[nt][0] * rs, v1 = val[nt][1] * rs;
        if (MODE == 2) { v0 = fmaxf(v0, 0.f); v0 *= v0; v1 = fmaxf(v1, 0.f); v1 *= v1; }
        *(GAS unsigned*)(C + row * ldc + cb[nt] + c2) = pk2(v0, v1);
    }
    __syncthreads();
}
template <int KCH>
__device__ __forceinline__ void sample_fused_A(LAS unsigned char* lds, const bf16* A, int K, const bf16* Bt, const SampleX& sx, int p, int wave, int lane, int tid_) {
    int tid = tid_; asm volatile("" : "+v"(tid));
    const int rg = p & 7, cp = p >> 3; int cb[1] = {32 * cp};
    float val[1][2];
    if constexpr (KCH == 8) micro_gemm_lds(lds, A + (size_t)(MP + 32 * rg) * K, K, Bt, K, cb[0], wave, lane, tid, val);
    else if constexpr (KCH == 32) micro_gemm_lds_k4096(lds, A + (size_t)(MP + 32 * rg) * K, K, Bt, K, cb[0], wave, lane, tid, val);
    else micro_gemm<1, KCH>(lds, A + (size_t)(MP + 32 * rg) * K, K, Bt, K, cb, wave, lane, tid, val);
    const int rl = 32 * rg + (tid >> 4);
    float s = val[0][0] * val[0][0] + val[0][1] * val[0][1];
    s += __shfl_xor(s, 1); s += __shfl_xor(s, 2); s += __shfl_xor(s, 4); s += __shfl_xor(s, 8);
    if ((tid & 15) == 0) __hip_atomic_store(sx.xbuf + (size_t)rl * 32 + cp, __float_as_uint(s), __ATOMIC_RELAXED, __HIP_MEMORY_SCOPE_AGENT);
    *(LAS f32x2*)(lds + STASH_OFF + tid * 8) = (f32x2){val[0][0], val[0][1]};
    asm volatile("s_waitcnt vmcnt(0) lgkmcnt(0)" ::: "memory"); __syncthreads();
    if (tid == 0) __hip_atomic_fetch_add(sx.cnt + 64 * rg, 1u, __ATOMIC_RELAXED, __HIP_MEMORY_SCOPE_AGENT);
}
template <bool FINAL>
__device__ __forceinline__ void sample_fused_B(LAS unsigned char* lds, const float* base, const float* g, float* Y, bf16* X, const SampleX& sx, int p, int wave, int lane, int tid_) {
    int tid = tid_; asm volatile("" : "+v"(tid));
    const int rg = p & 7, cp = p >> 3;
    const int rl = 32 * rg + (tid >> 4); const int col = 32 * cp + 2 * (tid & 15);
    const f32x2 bs = *(const GAS f32x2*)(base + (size_t)rl * D + col), gv = *(const GAS f32x2*)(g + col);
    if (wave == 0) { unsigned sp = 0;
        while ((unsigned)__builtin_amdgcn_readfirstlane(__hip_atomic_load(sx.cnt + 64 * rg, __ATOMIC_RELAXED, __HIP_MEMORY_SCOPE_AGENT)) < 32u) {
            __builtin_amdgcn_s_sleep(2);
            if ((++sp & 1023u) == 0u) { if (__hip_atomic_load(sx.tmo, __ATOMIC_RELAXED, __HIP_MEMORY_SCOPE_AGENT) != 0u) break; if (sp > (1u << 22)) { if (lane == 0) __hip_atomic_store(sx.tmo, 1u, __ATOMIC_RELAXED, __HIP_MEMORY_SCOPE_AGENT); break; } } }
        }
    __syncthreads();
    float tot = 0.f;
    { const unsigned* slot = sx.xbuf + (size_t)rl * 32;
#pragma unroll
      for (int k = 0; k < 32; ++k) tot += __uint_as_float(__hip_atomic_load(slot + k, __ATOMIC_RELAXED, __HIP_MEMORY_SCOPE_AGENT)); }
    const f32x2 val = *(const LAS f32x2*)(lds + STASH_OFF + tid * 8);
    const float rs = 1.f / sqrtf(tot * (1.f / D) + EPS);
    const float x0 = bs[0] + val[0] * rs * gv[0], x1 = bs[1] + val[1] * rs * gv[1];
    *(GAS f32x2*)(Y + (size_t)rl * D + col) = (f32x2){x0, x1};
    if (!FINAL) {
        *(GAS unsigned*)(X + (size_t)rl * D + col) = pk2(x0, x1);
        float q = x0 * x0 + x1 * x1;
        q += __shfl_xor(q, 1); q += __shfl_xor(q, 2); q += __shfl_xor(q, 4); q += __shfl_xor(q, 8);
        if ((tid & 15) == 0) sx.rsp[(size_t)rl * 32 + cp] = q;
    }
    __syncthreads();
}
template <int KCH, bool FINAL>
__device__ __forceinline__ void sample_fused_piece(LAS unsigned char* lds, const bf16* A, int K, const bf16* Bt, const float* base, const float* g, float* Y, bf16* X, const SampleX& sx, int p, int wave, int lane, int tid) {
    sample_fused_A<KCH>(lds, A, K, Bt, sx, p, wave, lane, tid);
    sample_fused_B<FINAL>(lds, base, g, Y, X, sx, p, wave, lane, tid);
}

__global__ void __launch_bounds__(NWAVES * 64, 2) enc_fwd(Args args) {
    extern __shared__ __attribute__((aligned(16))) unsigned char lds_raw[];
    LAS unsigned char* lds = (LAS unsigned char*)lds_raw;
    volatile LAS unsigned* MISC = (volatile LAS unsigned*)(lds + MISC_OFF);
    const int tid = threadIdx.x, lane = tid & 63, wave = __builtin_amdgcn_readfirstlane(tid >> 6);
    const int G = gridDim.x; const int bx = blockIdx.x; const int vcu = (G % 8 == 0) ? (bx % 8) * (G / 8) + bx / 8 : bx;
    const int gw = vcu * NWAVES + wave, NGW = G * NWAVES;
    unsigned char* ws = args.ws;
    unsigned* ctl = (unsigned*)(ws + WS_CTL);
    for (int u = tid; u < (LDS_BYTES - LDSCTL_OFF) / 4; u += NWAVES * 64) ((LAS unsigned*)(lds + LDSCTL_OFF))[u] = 0u;
    __syncthreads();
    XcdBarrier bar = xcd_barrier_post(ctl + CW_BAR, MISC + 8);
#define GRID_BAR() do { xcd_arrive(bar); xcd_wait(bar); } while (0)
    if (tid == 0) { unsigned* gp = ctl + CW_BAR + XB_GRP(bx & 7); const unsigned me = bar.x + 1u;
        const unsigned prev = atomicCAS(gp, 0u, me);
        if (prev != 0u && prev != me) __hip_atomic_store(ctl + CW_BAR + XB_MIS, 1u, __ATOMIC_RELAXED, __HIP_MEMORY_SCOPE_AGENT); }
    bf16* XN = (bf16*)(ws + WS_XN);
    float* Y = args.out + OUT_Y;

    p0_prologue(args, lds, gw, NGW, wave, lane);
    GRID_BAR();

    const bool localok = G == 256 && __hip_atomic_load(ctl + CW_BAR + XB_MIS, __ATOMIC_RELAXED, __HIP_MEMORY_SCOPE_AGENT) == 0u;
#define LOCAL_BAR() do { if (localok) xcd_local_barrier(bar); else GRID_BAR(); } while (0)
    if (bx & 1) for (int p = bx; p < 256; p += G) sample_gemm1_piece(args, lds, p, wave, lane, tid);
    { pg8::Gemm g{XN, (const bf16*)(ws + WS_WIN), MP, NIN, D}; pg8::StaticOrder S; S.init(MP, NIN, G, bx);
      pg8::Epi1 E{(bf16*)(ws + WS_P1), args.out + OUT_POOL_P, args.out + OUT_CONV_P, args.out + OUT_POOL_S, args.out + OUT_CONV_S};
      pg8::gemm_phase<pg8::Epi1, pg8::StaticOrder, true, true>(lds, g, S, E); }
    if (!(bx & 1)) for (int p = bx; p < 256; p += G) sample_gemm1_piece(args, lds, p, wave, lane, tid);
    GRID_BAR();

    if (bx < 32 && G > 32) {
      pg8::Gemm g{(const bf16*)(ws + WS_MN), (const bf16*)(ws + WS_WKV), 1024, 2048, D}; pg8::StaticOrder S; S.init(1024, 2048, 32, bx);
      pg8::EpiKV E{args.out + OUT_MK, args.out + OUT_MV, (bf16*)(ws + WS_KB), (bf16*)(ws + WS_VT)};
      pg8::gemm_phase<pg8::EpiKV, pg8::StaticOrder, true, true>(lds, g, S, E);
    } else {
      const int gw2 = (bx - 32) * NWAVES + wave, NGW2 = (G - 32) * NWAVES;
      if (G == 256) mixer_all(args, lds, bx & 7, (bx - 32) >> 3, 28, wave, lane);
      else mixer_all(args, lds, -1, bx - 32, G - 32, wave, lane);
      if (G == 256) { const int lw = ((bx - 32) >> 3) * NWAVES + wave, xg = bx & 7, NV = (180 + 2 * 44) * 8;
          if (lw < 180) p2_late(args, lds, lw * 8 + xg, NV, wave, lane);
          else { p2_late(args, lds, (180 + 2 * (lw - 180)) * 8 + xg, NV, wave, lane); p2_late(args, lds, (181 + 2 * (lw - 180)) * 8 + xg, NV, wave, lane); } }
      else { __syncthreads(); p2_late(args, lds, gw2, NGW2, wave, lane); }
    }
    GRID_BAR();

    bf16* SQO = (bf16*)(ws + WS_SQO) - (size_t)MP * D; bf16* SAO = (bf16*)(ws + WS_SAO) - (size_t)MP * D; bf16* SHID = (bf16*)(ws + WS_SHID) - (size_t)MP * FF;
    unsigned* tmo = ctl + CW_TMO;
    float* Ys = Y + (size_t)MP * D; bf16* XNs = XN + (size_t)MP * D;
    const SampleX sx0{(unsigned*)(ws + WS_SXB), ctl + CW_SSEAM, (float*)(ws + WS_SRSP), tmo};
    const SampleX sx1{(unsigned*)(ws + WS_SXB + 32768), ctl + CW_SSEAM + 512, (float*)(ws + WS_SRSP + 32768), tmo};
    const SampleX sx2{(unsigned*)(ws + WS_SXB + 65536), ctl + CW_SSEAM + 1024, nullptr, tmo};

    { pg8::Gemm g{(const bf16*)(ws + WS_MRG), (const bf16*)(ws + WS_WOUT), MP, D, D}; pg8::StaticOrder S; S.init(MP, D, G, bx);
      pg8::EpiRes<1> E{(const float*)(ws + WS_RNORM), XN, nullptr, args.in[15], (unsigned*)(ws + WS_XB1), ctl + CW_SEAM, (float*)(ws + WS_RSP1), tmo};
      if (G == 256) sample_fused_A<8>(lds, (const bf16*)(ws + WS_MRG), D, (const bf16*)(ws + WS_WOUT), sx0, bx, wave, lane, tid);
      pg8::gemm_phase<pg8::EpiRes<1>, pg8::StaticOrder, false, true>(lds, g, S, E); }
    if (G == 256) sample_fused_B<false>(lds, args.in[1], args.in[15], Ys, XNs, sx0, bx, wave, lane, tid);
    else for (int p = bx; p < 256; p += G) sample_fused_piece<8, false>(lds, (const bf16*)(ws + WS_MRG), D, (const bf16*)(ws + WS_WOUT), args.in[1], args.in[15], Ys, XNs, sx0, p, wave, lane, tid);
    LOCAL_BAR();
    if (bx & 1) for (int p = bx; p < 256; p += G) sample_gemm_piece<1, 8, 1>(lds, XN, D, (const bf16*)(ws + WS_WQ), SQO, D, sx0.rsp, p, wave, lane, tid);
    { pg8::Gemm g{XN, (const bf16*)(ws + WS_WQ), MP, D, D}; pg8::StaticOrder S; S.init(MP, D, G, bx);
      pg8::EpiBf16S<0, false> E{(bf16*)(ws + WS_QO), D, (const float*)(ws + WS_RSP1), nullptr};
      pg8::gemm_phase<pg8::EpiBf16S<0, false>, pg8::StaticOrder, true, true>(lds, g, S, E); }
    if (!(bx & 1)) for (int p = bx; p < 256; p += G) sample_gemm_piece<1, 8, 1>(lds, XN, D, (const bf16*)(ws + WS_WQ), SQO, D, sx0.rsp, p, wave, lane, tid);
    LOCAL_BAR();
    { const bf16* QO = (const bf16*)(ws + WS_QO); bf16* AO = (bf16*)(ws + WS_AO);
      pg8::StaticOrder SA; SA.init(MP, D, G, bx); pg8::Unit au;
      for (int i = 0; SA.next(i, au); ++i) {
          const int hd = au.pn, b = au.pm >> 4; const size_t qb = (size_t)(au.pm * 256 + wave * 32) * D + hd * 256;
          int ln = lane; asm volatile("" : "+v"(ln));
          attn_unit(lds, QO + qb, AO + qb, (unsigned)(ln & 31) * 2048u, (const bf16*)(ws + WS_KB) + (size_t)b * 256 * 1024 + hd * 256, (const bf16*)(ws + WS_VT) + (size_t)(b * 4 + hd) * 65536, true, wave, ln);
      } }
    if (G == 256 && bx >= 64) { int ln = lane; asm volatile("" : "+v"(ln));
        p0_items(args, (LAS float*)(lds + wave * 16384), DN_LO, DN_HI, (bx - 64) * NWAVES + wave, 192 * NWAVES, ln); }
    else if (G != 256) { int ln = lane; asm volatile("" : "+v"(ln)); p0_items(args, (LAS float*)(lds + wave * 16384), DN_LO, DN_HI, gw, NGW, ln); }
    for (int u = bx; u < 64; u += G) {
        const int sb = 2 * (u & 7) + (u >> 5), hd = (u >> 3) & 3; const size_t qb = (size_t)(MP + sb * 16) * D + hd * 256;
        attn_unit_small(lds, SQO + qb, SAO + qb, (const bf16*)(ws + WS_KBS) + (size_t)sb * 256 * 1024 + hd * 256, (const bf16*)(ws + WS_VTS) + (size_t)(sb * 4 + hd) * 65536, wave, lane);
    }
    GRID_BAR();
    { pg8::Gemm g{(const bf16*)(ws + WS_AO), (const bf16*)(ws + WS_WCO), MP, D, D}; pg8::StaticOrder S; S.init(MP, D, G, bx);
      pg8::EpiRes<2> E{nullptr, XN, nullptr, args.in[22], (unsigned*)(ws + WS_XB2), ctl + CW_SEAM + 4096, (float*)(ws + WS_RSP2), tmo};
      if (G == 256) sample_fused_A<8>(lds, SAO, D, (const bf16*)(ws + WS_WCO), sx1, bx, wave, lane, tid);
      pg8::gemm_phase<pg8::EpiRes<2>, pg8::StaticOrder, false, true>(lds, g, S, E); }
    if (G == 256) sample_fused_B<false>(lds, Ys, args.in[22], Ys, XNs, sx1, bx, wave, lane, tid);
    else for (int p = bx; p < 256; p += G) sample_fused_piece<8, false>(lds, SAO, D, (const bf16*)(ws + WS_WCO), Ys, args.in[22], Ys, XNs, sx1, p, wave, lane, tid);
    LOCAL_BAR();
    if (bx & 1) for (int p = bx; p < 256; p += G) sample_gemm_piece<4, 8, 2>(lds, XN, D, (const bf16*)(ws + WS_WUP), SHID, FF, sx1.rsp, p, wave, lane, tid);
    { pg8::Gemm g{XN, (const bf16*)(ws + WS_WUP), MP, FF, D}; pg8::StaticOrder S; S.init(MP, FF, G, bx);
      LAS float* rstab = (LAS float*)(lds + RSTAB_OFF);
      { pg8::Unit u0; if (S.next(0, u0) && tid < 256) { const f32x4 p = *(const GAS f32x4*)((const float*)(ws + WS_RSP2) + (size_t)(u0.pm * 256 + tid) * 4);
            rstab[tid] = 1.0f / sqrtf(((p[0] + p[1]) + (p[2] + p[3])) * (1.0f / 1024.0f) + EPS); } }
      __syncthreads();
      pg8::EpiBf16S<1, true> E{(bf16*)(ws + WS_HID), FF, (const float*)(ws + WS_RSP2), rstab};
      pg8::gemm_phase<pg8::EpiBf16S<1, true>, pg8::StaticOrder, true, true>(lds, g, S, E); }
    if (!(bx & 1)) for (int p = bx; p < 256; p += G) sample_gemm_piece<4, 8, 2>(lds, XN, D, (const bf16*)(ws + WS_WUP), SHID, FF, sx1.rsp, p, wave, lane, tid);
    LOCAL_BAR();
    { pg8::Gemm g{(const bf16*)(ws + WS_HID), (const bf16*)(ws + WS_WDOWN), MP, D, FF}; pg8::StaticOrder S; S.init(MP, D, G, bx);
      pg8::EpiRes<3> E{nullptr, XN, Y, args.in[26], (unsigned*)(ws + WS_XB3), ctl + CW_SEAM + 8192, nullptr, tmo};
      if (G == 256 && (bx & 1)) sample_fused_A<32>(lds, SHID, FF, (const bf16*)(ws + WS_WDOWN), sx2, bx, wave, lane, tid);
      pg8::gemm_phase<pg8::EpiRes<3>, pg8::StaticOrder, false, true>(lds, g, S, E); }
    if (G == 256 && !(bx & 1)) { __syncthreads(); sample_fused_A<32>(lds, SHID, FF, (const bf16*)(ws + WS_WDOWN), sx2, bx, wave, lane, tid); }
    if (G == 256) sample_fused_B<true>(lds, Ys, args.in[26], Ys, nullptr, sx2, bx, wave, lane, tid);
    else for (int p = bx; p < 256; p += G) sample_fused_piece<32, true>(lds, SHID, FF, (const bf16*)(ws + WS_WDOWN), Ys, args.in[26], Ys, nullptr, sx2, p, wave, lane, tid);
}

extern "C" void kernel_launch(void* const* d_in, const int* in_sizes, int n_in, void* d_out, int out_size, void* d_ws, size_t ws_size, hipStream_t stream) {
    static int grid = 0;
    if (grid == 0) {
        if (n_in != 27 || (size_t)out_size != OUT_TOTAL || ws_size < WS_END) { fprintf(stderr, "kernel_launch: unexpected sizes n_in %d out %d ws %zu\n", n_in, out_size, ws_size); grid = -1; return; }
        int dev = 0, cus = 0, per_cu = 0;
        if (hipGetDevice(&dev) != hipSuccess || hipDeviceGetAttribute(&cus, hipDeviceAttributeMultiprocessorCount, dev) != hipSuccess) { grid = -1; return; }
        if (hipFuncSetAttribute((const void*)enc_fwd, hipFuncAttributeMaxDynamicSharedMemorySize, LDS_BYTES) != hipSuccess) { fprintf(stderr, "kernel_launch: hipFuncSetAttribute failed\n"); grid = -1; return; }
        if (hipOccupancyMaxActiveBlocksPerMultiprocessor(&per_cu, (const void*)enc_fwd, NWAVES * 64, LDS_BYTES) != hipSuccess || per_cu < 1) { fprintf(stderr, "kernel_launch: occupancy query says %d blocks/CU\n", per_cu); per_cu = 1; }
        (void)hipGetLastError();
        grid = cus;
    }
    if (grid < 0) return;
    (void)hipMemsetAsync((char*)d_ws + WS_CTL, 0, CTL_ZERO_BYTES, stream);
    Args a{};
    for (int i = 0; i < 27; ++i) a.in[i] = (const float*)d_in[i];
    a.out = (float*)d_out; a.ws = (unsigned char*)d_ws;
    hipLaunchKernelGGL(enc_fwd, dim3(grid), dim3(NWAVES * 64), LDS_BYTES, stream, a);
}
```

```cpp
#include <hip/hip_runtime.h>
#include <cstdio>
#include <cstdint>

namespace pg8 {
#define PG8_LAS __attribute__((address_space(3)))
typedef unsigned short bf16_t;
typedef short bf16x8 __attribute__((ext_vector_type(8)));
typedef float f32x4 __attribute__((ext_vector_type(4)));
typedef unsigned u32x4 __attribute__((ext_vector_type(4)));
typedef unsigned u32x2 __attribute__((ext_vector_type(2)));
constexpr int BM = 256, BK = 64, HALF = 128, HTB = HALF * BK * 2  , STAGE_BYTES = 8 * HTB, NXCD = 8, WGM = 8;

__host__ __device__ __forceinline__ int lds_byte(int r, int c) { const int st = (r >> 4) * 2 + (c >> 5), rr = r & 15, cc = c & 31, ob = rr * 64 + cc * 2; return st * 1024 + (ob ^ (((ob >> 9) & 1) << 5)); }
__host__ __device__ __forceinline__ void stage_rc(int b, int& R, int& C) { const int st = b / 1024, sb = b % 1024, swz = sb ^ (((sb >> 9) & 1) << 5); R = (st >> 1) * 16 + swz / 64; C = (st & 1) * 32 + (swz % 64) / 2; }
__host__ __device__ __forceinline__ int perm32(int rho) { const int n = rho >> 4, i = rho & 15; return 8 * (i >> 2) + 4 * n + (i & 3); }

struct Unit { int pm, pn; };
struct Gemm { const bf16_t* A; const bf16_t* Bt; int M, N, K; };

struct StaticOrder {
    int nM, nN, nwg, G, c;
    __host__ __device__ void init(int M, int N, int G_, int c_) { nM = M / BM; nN = N / BM; nwg = nM * nN; G = G_; c = c_; }
    __host__ __device__ __forceinline__ bool next(int i, Unit& u) const {
        const long L = (long)i * G + c; if (L >= nwg) return false;
        int wgid = (int)L; { const int q = nwg / NXCD, r = nwg % NXCD, xcd = wgid % NXCD, off = wgid / NXCD; wgid = (xcd < r ? xcd * (q + 1) : r * (q + 1) + (xcd - r) * q) + off; }
        const int nig = WGM * nN, gid = wgid / nig, fm = gid * WGM, gsz = (nM - fm) < WGM ? (nM - fm) : WGM;
        u.pm = fm + ((wgid % nig) % gsz); u.pn = (wgid % nig) / gsz; return true;
    }
    __device__ __forceinline__ void a_ready(const Unit&) const {}
    __device__ __forceinline__ void done(const Unit&) const {}
};

__device__ __forceinline__ unsigned cvt_pk_bf16(float lo, float hi) { unsigned r; asm volatile("v_cvt_pk_bf16_f32 %0, %1, %2" : "=v"(r) : "v"(lo), "v"(hi)); return r; }

struct EpiF32 {
    static constexpr bool PERM = false, AFTER_DRAIN = false;
    float* C; int ldc;
    __device__ __forceinline__ void operator()(const f32x4 (&acc)[2][2][4][2], const Unit& u, int wr, int wc, int fr, int fq) const {
        const int row0 = u.pm * BM + wr * 64 + fr, col0 = u.pn * BM + wc * 32 + 4 * fq;
#pragma unroll
        for (int ai = 0; ai < 2; ++ai)
#pragma unroll
            for (int m = 0; m < 4; ++m) { float* rowp = C + (size_t)(row0 + ai * HALF + m * 16) * ldc + col0;
#pragma unroll
                for (int bj = 0; bj < 2; ++bj)
#pragma unroll
                    for (int n = 0; n < 2; ++n) *(f32x4*)(rowp + bj * HALF + n * 16) = acc[ai][bj][m][n]; }
    }
};
template <int ACT> struct EpiBf16 {
    static constexpr bool PERM = true, AFTER_DRAIN = false;
    bf16_t* O; int ldc;
    __device__ __forceinline__ void operator()(const f32x4 (&acc)[2][2][4][2], const Unit& u, int wr, int wc, int fr, int fq) const {
        const int row0 = u.pm * BM + wr * 64 + fr, col0 = u.pn * BM + wc * 32 + 8 * fq;
#pragma unroll
        for (int ai = 0; ai < 2; ++ai)
#pragma unroll
            for (int m = 0; m < 4; ++m) { bf16_t* rowp = O + (size_t)(row0 + ai * HALF + m * 16) * ldc + col0;
#pragma unroll
                for (int bj = 0; bj < 2; ++bj) { f32x4 v0 = acc[ai][bj][m][0], v1 = acc[ai][bj][m][1];
                    if (ACT == 1) {
#pragma unroll
                        for (int j = 0; j < 4; ++j) { const float a = fmaxf(v0[j], 0.f), b = fmaxf(v1[j], 0.f); v0[j] = a * a; v1[j] = b * b; } }
                    u32x4 w; w.x = cvt_pk_bf16(v0[0], v0[1]); w.y = cvt_pk_bf16(v0[2], v0[3]); w.z = cvt_pk_bf16(v1[0], v1[1]); w.w = cvt_pk_bf16(v1[2], v1[3]);
                    *(u32x4*)(rowp + bj * HALF) = w; } }
    }
};
struct Epi1 {
    static constexpr bool PERM = true, AFTER_DRAIN = false;
    bf16_t* P1; float* pool_p; float* conv_p; float* pool_s; float* conv_s;
    __device__ __forceinline__ void operator()(const f32x4 (&acc)[2][2][4][2], const Unit& u, int wr, int wc, int fr, int fq) const {
        const int row0 = u.pm * BM + wr * 64 + fr;
        const bool sample = (u.pm == 64), tailp = ((u.pm & 15) == 15) && !sample;
        if (u.pn < 4) {
            const int col0 = u.pn * BM + wc * 32 + 8 * fq;
#pragma unroll
            for (int ai = 0; ai < 2; ++ai)
#pragma unroll
                for (int m = 0; m < 4; ++m) { const int row = row0 + ai * HALF + m * 16; bf16_t* rowp = P1 + (size_t)row * 1536 + col0;
#pragma unroll
                    for (int bj = 0; bj < 2; ++bj) { const f32x4 v0 = acc[ai][bj][m][0], v1 = acc[ai][bj][m][1];
                        u32x4 w; w.x = cvt_pk_bf16(v0[0], v0[1]); w.y = cvt_pk_bf16(v0[2], v0[3]); w.z = cvt_pk_bf16(v1[0], v1[1]); w.w = cvt_pk_bf16(v1[2], v1[3]);
                        *(u32x4*)(rowp + bj * HALF) = w;
                        if (u.pn < 2) {
                            float* dst = nullptr;
                            if (sample) { const int t = row & 15, sb = (row >> 4) & 15; if (t >= 1) dst = pool_s + ((size_t)(sb * 15 + t - 1) * 512 + col0 + bj * HALF); }
                            else if (tailp) { const int t = row & 4095, b = row >> 12; if (t >= 4081) dst = pool_p + ((size_t)(b * 15 + t - 4081) * 512 + col0 + bj * HALF); }
                            if (dst) { *(f32x4*)dst = v0; *(f32x4*)(dst + 4) = v1; }
                        } } }
        } else {
            const int ch0 = (u.pn - 4) * 128 + wc * 32 + 8 * fq;
#pragma unroll
            for (int ai = 0; ai < 2; ++ai)
#pragma unroll
                for (int m = 0; m < 4; ++m) { const int row = row0 + ai * HALF + m * 16;
                    const f32x4 v0 = acc[ai][0][m][0] * acc[ai][1][m][0], v1 = acc[ai][0][m][1] * acc[ai][1][m][1];
                    u32x4 w; w.x = cvt_pk_bf16(v0[0], v0[1]); w.y = cvt_pk_bf16(v0[2], v0[3]); w.z = cvt_pk_bf16(v1[0], v1[1]); w.w = cvt_pk_bf16(v1[2], v1[3]);
                    *(u32x4*)(P1 + (size_t)row * 1536 + 1024 + ch0) = w;
                    float* dst = nullptr;
                    if (sample) { const int t = row & 15, sb = (row >> 4) & 15; if (t >= 14) dst = conv_s + ((size_t)(sb * 2 + t - 14) * 512 + ch0); }
                    else if (tailp) { const int t = row & 4095, b = row >> 12; if (t >= 4094) dst = conv_p + ((size_t)(b * 2 + t - 4094) * 512 + ch0); }
                    if (dst) { *(f32x4*)dst = v0; *(f32x4*)(dst + 4) = v1; } }
        }
    }
};
struct EpiKV {
    static constexpr bool PERM = false, AFTER_DRAIN = false;
    float* outK; float* outV; bf16_t* KB; bf16_t* VT;
    __device__ __forceinline__ void operator()(const f32x4 (&acc)[2][2][4][2], const Unit& u, int wr, int wc, int fr, int fq) const {
        const int row0 = u.pm * BM + wr * 64 + fr;
        if (u.pn < 4) {
            const int col0 = u.pn * BM + wc * 32 + 4 * fq;
#pragma unroll
            for (int ai = 0; ai < 2; ++ai)
#pragma unroll
                for (int m = 0; m < 4; ++m) { const size_t off = (size_t)(row0 + ai * HALF + m * 16) * 1024 + col0;
#pragma unroll
                    for (int bj = 0; bj < 2; ++bj)
#pragma unroll
                        for (int n = 0; n < 2; ++n) { const f32x4 v = acc[ai][bj][m][n]; __builtin_nontemporal_store(v, (f32x4*)(outK + off + bj * HALF + n * 16));
                            u32x2 w; w.x = cvt_pk_bf16(v[0], v[1]); w.y = cvt_pk_bf16(v[2], v[3]); *(u32x2*)(KB + off + bj * HALF + n * 16) = w; } }
        } else {
            const int h = u.pn - 4, e0 = wc * 32 + 4 * fq;
            bf16_t* vt = VT + (size_t)(u.pm * 4 + h) * 65536;
#pragma unroll
            for (int ai = 0; ai < 2; ++ai)
#pragma unroll
                for (int m = 0; m < 4; ++m) { const int mrow = wr * 64 + fr + ai * HALF + m * 16;
                    const int pos = (mrow & ~12) | ((mrow & 4) << 1) | ((mrow & 8) >> 1);
                    const size_t off = (size_t)(u.pm * BM + mrow) * 1024 + h * 256 + e0;
#pragma unroll
                    for (int bj = 0; bj < 2; ++bj)
#pragma unroll
                        for (int n = 0; n < 2; ++n) { const f32x4 v = acc[ai][bj][m][n]; __builtin_nontemporal_store(v, (f32x4*)(outV + off + bj * HALF + n * 16));
                            const unsigned w0 = cvt_pk_bf16(v[0], v[1]), w1 = cvt_pk_bf16(v[2], v[3]); const int e = e0 + bj * HALF + n * 16;
                            vt[(size_t)(e + 0) * 256 + pos] = (bf16_t)(w0 & 0xffffu); vt[(size_t)(e + 1) * 256 + pos] = (bf16_t)(w0 >> 16);
                            vt[(size_t)(e + 2) * 256 + pos] = (bf16_t)(w1 & 0xffffu); vt[(size_t)(e + 3) * 256 + pos] = (bf16_t)(w1 >> 16); } }
        }
    }
};


template <int ACT, bool TAB> struct EpiBf16S {
    static constexpr bool PERM = true, AFTER_DRAIN = false;
    bf16_t* O; int ldc; const float* rsp; const PG8_LAS float* rstab;
    __device__ __forceinline__ void operator()(const f32x4 (&acc)[2][2][4][2], const Unit& u, int wr, int wc, int fr, int fq) const {
        const int row0 = u.pm * BM + wr * 64 + fr, col0 = u.pn * BM + wc * 32 + 8 * fq;
#pragma unroll
        for (int ai = 0; ai < 2; ++ai)
#pragma unroll
            for (int m = 0; m < 4; ++m) { const int row = row0 + ai * HALF + m * 16; bf16_t* rowp = O + (size_t)row * ldc + col0;
                float rs;
                if (TAB) rs = rstab[wr * 64 + fr + ai * HALF + m * 16];
                else { const f32x4 p = *(const f32x4*)(rsp + (size_t)row * 4); rs = 1.0f / sqrtf(((p[0] + p[1]) + (p[2] + p[3])) * (1.0f / 1024.0f) + 1e-6f); }
#pragma unroll
                for (int bj = 0; bj < 2; ++bj) { f32x4 v0 = acc[ai][bj][m][0] * rs, v1 = acc[ai][bj][m][1] * rs;
                    if (ACT == 1) {
#pragma unroll
                        for (int j = 0; j < 4; ++j) { const float a = fmaxf(v0[j], 0.f), b = fmaxf(v1[j], 0.f); v0[j] = a * a; v1[j] = b * b; } }
                    u32x4 w; w.x = cvt_pk_bf16(v0[0], v0[1]); w.y = cvt_pk_bf16(v0[2], v0[3]); w.z = cvt_pk_bf16(v1[0], v1[1]); w.w = cvt_pk_bf16(v1[2], v1[3]);
                    *(u32x4*)(rowp + bj * HALF) = w; } }
    }
};

template <int MODE> struct EpiRes {
    static constexpr bool PERM = true, AFTER_DRAIN = true;
    const float* basef; bf16_t* X; float* outf; const float* g; unsigned* xbuf; unsigned* cnt; float* rsp; unsigned* tmo;
    __device__ __forceinline__ void fused(f32x4 (&acc)[2][2][4][2], const Unit& u, int wr, int wc, int fr, int fq, PG8_LAS unsigned char* lds, int wid, int lane) const {
        PG8_LAS float* P = (PG8_LAS float*)lds;
        PG8_LAS float* S = (PG8_LAS float*)(lds + 4096);
        PG8_LAS float* R = (PG8_LAS float*)(lds + 5120);
        const int col0 = u.pn * BM + wc * 32 + 8 * fq;
        u32x4 pre[4][2][1];
#pragma unroll
        for (int m = 0; m < 4; ++m) { const size_t off = (size_t)(u.pm * BM + wr * 64 + m * 16 + fr) * 1024 + col0;
#pragma unroll
            for (int bj = 0; bj < 2; ++bj) {
                pre[m][bj][0] = *(const u32x4*)(X + off + bj * HALF); } }
#pragma unroll
        for (int ai = 0; ai < 2; ++ai)
#pragma unroll
            for (int m = 0; m < 4; ++m) { float s = 0.f;
#pragma unroll
                for (int bj = 0; bj < 2; ++bj)
#pragma unroll
                    for (int n = 0; n < 2; ++n) { const f32x4 x = acc[ai][bj][m][n]; s += (x[0] * x[0] + x[1] * x[1]) + (x[2] * x[2] + x[3] * x[3]); }
                s += __shfl_xor(s, 16); s += __shfl_xor(s, 32);
                if (fq == 0) P[(ai * HALF + wr * 64 + m * 16 + fr) * 4 + wc] = s; }
        asm volatile("s_waitcnt lgkmcnt(0)" ::: "memory"); __builtin_amdgcn_s_barrier(); asm volatile("" ::: "memory");
        const int row = wid * 32 + (lane & 31);
        if (lane < 32) { const f32x4 p = *(const PG8_LAS f32x4*)(P + row * 4); const float t = (p[0] + p[1]) + (p[2] + p[3]);
            __hip_atomic_store(xbuf + (size_t)(u.pm * BM + row) * 4 + u.pn, __float_as_uint(t), __ATOMIC_RELAXED, __HIP_MEMORY_SCOPE_AGENT); }
        asm volatile("s_waitcnt vmcnt(0)" ::: "memory");
        if (lane == 0) __hip_atomic_fetch_add(cnt + 64 * u.pm, 1u, __ATOMIC_RELAXED, __HIP_MEMORY_SCOPE_AGENT);
        if (wid == 0) { unsigned sp = 0;
            while ((unsigned)__builtin_amdgcn_readfirstlane(__hip_atomic_load(cnt + 64 * u.pm, __ATOMIC_RELAXED, __HIP_MEMORY_SCOPE_AGENT)) < 32u) {
                __builtin_amdgcn_s_sleep(2);
                if ((++sp & 1023u) == 0u) { if (__hip_atomic_load(tmo, __ATOMIC_RELAXED, __HIP_MEMORY_SCOPE_AGENT) != 0u) break; if (sp > (1u << 22)) { if (lane == 0) __hip_atomic_store(tmo, 1u, __ATOMIC_RELAXED, __HIP_MEMORY_SCOPE_AGENT); break; } } }
            }
        asm volatile("s_waitcnt vmcnt(0) lgkmcnt(0)" ::: "memory"); __builtin_amdgcn_s_barrier(); asm volatile("" ::: "memory");
        if (lane < 32) { const unsigned* slot = xbuf + (size_t)(u.pm * BM + row) * 4; float t = 0.f;
#pragma unroll
            for (int k = 0; k < 4; ++k) t += __uint_as_float(__hip_atomic_load(slot + k, __ATOMIC_RELAXED, __HIP_MEMORY_SCOPE_AGENT));
            S[row] = 1.0f / sqrtf(t * (1.0f / 1024.0f) + 1e-6f);
            if (MODE == 1) R[row] = basef[u.pm * BM + row]; }
        asm volatile("s_waitcnt lgkmcnt(0)" ::: "memory"); __builtin_amdgcn_s_barrier(); asm volatile("" ::: "memory");
        f32x4 gv[2][2];
#pragma unroll
        for (int bj = 0; bj < 2; ++bj)
#pragma unroll
            for (int n = 0; n < 2; ++n) gv[bj][n] = *(const f32x4*)(g + col0 + bj * HALF + 4 * n);
#pragma unroll
        for (int ai = 0; ai < 2; ++ai)
#pragma unroll
            for (int m = 0; m < 4; ++m) { const int r = ai * HALF + wr * 64 + m * 16 + fr; const float sr = S[r], rn = MODE == 1 ? R[r] : 1.f; const size_t off = (size_t)(u.pm * BM + r) * 1024 + col0; float q = 0.f;
#pragma unroll
                for (int bj = 0; bj < 2; ++bj) { f32x4 b0, b1;
                    { const u32x4 w = ai == 0 ? pre[m][bj][0] : *(const u32x4*)(X + off + bj * HALF);
                        b0 = (f32x4){__uint_as_float(w.x << 16), __uint_as_float(w.x & 0xffff0000u), __uint_as_float(w.y << 16), __uint_as_float(w.y & 0xffff0000u)};
                        b1 = (f32x4){__uint_as_float(w.z << 16), __uint_as_float(w.z & 0xffff0000u), __uint_as_float(w.w << 16), __uint_as_float(w.w & 0xffff0000u)};
                        if (MODE == 1) { b0 = b0 * rn; b1 = b1 * rn; } }
                    const f32x4 v0 = b0 + acc[ai][bj][m][0] * sr * gv[bj][0], v1 = b1 + acc[ai][bj][m][1] * sr * gv[bj][1];
                    if (MODE == 3) { __builtin_nontemporal_store(v0, (f32x4*)(outf + off + bj * HALF)); __builtin_nontemporal_store(v1, (f32x4*)(outf + off + bj * HALF + 4)); }
                    else { q += ((v0[0] * v0[0] + v0[1] * v0[1]) + (v0[2] * v0[2] + v0[3] * v0[3])) + ((v1[0] * v1[0] + v1[1] * v1[1]) + (v1[2] * v1[2] + v1[3] * v1[3]));
                        u32x4 w; w.x = cvt_pk_bf16(v0[0], v0[1]); w.y = cvt_pk_bf16(v0[2], v0[3]); w.z = cvt_pk_bf16(v1[0], v1[1]); w.w = cvt_pk_bf16(v1[2], v1[3]);
                        *(u32x4*)(X + off + bj * HALF) = w; } }
                if (MODE != 3) { q += __shfl_xor(q, 16); q += __shfl_xor(q, 32); if (fq == 0) P[r * 4 + wc] = q; }
                if (m & 1) asm volatile("" ::: "memory"); }
        if (MODE != 3) {
            asm volatile("s_waitcnt lgkmcnt(0)" ::: "memory"); __builtin_amdgcn_s_barrier(); asm volatile("" ::: "memory");
            if (lane < 32) { const f32x4 p = *(const PG8_LAS f32x4*)(P + row * 4); rsp[(size_t)(u.pm * BM + row) * 4 + u.pn] = (p[0] + p[1]) + (p[2] + p[3]); }
        }
    }
};

template <class Epi, class Sched, bool ALIGN_EPI = false, bool SP2 = false>
__device__ __forceinline__ void gemm_phase(PG8_LAS unsigned char* lds, const Gemm g, const Sched& S, const Epi& E) {
    int tid_ = threadIdx.x; asm volatile("" : "+v"(tid_));
    const int tid = tid_, wid = __builtin_amdgcn_readfirstlane(tid >> 6), lane = tid & 63, wr = wid >> 2, wc = wid & 3, fr = lane & 15, fq = lane >> 4;
    const int K = g.K, nt = K / BK;
    unsigned voffA[2], voffB[2];
#pragma unroll
    for (int i = 0; i < 2; ++i) { int R, C; stage_rc(tid * 16 + i * 8192, R, C); const int Rb = Epi::PERM ? ((R & ~31) + perm32(R & 31)) : R;
        voffA[i] = (unsigned)(R * K + C) * 2u; voffB[i] = (unsigned)(Rb * K + C) * 2u; }
    const size_t kstep = (size_t)(BK * 2);
    const size_t hstep = (size_t)HALF * K * 2;
    const size_t tstep = 2 * hstep;
    const unsigned ldsw = (unsigned)wid * 1024u;
    const int aoff = lds_byte(wr * 64 + fr, fq * 8), boff = lds_byte(wc * 32 + fr, fq * 8);
#define PG8_SA(b, h) (((b) * 2 + (h)) * HTB)
#define PG8_SB(b, h) ((4 + (b) * 2 + (h)) * HTB)
#define PG8_STAGE(bufoff, gbase, voff) do { _Pragma("unroll") for (int _i = 0; _i < 2; ++_i) \
        __builtin_amdgcn_global_load_lds((const unsigned*)((const char*)(gbase) + (voff)[_i]), (PG8_LAS unsigned*)(lds + (bufoff) + ldsw + _i * 8192), 16, 0, 0); } while (0)
#define PG8_LDA(dst, b, h) do { _Pragma("unroll") for (int m = 0; m < 4; ++m) _Pragma("unroll") for (int k = 0; k < 2; ++k) dst[m][k] = *(const PG8_LAS bf16x8*)(lds + PG8_SA(b, h) + aoff + m * 2048 + k * 1024); } while (0)
#define PG8_LDB(dst, b, h) do { _Pragma("unroll") for (int n = 0; n < 2; ++n) _Pragma("unroll") for (int k = 0; k < 2; ++k) dst[n][k] = *(const PG8_LAS bf16x8*)(lds + PG8_SB(b, h) + boff + n * 2048 + k * 1024); } while (0)
#define PG8_MMA(ai, bj, At, Bt) do { __builtin_amdgcn_s_setprio(1); _Pragma("unroll") for (int m = 0; m < 4; ++m) _Pragma("unroll") for (int n = 0; n < 2; ++n) _Pragma("unroll") for (int k = 0; k < 2; ++k) \
        acc[ai][bj][m][n] = __builtin_amdgcn_mfma_f32_16x16x32_bf16(Bt[n][k], At[m][k], acc[ai][bj][m][n], 0, 0, 0); __builtin_amdgcn_s_setprio(0); } while (0)
#define PG8_WAIT_V(n) asm volatile("s_waitcnt vmcnt(" #n ")" ::: "memory")
#define PG8_WAIT_L(n) asm volatile("s_waitcnt lgkmcnt(" #n ")" ::: "memory")
#define PG8_BAR __builtin_amdgcn_s_barrier()
#define PG8_SCHED __builtin_amdgcn_sched_barrier(0)
    Unit cur, nxt; int ui = 0;
    if (!S.next(0, cur)) return;
    f32x4 acc[2][2][4][2];
#pragma unroll
    for (int a = 0; a < 2; ++a)
#pragma unroll
        for (int b = 0; b < 2; ++b)
#pragma unroll
            for (int m = 0; m < 4; ++m)
#pragma unroll
                for (int n = 0; n < 2; ++n) acc[a][b][m][n] = (f32x4){0.f, 0.f, 0.f, 0.f};
    bf16x8 At[4][2], B0[2][2], B1[2][2];
    const char* cA = (const char*)g.A + (size_t)cur.pm * tstep; const char* cB = (const char*)g.Bt + (size_t)cur.pn * tstep;
    S.a_ready(cur);
    if constexpr (SP2) {
        PG8_STAGE(PG8_SB(0, 0), cB, voffB); PG8_STAGE(PG8_SB(0, 1), cB + hstep, voffB); PG8_STAGE(PG8_SA(0, 0), cA, voffA); PG8_STAGE(PG8_SA(0, 1), cA + hstep, voffA);
        if (wr == 1) PG8_BAR;
        PG8_WAIT_V(2); PG8_BAR;
        PG8_STAGE(PG8_SB(1, 0), cB + kstep, voffB); PG8_STAGE(PG8_SA(1, 0), cA + kstep, voffA); PG8_STAGE(PG8_SB(1, 1), cB + hstep + kstep, voffB);
        PG8_WAIT_V(6); PG8_BAR;
    } else {
        PG8_STAGE(PG8_SB(0, 0), cB, voffB); PG8_STAGE(PG8_SA(0, 0), cA, voffA); PG8_STAGE(PG8_SB(0, 1), cB + hstep, voffB); PG8_STAGE(PG8_SA(0, 1), cA + hstep, voffA);
        if (wr == 1) PG8_BAR;
        PG8_WAIT_V(4); PG8_BAR;
        PG8_STAGE(PG8_SB(1, 0), cB + kstep, voffB); PG8_STAGE(PG8_SA(1, 0), cA + kstep, voffA); PG8_STAGE(PG8_SB(1, 1), cB + hstep + kstep, voffB);
        PG8_WAIT_V(6); PG8_BAR;
    }
    for (;;) {
        const bool has_next = S.next(ui + 1, nxt);
        const char* nA = has_next ? (const char*)g.A + (size_t)nxt.pm * tstep : cA; const char* nB = has_next ? (const char*)g.Bt + (size_t)nxt.pn * tstep : cB;
        for (int t = 0; t < nt; t += 2) {
            const bool last = (t == nt - 2);
            const char* a1 = cA + (size_t)(t + 1) * kstep;
            const char* a2 = last ? nA : cA + (size_t)(t + 2) * kstep; const char* b2 = last ? nB : cB + (size_t)(t + 2) * kstep;
            const char* a3 = a2 + kstep; const char* b3 = b2 + kstep;
            if (last && has_next) S.a_ready(nxt);
            if constexpr (SP2) {
            PG8_LDB(B0, 0, 0); PG8_LDB(B1, 0, 1); PG8_SCHED; PG8_LDA(At, 0, 0); PG8_STAGE(PG8_SA(1, 1), a1 + hstep, voffA);
            PG8_WAIT_V(8); PG8_WAIT_L(0); PG8_BAR; PG8_MMA(0, 0, At, B0); PG8_MMA(0, 1, At, B1); PG8_BAR; PG8_SCHED;
            PG8_LDA(At, 0, 1); PG8_STAGE(PG8_SB(0, 0), b2, voffB); PG8_STAGE(PG8_SB(0, 1), b2 + hstep, voffB); PG8_STAGE(PG8_SA(0, 0), a2, voffA);
            PG8_WAIT_V(8); PG8_WAIT_L(0); PG8_BAR; PG8_MMA(1, 0, At, B0); PG8_MMA(1, 1, At, B1); PG8_BAR; PG8_SCHED;
            PG8_LDB(B0, 1, 0); PG8_LDB(B1, 1, 1); PG8_SCHED; PG8_LDA(At, 1, 0); PG8_STAGE(PG8_SA(0, 1), a2 + hstep, voffA);
            PG8_WAIT_V(8); PG8_WAIT_L(0); PG8_BAR; PG8_MMA(0, 0, At, B0); PG8_MMA(0, 1, At, B1); PG8_BAR; PG8_SCHED;
            PG8_LDA(At, 1, 1); PG8_STAGE(PG8_SB(1, 0), b3, voffB); PG8_STAGE(PG8_SB(1, 1), b3 + hstep, voffB); PG8_STAGE(PG8_SA(1, 0), a3, voffA);
            PG8_WAIT_V(8); PG8_WAIT_L(0); PG8_BAR; PG8_MMA(1, 0, At, B0); PG8_MMA(1, 1, At, B1); PG8_BAR; PG8_SCHED;
            } else {
            PG8_LDB(B0, 0, 0); PG8_SCHED; PG8_LDA(At, 0, 0); PG8_STAGE(PG8_SA(1, 1), a1 + hstep, voffA);
            PG8_WAIT_L(8); PG8_BAR; PG8_WAIT_L(0); PG8_MMA(0, 0, At, B0); PG8_BAR; PG8_SCHED;
            PG8_LDB(B1, 0, 1); PG8_STAGE(PG8_SB(0, 0), b2, voffB);
            PG8_BAR; PG8_WAIT_L(0); PG8_MMA(0, 1, At, B1); PG8_BAR;
            PG8_LDA(At, 0, 1); PG8_STAGE(PG8_SA(0, 0), a2, voffA);
            PG8_BAR; PG8_WAIT_L(0); PG8_MMA(1, 0, At, B0); PG8_BAR; PG8_SCHED;
            PG8_STAGE(PG8_SB(0, 1), b2 + hstep, voffB);
            PG8_WAIT_V(6); PG8_BAR; PG8_MMA(1, 1, At, B1); PG8_BAR;
            PG8_LDB(B0, 1, 0); PG8_SCHED; PG8_LDA(At, 1, 0); PG8_STAGE(PG8_SA(0, 1), a2 + hstep, voffA);
            PG8_WAIT_L(8); PG8_BAR; PG8_WAIT_L(0); PG8_MMA(0, 0, At, B0); PG8_BAR; PG8_SCHED;
            PG8_LDB(B1, 1, 1); PG8_STAGE(PG8_SB(1, 0), b3, voffB);
            PG8_BAR; PG8_WAIT_L(0); PG8_MMA(0, 1, At, B1); PG8_BAR;
            PG8_LDA(At, 1, 1); PG8_STAGE(PG8_SA(1, 0), a3, voffA);
            PG8_BAR; PG8_WAIT_L(0); PG8_MMA(1, 0, At, B0); PG8_BAR; PG8_SCHED;
            PG8_STAGE(PG8_SB(1, 1), b3 + hstep, voffB);
            PG8_WAIT_V(6); PG8_BAR; PG8_MMA(1, 1, At, B1); PG8_BAR;
            }
        }
        if constexpr (ALIGN_EPI) { if (wr == 0) PG8_BAR; }
        if constexpr (!Epi::AFTER_DRAIN) { E(acc, cur, wr, wc, fr, fq); S.done(cur); }
        if (!has_next) break;
#pragma unroll
        for (int a = 0; a < 2; ++a)
#pragma unroll
            for (int b = 0; b < 2; ++b)
#pragma unroll
                for (int m = 0; m < 4; ++m)
#pragma unroll
                    for (int n = 0; n < 2; ++n) acc[a][b][m][n] = (f32x4){0.f, 0.f, 0.f, 0.f};
        cur = nxt; cA = nA; cB = nB; ++ui;
        if constexpr (ALIGN_EPI) { if (wr == 1) PG8_BAR; }
    }
    PG8_WAIT_V(0);
    if constexpr (!ALIGN_EPI) { if (wr == 0) PG8_BAR; }
    PG8_BAR;
    if constexpr (Epi::AFTER_DRAIN) { E.fused(acc, cur, wr, wc, fr, fq, lds, wid, lane); S.done(cur); }
#undef PG8_SA
#undef PG8_SB
#undef PG8_STAGE
#undef PG8_LDA
#undef PG8_LDB
#undef PG8_MMA
#undef PG8_WAIT_V
#undef PG8_WAIT_L
#undef PG8_BAR
#undef PG8_SCHED
}
}
constexpr int NWAVES = 8;
constexpr int D = 1024, MP = 16384, MS = 256, M = MP + MS, NIN = 2048, FF = 4096;
constexpr float EPS = 1e-6f;
constexpr size_t OUT_Y = 0, OUT_POOL_P = 17039360, OUT_CONV_P = 17070080, OUT_MK = 17074176, OUT_MV = 18122752, OUT_POOL_S = 19171328, OUT_CONV_S = 19294208, OUT_TOTAL = 19310592;
constexpr size_t MiB = 1u << 20;
constexpr size_t WS_CTL = 0, CTL_ZERO_BYTES = 128 * 1024;
constexpr size_t WS_WDOWN = 1 * MiB, WS_WUP = 9 * MiB, WS_WIN = 17 * MiB, WS_WKV = 21 * MiB, WS_WOUT = 25 * MiB, WS_WQ = 27 * MiB, WS_WCO = 29 * MiB, WS_WP = 31 * MiB;
constexpr size_t WS_HISTU = 31 * MiB + 512 * 1024, WS_HISTV = WS_HISTU + 16 * 15 * 512 * 2, WS_ZERO = 32 * 1024;
constexpr size_t WS_MN = 32 * MiB, WS_KB = 34 * MiB, WS_VT = 36 * MiB, WS_KBS = 38 * MiB, WS_VTS = 46 * MiB;
constexpr size_t WS_XN = 54 * MiB;
constexpr size_t WS_MRG = 87 * MiB;
constexpr size_t WS_AO = 87 * MiB;
constexpr size_t WS_P1 = 120 * MiB;
constexpr size_t WS_QO = 120 * MiB;
constexpr size_t WS_HID = 120 * MiB;
constexpr size_t WS_XB1 = 248 * MiB, WS_XB2 = WS_XB1 + 256 * 1024, WS_XB3 = WS_XB2 + 256 * 1024, WS_RSP1 = WS_XB3 + 256 * 1024, WS_RSP2 = WS_RSP1 + 256 * 1024;
constexpr size_t WS_SXB = 249 * MiB + 512 * 1024, WS_SRSP = WS_SXB + 3 * 32768;
constexpr size_t WS_RNORM = 249 * MiB + 768 * 1024;
constexpr size_t WS_SQO = 250 * MiB, WS_SAO = WS_SQO + 512 * 1024, WS_SRAW = 251 * MiB, WS_SHID = 252 * MiB;
constexpr size_t WS_END = 256 * MiB;
constexpr int CW_TMO = 0, CW_SEAM = 16384, CW_SSEAM = 16384 + 3 * 4096;
static_assert(WS_MRG + (size_t)M * D * 2 <= WS_P1 && WS_HID + (size_t)MP * FF * 2 <= WS_XB1 && WS_SHID + (size_t)MS * FF * 2 <= WS_END, "ws map");
constexpr int CW_BAR = 4096;

constexpr int RING_BYTES = 131072, LDSCTL_OFF = RING_BYTES, MISC_OFF = LDSCTL_OFF + 320, RSTAB_OFF = RING_BYTES + 1024, GGTAB_OFF = RING_BYTES + 2048, STASH_OFF = RING_BYTES + 4096, LDS_BYTES = 147456;

#define GAS __attribute__((address_space(1)))
#define LAS __attribute__((address_space(3)))
typedef unsigned short bf16;
typedef unsigned v4u __attribute__((ext_vector_type(4)));
typedef unsigned v2u __attribute__((ext_vector_type(2)));
typedef float f32x4 __attribute__((ext_vector_type(4)));
typedef float f32x16 __attribute__((ext_vector_type(16)));
typedef float f32x2 __attribute__((ext_vector_type(2)));
typedef short bf16x8 __attribute__((ext_vector_type(8)));
#define LDS_WAIT() asm volatile("s_waitcnt lgkmcnt(0)" ::: "memory")
#define VM_WAIT() asm volatile("s_waitcnt vmcnt(0)" ::: "memory")
__device__ __forceinline__ unsigned f2bf(float f) { unsigned u = __builtin_bit_cast(unsigned, f); return (u + 0x7fffu + ((u >> 16) & 1u)) >> 16; }
__device__ __forceinline__ unsigned pk2(float lo, float hi) { return pg8::cvt_pk_bf16(lo, hi); }
typedef __bf16 bf16n2 __attribute__((ext_vector_type(2)));
__device__ __forceinline__ unsigned pk2c(float lo, float hi) { const bf16n2 v = __builtin_convertvector((f32x2){lo, hi}, bf16n2); return __builtin_bit_cast(unsigned, v); }
__device__ __forceinline__ float bflo(unsigned w) { return __builtin_bit_cast(float, w << 16); }
__device__ __forceinline__ float bfhi(unsigned w) { return __builtin_bit_cast(float, w & 0xffff0000u); }

#define XB_TMO      128
#define XB_XCNT(j)  (256  + 64 * (j))
#define XB_XSUB(j)  (1280 + 64 * (j))
#define XB_XGEN(j)  (2304 + 64 * (j))
#define XB_TOP      3328
#define XB_TOPGEN   3392
#define XCD_BAR_WORDS 3456
#define XB_SPIN_CAP (1u << 22)
__device__ __forceinline__ unsigned xb_ld(unsigned* p)              { return __hip_atomic_load(p, __ATOMIC_RELAXED, __HIP_MEMORY_SCOPE_AGENT); }
__device__ __forceinline__ unsigned xb_add(unsigned* p, unsigned v) { return __hip_atomic_fetch_add(p, v, __ATOMIC_RELAXED, __HIP_MEMORY_SCOPE_AGENT); }
__device__ __forceinline__ unsigned xb_xcc_id() { return (unsigned)__builtin_amdgcn_s_getreg((3 << 11) | 20) & 0xFu; }
#define XB_SPIN(cond, bar) do { unsigned _sp = 0; while (cond) { __builtin_amdgcn_s_sleep(1); \
    if ((++_sp & 255u) == 0u) { if (xb_ld(&(bar)[XB_TMO])) break; if (_sp > XB_SPIN_CAP) { atomicAdd(&(bar)[XB_TMO], 1u); break; } } } } while (0)
struct XcdBarrier { unsigned* bar; unsigned x; volatile LAS unsigned* st; };
__device__ __forceinline__ XcdBarrier xcd_barrier_post(unsigned* bar, volatile LAS unsigned* st) {
    XcdBarrier b; b.bar = bar; b.x = xb_xcc_id(); b.st = st;
    if (threadIdx.x == 0) (void)xb_add(&bar[XB_XCNT(b.x)], 1u);
    return b;
}
__device__ __forceinline__ void xcd_barrier_complete(unsigned* bar, unsigned x, unsigned& nloc, unsigned& nx) {
    const unsigned G = gridDim.x * gridDim.y * gridDim.z;
    unsigned sum, cnt, mine, sp = 0u;
    for (;;) {
        sum = 0u; cnt = 0u; mine = 0u;
#pragma unroll
        for (unsigned j = 0; j < 16; ++j) { const unsigned c = xb_ld(&bar[XB_XCNT(j)]); sum += c; cnt += (c > 0u) ? 1u : 0u; mine = (j == x) ? c : mine; }
        if (sum == G) break;
        __builtin_amdgcn_s_sleep(1);
        if ((++sp & 255u) == 0u) { if (xb_ld(&bar[XB_TMO])) break; if (sp > XB_SPIN_CAP) { atomicAdd(&bar[XB_TMO], 1u); break; } }
    }
    nloc = mine > 0u ? mine : 1u; nx = cnt > 0u ? cnt : 1u;
}
__device__ __forceinline__ void xcd_barrier(const XcdBarrier& b) {
    asm volatile("s_waitcnt vmcnt(0)" ::: "memory");
    __syncthreads();
    if (threadIdx.x == 0) {
        unsigned* bar = b.bar;
        __builtin_amdgcn_s_waitcnt(0);
        unsigned nloc = b.st[0], nx = b.st[1];
        if (nloc == 0u) { xcd_barrier_complete(bar, b.x, nloc, nx); b.st[0] = nloc; b.st[1] = nx; }
        const unsigned old = xb_add(&bar[XB_XSUB(b.x)], 1u);
        const unsigned gen = old / nloc;
        if (old + 1u == (gen + 1u) * nloc) {
            __builtin_amdgcn_fence(__ATOMIC_RELEASE, "agent");
            asm volatile("s_waitcnt vmcnt(0)" ::: "memory");
            const unsigned og = xb_add(&bar[XB_TOP], 1u);
            const unsigned tg = og / nx;
            if (og + 1u == (tg + 1u) * nx) xb_add(&bar[XB_TOPGEN], 1u);
            else XB_SPIN(xb_ld(&bar[XB_TOPGEN]) == tg, bar);
            __builtin_amdgcn_fence(__ATOMIC_ACQUIRE, "agent");
            xb_add(&bar[XB_XGEN(b.x)], 1u);
            asm volatile("s_waitcnt vmcnt(0)" ::: "memory");
        } else {
            XB_SPIN(xb_ld(&bar[XB_XGEN(b.x)]) == gen, bar);
            __builtin_amdgcn_fence(__ATOMIC_ACQUIRE, "agent");
            asm volatile("s_waitcnt vmcnt(0)" ::: "memory");
        }
    }
    __syncthreads();
}

__device__ __forceinline__ void xcd_arrive(const XcdBarrier& b) {
    asm volatile("s_waitcnt vmcnt(0)" ::: "memory");
    __syncthreads();
    if (threadIdx.x == 0) {
        unsigned* bar = b.bar;
        __builtin_amdgcn_s_waitcnt(0);
        unsigned nloc = b.st[0], nx = b.st[1];
        if (nloc == 0u) { xcd_barrier_complete(bar, b.x, nloc, nx); b.st[0] = nloc; b.st[1] = nx; }
        const unsigned old = xb_add(&bar[XB_XSUB(b.x)], 1u);
        const unsigned gen = old / nloc;
        b.st[2] = gen;
        if (old + 1u == (gen + 1u) * nloc) {
            __builtin_amdgcn_fence(__ATOMIC_RELEASE, "agent");
            asm volatile("s_waitcnt vmcnt(0)" ::: "memory");
            (void)xb_add(&bar[XB_TOP], 1u);
        }
    }
}
__device__ __forceinline__ void xcd_wait(const XcdBarrier& b) {
    if (threadIdx.x == 0) {
        unsigned* bar = b.bar; const unsigned need = (b.st[2] + 1u) * b.st[1];
        XB_SPIN((int)(xb_ld(&bar[XB_TOP]) - need) < 0, bar);
        __builtin_amdgcn_fence(__ATOMIC_ACQUIRE, "agent");
        asm volatile("s_waitcnt vmcnt(0)" ::: "memory");
    }
    __syncthreads();
}

#define XB_LSUB(j)  (5120 + 64 * (j))
#define XB_GRP(j)   (6400 + 64 * (j))
#define XB_MIS      7040
__device__ __forceinline__ void xcd_local_barrier(const XcdBarrier& b) {
    asm volatile("s_waitcnt vmcnt(0)" ::: "memory");
    __syncthreads();
    if (threadIdx.x == 0) {
        unsigned* bar = b.bar;
        const unsigned nloc = b.st[0];
        const unsigned old = xb_add(&bar[XB_LSUB(b.x)], 1u);
        const unsigned need = (old / nloc + 1u) * nloc;
        XB_SPIN((int)(xb_ld(&bar[XB_LSUB(b.x)]) - need) < 0, bar);
        __builtin_amdgcn_fence(__ATOMIC_ACQUIRE, "agent");
        asm volatile("s_waitcnt vmcnt(0)" ::: "memory");
    }
    __syncthreads();
}

struct Args { const float* in[27]; float* out; unsigned char* ws; };

__device__ __forceinline__ float wave_sum(float v) {
#pragma unroll
    for (int o = 1; o < 64; o <<= 1) v += __shfl_xor(v, o);
    return v;
}

struct TItem { const float* W; const float* g; const float* gn; bf16* WT; int ldw, K, srccol, dstrow, k0; float sc; int kperm; };
struct TRegs { f32x4 v[8]; float gk[8]; };
__device__ __forceinline__ void t_load(const TItem& t, TRegs& r, int lane) {
    const int rl = lane >> 3, cq = lane & 7;
#pragma unroll
    for (int i = 0; i < 8; ++i) { const int kk = 8 * i + rl; r.v[i] = __builtin_nontemporal_load((const GAS f32x4*)(t.W + (size_t)(t.k0 + kk) * t.ldw + t.srccol + 4 * cq)); r.gk[i] = t.g ? t.g[t.k0 + kk] : 1.f; }
}
__device__ __forceinline__ void t_process(const TItem& t, const TRegs& r, LAS float* scr, int lane) {
    const int rl = lane >> 3, cq = lane & 7;
    f32x4 gn4 = (f32x4){1.f, 1.f, 1.f, 1.f}; if (t.gn) gn4 = *(const GAS f32x4*)(t.gn + t.srccol + 4 * cq);
#pragma unroll
    for (int i = 0; i < 8; ++i) { const int kk = 8 * i + rl; const float m = r.gk[i] * t.sc; LAS float* d = scr + kk * 33 + 4 * cq;
        d[0] = r.v[i].x * m * gn4.x; d[1] = r.v[i].y * m * gn4.y; d[2] = r.v[i].z * m * gn4.z; d[3] = r.v[i].w * m * gn4.w; }
    LDS_WAIT(); asm volatile("" ::: "memory");
    const int c = lane & 7;
    const int lp = t.kperm == 0 ? 8 * c : t.kperm == 1 ? (((c & 6) << 3) | ((c & 1) << 2)) : (((c & 4) << 3) | ((c & 3) << 2));
    const LAS float* s0 = scr + lp * 33; const LAS float* s1 = s0 + (4 << t.kperm) * 33;
#pragma unroll
    for (int j = 0; j < 4; ++j) { const int n = (lane >> 3) + 8 * j;
        float e[8];
#pragma unroll
        for (int q = 0; q < 8; ++q) e[q] = (q < 4 ? s0 : s1)[(q & 3) * 33 + n];
        v4u o; o.x = pk2(e[0], e[1]); o.y = pk2(e[2], e[3]); o.z = pk2(e[4], e[5]); o.w = pk2(e[6], e[7]);
        *(GAS v4u*)(t.WT + (size_t)(t.dstrow + n) * t.K + t.k0 + 8 * c) = o; }
    LDS_WAIT(); asm volatile("" ::: "memory");
}
__device__ __forceinline__ void rms_row_to_bf16(const float* xrow, bf16* orow, float* n0, int lane) {
    const GAS f32x4* xr = (const GAS f32x4*)xrow + lane;
    f32x4 v[4]; float s = 0.f;
#pragma unroll
    for (int j = 0; j < 4; ++j) { v[j] = __builtin_nontemporal_load(xr + 64 * j); s += (v[j].x * v[j].x + v[j].y * v[j].y) + (v[j].z * v[j].z + v[j].w * v[j].w); }
    const float rs = 1.f / sqrtf(wave_sum(s) * (1.f / D) + EPS);
    if (lane == 0 && n0) *n0 = 1.f / rs;
    GAS v2u* o8 = (GAS v2u*)orow + lane;
#pragma unroll
    for (int j = 0; j < 4; ++j) { v2u w; w.x = pk2(v[j].x * rs, v[j].y * rs); w.y = pk2(v[j].z * rs, v[j].w * rs); o8[64 * j] = w; }
}
__device__ __forceinline__ void rms_rows2_to_bf16(const float* x0, bf16* o0, const float* x1, bf16* o1, float* n0, float* n1, int lane) {
    const GAS f32x4* a0 = (const GAS f32x4*)x0 + lane; const GAS f32x4* a1 = (const GAS f32x4*)x1 + lane;
    f32x4 v[4], w[4]; float s = 0.f, t = 0.f;
#pragma unroll
    for (int j = 0; j < 4; ++j) { v[j] = __builtin_nontemporal_load(a0 + 64 * j); w[j] = __builtin_nontemporal_load(a1 + 64 * j); }
#pragma unroll
    for (int j = 0; j < 4; ++j) { s += (v[j].x * v[j].x + v[j].y * v[j].y) + (v[j].z * v[j].z + v[j].w * v[j].w); t += (w[j].x * w[j].x + w[j].y * w[j].y) + (w[j].z * w[j].z + w[j].w * w[j].w); }
    const float rs = 1.f / sqrtf(wave_sum(s) * (1.f / D) + EPS), rt_ = 1.f / sqrtf(wave_sum(t) * (1.f / D) + EPS);
    GAS v2u* p0 = (GAS v2u*)o0 + lane; GAS v2u* p1 = (GAS v2u*)o1 + lane;
    if (lane == 0) { if (n0) *n0 = 1.f / rs; if (n1) *n1 = 1.f / rt_; }
#pragma unroll
    for (int j = 0; j < 4; ++j) { v2u u; u.x = pk2(v[j].x * rs, v[j].y * rs); u.y = pk2(v[j].z * rs, v[j].w * rs); p0[64 * j] = u;
        v2u z; z.x = pk2(w[j].x * rt_, w[j].y * rt_); z.y = pk2(w[j].z * rt_, w[j].w * rt_); p1[64 * j] = z; }
}
__device__ __forceinline__ const float* xrow_ptr(const Args& a, int row) { return row < MP ? a.in[0] + (size_t)row * D : a.in[1] + (size_t)(row - MP) * D; }

constexpr int I_IN = 16 * 64, I_KV = 16 * 64, I_WP = 4 * 2 * 4, N_EARLY = I_IN + I_KV + I_WP;
constexpr int I_OUT = 16 * 32, I_Q = 16 * 32, I_CO = 16 * 32, I_UP = 16 * 128, I_DN = 64 * 32, I_VS = 64 * 4 * 8, N_ITEMS = N_EARLY + I_OUT + I_Q + I_CO + I_UP + I_DN + I_VS;
constexpr int DN_LO = N_EARLY + I_OUT + I_Q + I_CO + I_UP, DN_HI = DN_LO + I_DN;
__device__ __forceinline__ TItem p0_item(const Args& a, int it) {
    unsigned char* ws = a.ws; TItem t; t.g = nullptr; t.gn = nullptr; t.sc = 1.f; t.kperm = 0;
    int r = it;
    if (r < I_IN) { const int kb = r / 64, nb = r % 64, n0 = 32 * nb; int src;
        if (n0 < 1024) src = n0; else { const int j = (n0 - 1024) >> 8, o = (n0 - 1024) & 255; src = o < 128 ? 1024 + 128 * j + o : 1536 + 128 * j + (o - 128); }
        t.W = a.in[8]; t.ldw = NIN; t.K = D; t.srccol = src; t.WT = (bf16*)(ws + WS_WIN); t.dstrow = n0; t.k0 = 64 * kb; t.g = a.in[7]; return t; } r -= I_IN;
    if (r < I_KV) { const int kb = r / 64, nb = r % 64, n0 = 32 * nb;
        t.W = n0 < 1024 ? a.in[17] : a.in[18]; t.ldw = D; t.K = D; t.srccol = n0 & 1023; t.WT = (bf16*)(ws + WS_WKV); t.dstrow = n0; t.k0 = 64 * kb; t.g = a.in[16]; return t; } r -= I_KV;
    if (r < I_WP) { const int gi = r / 8, kb = (r % 8) / 4, nb = r % 4;
        t.W = a.in[9] + gi * 16384; t.ldw = 128; t.K = 128; t.srccol = 32 * nb; t.WT = (bf16*)(ws + WS_WP) + gi * 16384; t.dstrow = 32 * nb; t.k0 = 64 * kb; t.gn = a.in[10] + gi * 128; t.kperm = 2; return t; } r -= I_WP;
    if (r < I_OUT) { t.W = a.in[14]; t.ldw = D; t.K = D; t.srccol = 32 * (r % 32); t.WT = (bf16*)(ws + WS_WOUT); t.dstrow = t.srccol; t.k0 = 64 * (r / 32);
        t.g = t.k0 < 512 ? a.in[12] : a.in[13] - 512; return t; } r -= I_OUT;
    if (r < I_Q) { t.W = a.in[20]; t.ldw = D; t.K = D; t.srccol = 32 * (r % 32); t.WT = (bf16*)(ws + WS_WQ); t.dstrow = t.srccol; t.k0 = 64 * (r / 32); t.g = a.in[19]; t.sc = 0.0625f; return t; } r -= I_Q;
    if (r < I_CO) { t.W = a.in[21]; t.ldw = D; t.K = D; t.srccol = 32 * (r % 32); t.WT = (bf16*)(ws + WS_WCO); t.dstrow = t.srccol; t.k0 = 64 * (r / 32); return t; } r -= I_CO;
    if (r < I_UP) { t.W = a.in[24]; t.ldw = FF; t.K = D; t.srccol = 32 * (r % 128); t.WT = (bf16*)(ws + WS_WUP); t.dstrow = t.srccol; t.k0 = 64 * (r / 128); t.g = a.in[23]; return t; } r -= I_UP;
    if (r < I_DN) { t.W = a.in[25]; t.ldw = D; t.K = FF; t.srccol = 32 * (r % 32); t.WT = (bf16*)(ws + WS_WDOWN); t.dstrow = t.srccol; t.k0 = 64 * (r / 32); return t; } r -= I_DN;
    { const int sbh = r / 32, kb = (r % 32) / 8, nb = r % 8, sb = sbh >> 2, h = sbh & 3;
        t.W = a.in[5] + (size_t)sb * 262144 + h * 256; t.ldw = 1024; t.K = 256; t.srccol = 32 * nb; t.WT = (bf16*)(ws + WS_VTS) + (size_t)sbh * 65536; t.dstrow = 32 * nb; t.k0 = 64 * kb; t.kperm = 1; return t; }
}
__device__ __forceinline__ void p0_items(const Args& a, LAS float* scr, int lo, int hi, int gw, int NGW, int lane) {
    int it = lo + gw; TItem cur; TRegs rc;
    if (it < hi) { cur = p0_item(a, it); t_load(cur, rc, lane); }
    while (it < hi) {
        const int nx = it + NGW; TItem nxt = cur; TRegs rn = rc;
        if (nx < hi) { nxt = p0_item(a, nx); t_load(nxt, rn, lane); }
        t_process(cur, rc, scr, lane);
        cur = nxt; rc = rn; it = nx;
    }
}
__device__ __forceinline__ void p0_prologue(const Args& a, LAS unsigned char* lds, int gw, int NGW, int wave, int lane_) {
    int lane = lane_; asm volatile("" : "+v"(lane));
    unsigned char* ws = a.ws;
    p0_items(a, (LAS float*)(lds + wave * 16384), 0, N_EARLY, gw, NGW, lane);
    float* rn = (float*)(ws + WS_RNORM);
    for (int m = gw; m < M + 1024; m += 2 * NGW) {
        const int m2 = m + NGW;
        const float* r0 = m < M ? xrow_ptr(a, m) : a.in[6] + (size_t)(m - M) * D; bf16* o0 = m < M ? (bf16*)(ws + WS_XN) + (size_t)m * D : (bf16*)(ws + WS_MN) + (size_t)(m - M) * D;
        if (m2 < M + 1024) {
            const float* r1 = m2 < M ? xrow_ptr(a, m2) : a.in[6] + (size_t)(m2 - M) * D; bf16* o1 = m2 < M ? (bf16*)(ws + WS_XN) + (size_t)m2 * D : (bf16*)(ws + WS_MN) + (size_t)(m2 - M) * D;
            rms_rows2_to_bf16(r0, o0, r1, o1, m < MP ? rn + m : nullptr, m2 < MP ? rn + m2 : nullptr, lane);
        } else rms_row_to_bf16(r0, o0, m < MP ? rn + m : nullptr, lane);
    }
    { GAS v4u* dst = (GAS v4u*)(ws + WS_HISTU); constexpr int NU = 16 * 15 * 512 / 8, NV = 16 * 2 * 512 / 8;
      for (int i = gw * 64 + lane; i < NU + NV; i += NGW * 64) { const GAS f32x4* src = i < NU ? (const GAS f32x4*)a.in[2] + 2 * i : (const GAS f32x4*)a.in[3] + 2 * (i - NU); const f32x4 p = src[0], q = src[1];
          v4u o; o.x = pk2(p.x, p.y); o.y = pk2(p.z, p.w); o.z = pk2(q.x, q.y); o.w = pk2(q.z, q.w); dst[i] = o; } }
}
__device__ __forceinline__ void p2_late(const Args& a, LAS unsigned char* lds, int gw, int NGW, int wave, int lane_) {
    int lane = lane_; asm volatile("" : "+v"(lane));
    unsigned char* ws = a.ws;
    p0_items(a, (LAS float*)(lds + wave * 16384), N_EARLY, DN_LO, gw, NGW, lane);
    p0_items(a, (LAS float*)(lds + wave * 16384), DN_HI, N_ITEMS, gw, NGW, lane);
    { const GAS f32x4* src = (const GAS f32x4*)a.in[4]; GAS v4u* dst = (GAS v4u*)(ws + WS_KBS); const size_t n = (size_t)16 * 256 * 1024 / 8, st = (size_t)NGW * 64;
      for (size_t i = (size_t)gw * 64 + lane; i < n; i += 4 * st) { f32x4 p[4], q[4];
#pragma unroll
          for (int k = 0; k < 4; ++k) if (i + k * st < n) { p[k] = __builtin_nontemporal_load(src + 2 * (i + k * st)); q[k] = __builtin_nontemporal_load(src + 2 * (i + k * st) + 1); }
#pragma unroll
          for (int k = 0; k < 4; ++k) if (i + k * st < n) { v4u o; o.x = pk2(p[k].x, p[k].y); o.y = pk2(p[k].z, p[k].w); o.z = pk2(q[k].x, q[k].y); o.w = pk2(q[k].z, q[k].w); dst[i + k * st] = o; } } }
}

__device__ __forceinline__ void load8(const bf16* p, float (&f)[8]) { const v4u w = *(const GAS v4u*)p; f[0] = bflo(w.x); f[1] = bfhi(w.x); f[2] = bflo(w.y); f[3] = bfhi(w.y); f[4] = bflo(w.z); f[5] = bfhi(w.z); f[6] = bflo(w.w); f[7] = bfhi(w.w); }
__device__ __forceinline__ void load8f(const float* p, float (&f)[8]) { const f32x4 a = *(const GAS f32x4*)p, b = *(const GAS f32x4*)(p + 4); f[0] = a.x; f[1] = a.y; f[2] = a.z; f[3] = a.w; f[4] = b.x; f[5] = b.y; f[6] = b.z; f[7] = b.w; }
__device__ __forceinline__ void acc8(const v4u w, float (&s)[8]) { s[0] += bflo(w.x); s[1] += bfhi(w.x); s[2] += bflo(w.y); s[3] += bfhi(w.y); s[4] += bflo(w.z); s[5] += bfhi(w.z); s[6] += bflo(w.w); s[7] += bfhi(w.w); }
__device__ __forceinline__ void mixer_stage_wp(LAS unsigned char* lds, const bf16* WPt, int wave, int lane) {
    const GAS char* gb = (const GAS char*)WPt + (size_t)wave * 16384;
    const unsigned rl4 = (unsigned)lane >> 4, l15 = (unsigned)lane & 15u;
#pragma unroll
    for (int n = 0; n < 16; ++n) { const unsigned rl = 4u * n + rl4;
        __builtin_amdgcn_global_load_lds((const GAS unsigned*)(gb + rl * 256u + ((l15 ^ (rl & 15u)) << 4)), (LAS unsigned*)(lds + (wave * 16 + n) * 1024), 16, 0, 0); }
}
__device__ __forceinline__ unsigned off_b(unsigned row, unsigned ch) { return 256u * row + 16u * (ch ^ (((row & 3u) << 2) | ((row >> 2) & 3u))); }
template <int GI> __device__ __forceinline__ void pool_issue(const Args& a, LAS unsigned char* tile, int row0, int nblk, bool sample, int lane) {
    constexpr int W = 2 << GI;
    const unsigned fr = lane & 15, fq = lane >> 4;
    const int nrows = 16 * nblk + W - 1, t0 = sample ? 0 : (row0 & 4095), sb = (row0 >> 4) & 15;
    const GAS char* wsb = (const GAS char*)a.ws;
#pragma unroll
    for (int n = 0; n < 16; ++n) if (n < 4 * nblk + 4) {
        const int r = 4 * n + (int)fq, tt = t0 - (W - 1) + r;
        unsigned o;
        if (r >= nrows) o = (unsigned)WS_ZERO;
        else if (tt >= 0) o = (unsigned)WS_P1 + (unsigned)(row0 - (W - 1) + r) * 3072u + (unsigned)(GI * 256);
        else o = sample ? (unsigned)WS_HISTU + (unsigned)(sb * 15 + 15 + tt) * 1024u + (unsigned)(GI * 256) : (unsigned)WS_ZERO;
        const unsigned lc = fr ^ ((fq << 2) | (unsigned)(n & 3));
        __builtin_amdgcn_global_load_lds((const GAS unsigned*)(wsb + o + (lc << 4)), (LAS unsigned*)(tile + n * 1024), 16, 0, 0); }
}
template <int GI> __device__ __forceinline__ void pool_compute(const Args& a, LAS unsigned char* lds, LAS unsigned char* tile, int row0, int nblk, bool sample, int lane) {
    constexpr int W = 2 << GI;
    const int fr = lane & 15, fq = lane >> 4;
    bf16x8 wf[4][8];
    { const bf16* wp = (const bf16*)(a.ws + WS_WP) + GI * 16384 + (size_t)fr * 128 + fq * 8;
#pragma unroll
      for (int ks = 0; ks < 4; ++ks)
#pragma unroll
          for (int db = 0; db < 8; ++db) wf[ks][db] = *(const GAS bf16x8*)(wp + db * 2048 + ks * 32); }
    const unsigned tb = (unsigned)(size_t)tile, qq = (unsigned)(lane & 15) >> 2, pp = (unsigned)lane & 3u;
    bf16x8 cfg;
    { float cw[8]; int fr_ = fr, r8 = 8 * fq; asm volatile("" : "+v"(fr_), "+v"(r8));
#pragma unroll
      for (int jj = 0; jj < 8; ++jj) { const int r = r8 + jj; cw[jj] = ((r >= fr_ && r <= fr_ + W - 1) ? (1.f / W) : 0.f) - (r == fr_ + W - 1 ? 1.f : 0.f); }
      v4u pc; pc.x = pk2(cw[0], cw[1]); pc.y = pk2(cw[2], cw[3]); pc.z = pk2(cw[4], cw[5]); pc.w = pk2(cw[6], cw[7]); cfg = __builtin_bit_cast(bf16x8, pc); }
    asm volatile("s_waitcnt vmcnt(0)" ::: "memory");
#pragma unroll 1
    for (int i = 0; i < nblk; ++i) {
        const int row = row0 + 16 * i + fr, t = sample ? fr : (row & 4095);
        const float inv = sample ? (1.f / W) : 1.f / (float)(t + 1 < W ? t + 1 : W);
        bf16x8 cf = cfg;
        if (!sample && ((row0 + 16 * i) & 4095) == 0) {
          float cw[8];
          int fr_ = fr, r8 = 8 * fq; asm volatile("" : "+v"(fr_), "+v"(r8));
#pragma unroll
          for (int jj = 0; jj < 8; ++jj) { const int r = r8 + jj; cw[jj] = ((r >= fr_ && r <= fr_ + W - 1) ? inv : 0.f) - (r == fr_ + W - 1 ? 1.f : 0.f); }
          v4u pc; pc.x = pk2(cw[0], cw[1]); pc.y = pk2(cw[2], cw[3]); pc.z = pk2(cw[4], cw[5]); pc.w = pk2(cw[6], cw[7]); cf = __builtin_bit_cast(bf16x8, pc); }
        v4u pa[4];
#pragma unroll
        for (int cb = 0; cb < 8; cb += 2) {
            unsigned ad[4];
#pragma unroll
            for (int k = 0; k < 4; ++k) { const unsigned c_ = cb + (k >> 1), tt = k & 1; ad[k] = tb + 4096u * i + off_b(8u * fq + 4u * tt + qq, 2u * c_ + (pp >> 1)) + 8u * (pp & 1u); }
            v2u r0, r1, r2, r3;
            asm volatile("ds_read_b64_tr_b16 %0, %4\n\tds_read_b64_tr_b16 %1, %5\n\tds_read_b64_tr_b16 %2, %6\n\tds_read_b64_tr_b16 %3, %7\n\ts_waitcnt lgkmcnt(0)"
                         : "=&v"(r0), "=&v"(r1), "=&v"(r2), "=&v"(r3) : "v"(ad[0]), "v"(ad[1]), "v"(ad[2]), "v"(ad[3]) : "memory");
            v4u f0; f0.x = r0.x; f0.y = r0.y; f0.z = r1.x; f0.w = r1.y;
            v4u f1; f1.x = r2.x; f1.y = r2.y; f1.z = r3.x; f1.w = r3.y;
            const pg8::f32x4 p0 = __builtin_amdgcn_mfma_f32_16x16x32_bf16(__builtin_bit_cast(bf16x8, f0), cf, (pg8::f32x4){0.f, 0.f, 0.f, 0.f}, 0, 0, 0);
            const pg8::f32x4 p1 = __builtin_amdgcn_mfma_f32_16x16x32_bf16(__builtin_bit_cast(bf16x8, f1), cf, (pg8::f32x4){0.f, 0.f, 0.f, 0.f}, 0, 0, 0);
            pa[cb >> 1].x = pk2c(p0[0], p0[1]); pa[cb >> 1].y = pk2c(p0[2], p0[3]); pa[cb >> 1].z = pk2c(p1[0], p1[1]); pa[cb >> 1].w = pk2c(p1[2], p1[3]);
        }
        pg8::f32x4 acc[8];
#pragma unroll
        for (int db = 0; db < 8; ++db) acc[db] = (pg8::f32x4){0.f, 0.f, 0.f, 0.f};
#pragma unroll
        for (int ks = 0; ks < 4; ++ks) { const bf16x8 pf = __builtin_bit_cast(bf16x8, pa[ks]);
#pragma unroll
            for (int db = 0; db < 8; ++db) acc[db] = __builtin_amdgcn_mfma_f32_16x16x32_bf16(wf[ks][db], pf, acc[db], 0, 0, 0); }
        float ss = 0.f;
#pragma unroll
        for (int db = 0; db < 8; ++db) ss += (acc[db][0] * acc[db][0] + acc[db][1] * acc[db][1]) + (acc[db][2] * acc[db][2] + acc[db][3] * acc[db][3]);
        ss += __shfl_xor(ss, 16); ss += __shfl_xor(ss, 32);
        const float rs = 1.f / sqrtf(ss * (1.f / 128.f) + EPS);
        bf16* MRG = (bf16*)(a.ws + WS_MRG);
#pragma unroll
        for (int db = 0; db < 8; ++db) { const f32x4 o = acc[db] * rs;
            v2u w; w.x = pk2(o[0], o[1]); w.y = pk2(o[2], o[3]); *(GAS v2u*)(MRG + (size_t)row * D + GI * 128 + 16 * db + 4 * fq) = w; }
    }
}
__device__ __forceinline__ f32x2 up2(unsigned w) { f32x2 r; r.x = bflo(w); r.y = bfhi(w); return r; }
__device__ __forceinline__ unsigned pk2v(f32x2 v) { const bf16n2 b = __builtin_convertvector(v, bf16n2); return __builtin_bit_cast(unsigned, b); }
template <int CTRL> __device__ __forceinline__ float dpp_f(float v) { return __builtin_bit_cast(float, __builtin_amdgcn_update_dpp(0, __builtin_bit_cast(int, v), CTRL, 0xf, 0xf, true)); }
__device__ __forceinline__ void conv_half(const Args& a, int row0, int half, bool sample, int lane) {
    const bf16* P1 = (const bf16*)(a.ws + WS_P1); bf16* MRG = (bf16*)(a.ws + WS_MRG);
    const int ch = 8 * lane, i0 = 8 * half;
    const bf16* histv = sample ? (const bf16*)(a.ws + WS_HISTV) + (size_t)(((row0 >> 4) & 15) * 2 + 2) * 512 : (const bf16*)(a.ws + WS_ZERO);
    const int hstep = sample ? 512 : 0, t0 = sample ? 0 : (row0 & 4095);
    v4u xv[10], xb[8];
#pragma unroll
    for (int k = 0; k < 10; ++k) { const int i = i0 + k - 2; const bf16* p = (t0 + i >= 0) ? P1 + (size_t)(row0 + i) * 1536 + 1024 : histv + (ptrdiff_t)i * hstep; xv[k] = *(const GAS v4u*)(p + ch); }
#pragma unroll
    for (int k = 0; k < 8; ++k) xb[k] = *(const GAS v4u*)(P1 + (size_t)(row0 + i0 + k) * 1536 + 512 + ch);
    f32x2 w0[4], w1[4], w2[4];
#pragma unroll
    for (int q = 0; q < 4; ++q) { w0[q] = *(const GAS f32x2*)(a.in[11] + ch + 2 * q); w1[q] = *(const GAS f32x2*)(a.in[11] + 512 + ch + 2 * q); w2[q] = *(const GAS f32x2*)(a.in[11] + 1024 + ch + 2 * q); }
    f32x2 va[4], vb[4], vc[4];
#pragma unroll
    for (int q = 0; q < 4; ++q) { va[q] = up2(xv[0][q]); vb[q] = up2(xv[1][q]); }
#pragma unroll
    for (int k = 0; k < 8; ++k) {
        f32x2 y[4]; f32x2 s2 = {0.f, 0.f};
#pragma unroll
        for (int q = 0; q < 4; ++q) { vc[q] = up2(xv[k + 2][q]); const f32x2 bg = up2(xb[k][q]);
            f32x2 cv = w0[q] * va[q]; cv = __builtin_elementwise_fma(w1[q], vb[q], cv); cv = __builtin_elementwise_fma(w2[q], vc[q], cv);
            y[q] = bg * cv; s2 = __builtin_elementwise_fma(y[q], y[q], s2); }
        float ss = s2.x + s2.y;
        ss += dpp_f<0xB1>(ss); ss += dpp_f<0x4E>(ss); ss += dpp_f<0x141>(ss);
        const float rs = 1.f / sqrtf(ss * (1.f / 64.f) + EPS);
        v4u o;
#pragma unroll
        for (int q = 0; q < 4; ++q) { const f32x2 r2 = {rs, rs}; o[q] = pk2v(y[q] * r2); }
        *(GAS v4u*)(MRG + (size_t)(row0 + i0 + k) * D + 512 + ch) = o;
#pragma unroll
        for (int q = 0; q < 4; ++q) { va[q] = vb[q]; vb[q] = vc[q]; }
    }
}
__device__ __forceinline__ void unpack8(const v4u w, float (&f)[8]) { f[0] = bflo(w.x); f[1] = bfhi(w.x); f[2] = bflo(w.y); f[3] = bfhi(w.y); f[4] = bflo(w.z); f[5] = bfhi(w.z); f[6] = bflo(w.w); f[7] = bfhi(w.w); }
__device__ __forceinline__ int mixer_blk(int xg, int bl) { return xg < 0 ? bl : (bl < 128 ? xg * 128 + bl : 1024 + xg * 2 + (bl - 128)); }
template <int GI> __device__ __forceinline__ void mixer_wave(const Args& a, LAS unsigned char* lds, int xg, int j, int nj, int wave, int lane) {
    LAS unsigned char* tile = lds + wave * 16384;
    if (xg >= 0 && nj == 56) {
        int bl0 = -1, nblk = 0;
        if (j < 42) { bl0 = 3 * j; nblk = 3; } else if (j == 42) { bl0 = 126; nblk = 2; } else if (j < 45) { bl0 = 128 + (j - 43); nblk = 1; }
        const int row0 = bl0 >= 0 ? mixer_blk(xg, bl0) * 16 : 0; const bool sample = row0 >= MP;
        if (nblk) pool_issue<GI>(a, tile, row0, nblk, sample, lane);
        int c0 = -1, c1 = -1;
        if (j >= 45) { c0 = 2 * (j - 45); c1 = c0 + 1; } else if (j <= 42) c0 = 22 + j;
        if (c0 >= 0) { const int h = 4 * c0 + GI, r0 = mixer_blk(xg, h >> 1) * 16; conv_half(a, r0, h & 1, r0 >= MP, lane); }
        if (c1 >= 0) { const int h = 4 * c1 + GI, r0 = mixer_blk(xg, h >> 1) * 16; conv_half(a, r0, h & 1, r0 >= MP, lane); }
        asm volatile("" ::: "memory");
        if (nblk) pool_compute<GI>(a, lds, tile, row0, nblk, sample, lane);
    } else {
        const int nb = xg >= 0 ? 130 : M / 16;
        for (int bl = j; bl < nb; bl += nj) { const int row0 = mixer_blk(xg, bl) * 16;
            pool_issue<GI>(a, tile, row0, 1, row0 >= MP, lane); pool_compute<GI>(a, lds, tile, row0, 1, row0 >= MP, lane); }
        for (int h = j * 4 + GI; h < 2 * nb; h += nj * 4) { const int r0 = mixer_blk(xg, h >> 1) * 16; conv_half(a, r0, h & 1, r0 >= MP, lane); }
    }
}
__device__ __forceinline__ void mixer_all(const Args& a, LAS unsigned char* lds, int xg, int cu, int ncu, int wave, int lane_) {
    int lane = lane_; asm volatile("" : "+v"(lane));
    const int gi = wave & 3, j = cu * 2 + (wave >> 2), nj = ncu * 2;
    if (gi == 0) mixer_wave<0>(a, lds, xg, j, nj, wave, lane);
    else if (gi == 1) mixer_wave<1>(a, lds, xg, j, nj, wave, lane);
    else if (gi == 2) mixer_wave<2>(a, lds, xg, j, nj, wave, lane);
    else mixer_wave<3>(a, lds, xg, j, nj, wave, lane);
}

__device__ __forceinline__ void resid_row(const float* base, const float* raw, const float* g, float* xo, bf16* xn, int lane_) {
    int lane = lane_; asm volatile("" : "+v"(lane));
    const GAS f32x4* rr = (const GAS f32x4*)raw + lane; const GAS f32x4* bb = (const GAS f32x4*)base + lane; const GAS f32x4* gg = (const GAS f32x4*)g + lane;
    f32x4 v[4]; float s = 0.f;
#pragma unroll
    for (int j = 0; j < 4; ++j) { v[j] = rr[64 * j]; s += (v[j].x * v[j].x + v[j].y * v[j].y) + (v[j].z * v[j].z + v[j].w * v[j].w); }
    const float rs = 1.f / sqrtf(wave_sum(s) * (1.f / D) + EPS);
    float s2 = 0.f;
#pragma unroll
    for (int j = 0; j < 4; ++j) { v[j] = bb[64 * j] + v[j] * rs * gg[64 * j]; s2 += (v[j].x * v[j].x + v[j].y * v[j].y) + (v[j].z * v[j].z + v[j].w * v[j].w); }
    GAS f32x4* oo = (GAS f32x4*)xo + lane;
#pragma unroll
    for (int j = 0; j < 4; ++j) oo[64 * j] = v[j];
    if (xn) { const float r2 = 1.f / sqrtf(wave_sum(s2) * (1.f / D) + EPS); GAS v2u* o8 = (GAS v2u*)xn + lane;
#pragma unroll
        for (int j = 0; j < 4; ++j) { v2u w; w.x = pk2(v[j].x * r2, v[j].y * r2); w.y = pk2(v[j].z * r2, v[j].w * r2); o8[64 * j] = w; } }
}

#define MFMA32(a, b, c) __builtin_amdgcn_mfma_f32_32x32x16_bf16((a), (b), (c), 0, 0, 0)
__device__ __forceinline__ bf16x8 pack8(const f32x16& x, int s) {
    v4u p; p.x = pk2(x[8 * s], x[8 * s + 1]); p.y = pk2(x[8 * s + 2], x[8 * s + 3]); p.z = pk2(x[8 * s + 4], x[8 * s + 5]); p.w = pk2(x[8 * s + 6], x[8 * s + 7]);
    return __builtin_bit_cast(bf16x8, p);
}
__device__ __forceinline__ void attn_stage(LAS unsigned char* lds, const bf16* G, unsigned pitch  , int wave, int lane) {
    const GAS char* gb = (const GAS char*)G + (size_t)wave * 32 * pitch;
    const unsigned hi = (unsigned)lane >> 5, l31 = (unsigned)lane & 31u;
#pragma unroll
    for (int n = 0; n < 16; ++n) { const unsigned rl = 2u * n + hi;
        const unsigned off = rl * pitch + ((l31 ^ (rl & 15u)) << 4);
        __builtin_amdgcn_global_load_lds((const GAS unsigned*)(gb + off), (LAS unsigned*)(lds + (wave * 16 + n) * 1024), 16, 0, 0); }
}
__device__ __forceinline__ void attn_unit(LAS unsigned char* lds, const bf16* Qb, bf16* Ob, unsigned qoff, const bf16* Kg, const bf16* VTg, bool store, int wave, int lane_) {
    int lane = lane_; asm volatile("" : "+v"(lane));
    const int r = lane & 31, h = lane >> 5;
    attn_stage(lds, Kg, 2048u, wave, lane);
    const GAS char* qp = (const GAS char*)Qb;
    const unsigned qo = qoff + 16u * h;
    const unsigned x = (unsigned)(h ^ (r & 15));
    const LAS unsigned char* fo[8]; const LAS unsigned char* fo2[8];
#pragma unroll
    for (int k = 0; k < 8; ++k) { fo[k] = lds + ((unsigned)r * 512u + (((unsigned)(2 * k) ^ x) * 16u)); fo2[k] = fo[k] + 65536; asm volatile("" : "+v"(fo2[k])); }
    bf16x8 qf[8];
#pragma unroll
    for (int k = 0; k < 8; ++k) qf[k] = *(const GAS bf16x8*)(qp + qo + 32 * k);
    asm volatile("s_waitcnt vmcnt(0)" ::: "memory"); __syncthreads();
    f32x16 s[8];
#pragma unroll
    for (int mb = 0; mb < 8; ++mb)
#pragma unroll
        for (int i = 0; i < 16; ++i) s[mb][i] = 0.f;
#pragma unroll
    for (int hf = 0; hf < 2; ++hf) {
        if (hf == 1) {
#pragma unroll
            for (int k = 0; k < 8; ++k) qf[k] = *(const GAS bf16x8*)(qp + qo + 256 + 32 * k);
        }
        bf16x8 kc[8], kn[8];
#pragma unroll
        for (int k = 0; k < 8; ++k) kc[k] = *(const LAS bf16x8*)(fo[k] + hf * 256);
#pragma unroll
        for (int mb = 0; mb < 8; ++mb) {
            if (mb < 7) {
#pragma unroll
                for (int k = 0; k < 8; ++k) kn[k] = *(const LAS bf16x8*)((mb + 1 < 4 ? fo[k] : fo2[k]) + (((mb + 1) & 3) * 16384 + hf * 256)); }
            __builtin_amdgcn_s_setprio(1);
#pragma unroll
            for (int k = 0; k < 8; ++k) s[mb] = MFMA32(kc[k], qf[k], s[mb]);
            __builtin_amdgcn_s_setprio(0);
#pragma unroll
            for (int k = 0; k < 8; ++k) kc[k] = kn[k];
            asm volatile("" ::: "memory");
        }
    }
    asm volatile("s_waitcnt lgkmcnt(0)" ::: "memory"); __syncthreads();
    { int lane2 = lane; asm volatile("" : "+v"(lane2)); attn_stage(lds, VTg, 512u, wave, lane2); }
    float mx = -3.0e38f;
#pragma unroll
    for (int mb = 0; mb < 8; ++mb)
#pragma unroll
        for (int i = 0; i < 16; ++i) mx = fmaxf(mx, s[mb][i]);
    mx = fmaxf(mx, __shfl_xor(mx, 32));
    float sum = 0.f;
#pragma unroll
    for (int mb = 0; mb < 8; ++mb)
#pragma unroll
        for (int i = 0; i < 16; ++i) { const float p = __builtin_amdgcn_exp2f((s[mb][i] - mx) * 1.44269504089f); s[mb][i] = p; sum += p; }
    sum += __shfl_xor(sum, 32);
    const float inv = 1.f / sum;
    bf16x8 pf[8][2];
#pragma unroll
    for (int mb = 0; mb < 8; ++mb) { pf[mb][0] = pack8(s[mb], 0); pf[mb][1] = pack8(s[mb], 1); }
    asm volatile("s_waitcnt vmcnt(0)" ::: "memory"); __syncthreads();
    GAS char* op = (GAS char*)Ob;
    bf16x8 vc[8], vn[8];
#pragma unroll
    for (int k = 0; k < 8; ++k) vc[k] = *(const LAS bf16x8*)(fo[k]);
#pragma unroll
    for (int eb = 0; eb < 8; ++eb) {
        f32x16 o;
#pragma unroll
        for (int i = 0; i < 16; ++i) o[i] = 0.f;
#pragma unroll
        for (int hv = 0; hv < 2; ++hv) {
            const int nstep = 2 * eb + hv + 1;
            if (nstep < 16) { const int neb = nstep >> 1, nhv = nstep & 1;
#pragma unroll
                for (int k = 0; k < 8; ++k) vn[k] = *(const LAS bf16x8*)((neb < 4 ? fo[k] : fo2[k]) + ((neb & 3) * 16384 + nhv * 256)); }
            __builtin_amdgcn_s_setprio(1);
#pragma unroll
            for (int k = 0; k < 8; ++k) o = MFMA32(vc[k], pf[4 * hv + (k >> 1)][k & 1], o);
            __builtin_amdgcn_s_setprio(0);
#pragma unroll
            for (int k = 0; k < 8; ++k) vc[k] = vn[k];
            asm volatile("" ::: "memory");
        }
        if (store) {
#pragma unroll
            for (int g = 0; g < 4; ++g) { v2u w; w.x = pk2(o[4 * g] * inv, o[4 * g + 1] * inv); w.y = pk2(o[4 * g + 2] * inv, o[4 * g + 3] * inv);
                *(GAS v2u*)(op + qoff + 8u * h + (64 * eb + 16 * g)) = w; }
        }
    }
    asm volatile("s_waitcnt lgkmcnt(0)" ::: "memory"); __syncthreads();
}

__device__ __forceinline__ void attn_unit_small(LAS unsigned char* lds, const bf16* Qb, bf16* Ob, const bf16* Kg, const bf16* VTg, int wave, int lane_) {
    int lane = lane_; asm volatile("" : "+v"(lane));
    const int r = lane & 31, h = lane >> 5;
    const GAS char* qp = (const GAS char*)Qb; const GAS char* kp = (const GAS char*)Kg + (size_t)wave * 65536; const GAS char* vp = (const GAS char*)VTg + (size_t)wave * 16384;
    const unsigned qo = (unsigned)(r & 15) * 2048u + 16u * h, ko = (unsigned)r * 2048u + 16u * h, vo = (unsigned)r * 512u + 16u * h;
    bf16x8 qf[16], kf[16], vf[16];
#pragma unroll
    for (int ks = 0; ks < 16; ++ks) { qf[ks] = *(const GAS bf16x8*)(qp + qo + 32 * ks); kf[ks] = *(const GAS bf16x8*)(kp + ko + 32 * ks); }
#pragma unroll
    for (int c = 0; c < 16; ++c) vf[c] = *(const GAS bf16x8*)(vp + vo + 32 * c);
    f32x16 s;
#pragma unroll
    for (int i = 0; i < 16; ++i) s[i] = 0.f;
#pragma unroll
    for (int ks = 0; ks < 16; ++ks) s = MFMA32(kf[ks], qf[ks], s);
    LAS float* red = (LAS float*)lds;
    LAS unsigned char* pbuf = lds + 4096;
    float mx = s[0];
#pragma unroll
    for (int i = 1; i < 16; ++i) mx = fmaxf(mx, s[i]);
    mx = fmaxf(mx, __shfl_xor(mx, 32));
    if (h == 0) red[wave * 32 + r] = mx;
    asm volatile("s_waitcnt lgkmcnt(0)" ::: "memory"); __syncthreads();
#pragma unroll
    for (int w = 0; w < 8; ++w) mx = fmaxf(mx, red[w * 32 + r]);
    float sum = 0.f;
#pragma unroll
    for (int i = 0; i < 16; ++i) { const float p = __builtin_amdgcn_exp2f((s[i] - mx) * 1.44269504089f); s[i] = p; sum += p; }
    sum += __shfl_xor(sum, 32);
    if (h == 0) red[256 + wave * 32 + r] = sum;
    *(LAS bf16x8*)(pbuf + (wave * 2 + 0) * 1024 + lane * 16) = pack8(s, 0);
    *(LAS bf16x8*)(pbuf + (wave * 2 + 1) * 1024 + lane * 16) = pack8(s, 1);
    asm volatile("s_waitcnt lgkmcnt(0)" ::: "memory"); __syncthreads();
    float tot = 0.f;
#pragma unroll
    for (int w = 0; w < 8; ++w) tot += red[256 + w * 32 + r];
    const float inv = 1.f / tot;
    f32x16 o;
#pragma unroll
    for (int i = 0; i < 16; ++i) o[i] = 0.f;
#pragma unroll
    for (int c = 0; c < 16; ++c) { const bf16x8 pf = *(const LAS bf16x8*)(pbuf + c * 1024 + lane * 16); o = MFMA32(vf[c], pf, o); }
    if (r < 16) { GAS char* op = (GAS char*)Ob + (unsigned)r * 2048u + 8u * h + 64u * wave;
#pragma unroll
        for (int g = 0; g < 4; ++g) { v2u w2; w2.x = pk2(o[4 * g] * inv, o[4 * g + 1] * inv); w2.y = pk2(o[4 * g + 2] * inv, o[4 * g + 3] * inv); *(GAS v2u*)(op + 16 * g) = w2; } }
    asm volatile("s_waitcnt lgkmcnt(0)" ::: "memory"); __syncthreads();
}

template <int NT, int KCH>
__device__ __forceinline__ void micro_gemm(LAS unsigned char* lds, const bf16* A, int lda, const bf16* Bt, int ldb, const int (&cb)[NT], int wave, int lane_, int tid_, float (&val)[NT][2]) {
    int lane = lane_, tid = tid_; asm volatile("" : "+v"(lane), "+v"(tid));
    constexpr int KB = (KCH > 8 && NT == 1) ? 16 : 8;
    const int r = lane & 31, h = lane >> 5;
    const GAS char* ap = (const GAS char*)A; const GAS char* bp = (const GAS char*)Bt;
    const unsigned ao = ((unsigned)r * lda + wave * (KCH * 16) + 8 * h) * 2u, bo = ((unsigned)r * ldb + wave * (KCH * 16) + 8 * h) * 2u;
    f32x16 acc[NT];
#pragma unroll
    for (int nt = 0; nt < NT; ++nt)
#pragma unroll
        for (int i = 0; i < 16; ++i) acc[nt][i] = 0.f;
#pragma unroll 1
    for (int kc = 0; kc < KCH; kc += KB) {
        bf16x8 af[KB], bfr[NT][KB];
#pragma unroll
        for (int i = 0; i < KB; ++i) af[i] = *(const GAS bf16x8*)(ap + ao + (kc + i) * 32);
#pragma unroll
        for (int nt = 0; nt < NT; ++nt)
#pragma unroll
            for (int i = 0; i < KB; ++i) bfr[nt][i] = *(const GAS bf16x8*)(bp + (size_t)cb[nt] * ldb * 2 + bo + (kc + i) * 32);
#pragma unroll
        for (int nt = 0; nt < NT; ++nt)
#pragma unroll
            for (int i = 0; i < KB; ++i) acc[nt] = MFMA32(af[i], bfr[nt][i], acc[nt]);
    }
    LAS float* part = (LAS float*)lds;
#pragma unroll
    for (int nt = 0; nt < NT; ++nt)
#pragma unroll
        for (int i = 0; i < 16; ++i) part[(wave * NT + nt) * 1024 + ((i & 3) + 8 * (i >> 2) + 4 * h) * 32 + r] = acc[nt][i];
    __syncthreads();
#pragma unroll
    for (int nt = 0; nt < NT; ++nt) { float s0 = 0.f, s1 = 0.f;
#pragma unroll
        for (int w = 0; w < 8; ++w) { const f32x2 p = *(const LAS f32x2*)(part + (w * NT + nt) * 1024 + 2 * tid); s0 += p.x; s1 += p.y; }
        val[nt][0] = s0; val[nt][1] = s1; }
}
__device__ __forceinline__ void micro_gemm_lds(LAS unsigned char* lds, const bf16* A, int lda, const bf16* Bt, int ldb, int cb0, int wave, int lane_, int tid_, float (&val)[1][2]) {
    int lane = lane_, tid = tid_; asm volatile("" : "+v"(lane), "+v"(tid));
    const int r = lane & 31, h = lane >> 5;
    LAS unsigned char* reg = lds + wave * 16384;
    __syncthreads();
    { const unsigned rq = (unsigned)lane >> 4, pc = (unsigned)lane & 15u;
      const GAS char* ap = (const GAS char*)A + wave * 256; const GAS char* bp = (const GAS char*)(Bt + (size_t)cb0 * ldb) + wave * 256;
#pragma unroll
      for (int n = 0; n < 8; ++n) { const unsigned row = 4u * n + rq, lc = pc ^ (row & 15u);
          __builtin_amdgcn_global_load_lds((const GAS unsigned*)(ap + row * (unsigned)(lda * 2) + lc * 16u), (LAS unsigned*)(reg + n * 1024), 16, 0, 0); }
#pragma unroll
      for (int n = 0; n < 8; ++n) { const unsigned row = 4u * n + rq, lc = pc ^ (row & 15u);
          __builtin_amdgcn_global_load_lds((const GAS unsigned*)(bp + row * (unsigned)(ldb * 2) + lc * 16u), (LAS unsigned*)(reg + 8192 + n * 1024), 16, 0, 0); } }
    f32x16 acc;
#pragma unroll
    for (int i = 0; i < 16; ++i) acc[i] = 0.f;
    const LAS unsigned char* fa = reg + r * 256; const unsigned x = (unsigned)(r & 15);
    asm volatile("s_waitcnt vmcnt(0)" ::: "memory");
    bf16x8 af[8], bfr[8];
#pragma unroll
    for (int i = 0; i < 8; ++i) { const unsigned pcx = ((unsigned)(2 * i + h) ^ x) * 16u; af[i] = *(const LAS bf16x8*)(fa + pcx); bfr[i] = *(const LAS bf16x8*)(fa + 8192 + pcx); }
#pragma unroll
    for (int i = 0; i < 8; ++i) acc = MFMA32(af[i], bfr[i], acc);
    asm volatile("s_waitcnt lgkmcnt(0)" ::: "memory");
    LAS float* part = (LAS float*)reg;
#pragma unroll
    for (int i = 0; i < 16; ++i) part[((i & 3) + 8 * (i >> 2) + 4 * h) * 32 + r] = acc[i];
    __syncthreads();
    float s0 = 0.f, s1 = 0.f;
#pragma unroll
    for (int w = 0; w < 8; ++w) { const f32x2 p = *(const LAS f32x2*)((const LAS float*)(lds + w * 16384) + 2 * tid); s0 += p.x; s1 += p.y; }
    val[0][0] = s0; val[0][1] = s1;
}
__device__ __forceinline__ void micro_gemm_lds_k4096(LAS unsigned char* lds, const bf16* A, int lda, const bf16* Bt, int ldb, int cb0, int wave, int lane_, int tid_, float (&val)[1][2]) {
    int lane = lane_, tid = tid_; asm volatile("" : "+v"(lane), "+v"(tid));
    const int r = lane & 31, h = lane >> 5;
    LAS unsigned char* reg = lds + wave * 16384;
    __syncthreads();
    const unsigned rq = (unsigned)lane >> 3, pc = (unsigned)lane & 7u;
    const GAS char* ap = (const GAS char*)A + wave * 128; const GAS char* bp = (const GAS char*)(Bt + (size_t)cb0 * ldb) + wave * 128;
    unsigned ao[4], bo[4];
#pragma unroll
    for (int n = 0; n < 4; ++n) { const unsigned row = 8u * n + rq, lc = pc ^ ((row >> 1) & 7u); ao[n] = row * (unsigned)(lda * 2) + lc * 16u; bo[n] = row * (unsigned)(ldb * 2) + lc * 16u; }
#define MG4K_ISSUE(rd) do { LAS unsigned char* dst_ = reg + ((rd) & 1) * 8192; \
        _Pragma("unroll") for (int n = 0; n < 4; ++n) __builtin_amdgcn_global_load_lds((const GAS unsigned*)(ap + (rd) * 1024 + ao[n]), (LAS unsigned*)(dst_ + n * 1024), 16, 0, 0); \
        _Pragma("unroll") for (int n = 0; n < 4; ++n) __builtin_amdgcn_global_load_lds((const GAS unsigned*)(bp + (rd) * 1024 + bo[n]), (LAS unsigned*)(dst_ + 4096 + n * 1024), 16, 0, 0); } while (0)
    f32x16 acc;
#pragma unroll
    for (int i = 0; i < 16; ++i) acc[i] = 0.f;
    const unsigned x = (unsigned)(r >> 1) & 7u;
    MG4K_ISSUE(0);
#pragma unroll
    for (int rd = 0; rd < 8; ++rd) {
        if (rd < 7) { MG4K_ISSUE(rd + 1); asm volatile("s_waitcnt vmcnt(8)" ::: "memory"); } else asm volatile("s_waitcnt vmcnt(0)" ::: "memory");
        const LAS unsigned char* fa = reg + (rd & 1) * 8192 + r * 128;
        bf16x8 af[4], bfr[4];
#pragma unroll
        for (int i = 0; i < 4; ++i) { const unsigned pcx = ((unsigned)(2 * i + h) ^ x) * 16u; af[i] = *(const LAS bf16x8*)(fa + pcx); bfr[i] = *(const LAS bf16x8*)(fa + 4096 + pcx); }
#pragma unroll
        for (int i = 0; i < 4; ++i) acc = MFMA32(af[i], bfr[i], acc);
        asm volatile("s_waitcnt lgkmcnt(0)" ::: "memory");
    }
#undef MG4K_ISSUE
    LAS float* part = (LAS float*)reg;
#pragma unroll
    for (int i = 0; i < 16; ++i) part[((i & 3) + 8 * (i >> 2) + 4 * h) * 32 + r] = acc[i];
    __syncthreads();
    float s0 = 0.f, s1 = 0.f;
#pragma unroll
    for (int w = 0; w < 8; ++w) { const f32x2 p = *(const LAS f32x2*)((const LAS float*)(lds + w * 16384) + 2 * tid); s0 += p.x; s1 += p.y; }
    val[0][0] = s0; val[0][1] = s1;
}
template <int NT>
__device__ __forceinline__ void micro_gemm_lds_nt(LAS unsigned char* lds, const bf16* A, int lda, const bf16* Bt, int ldb, const int (&cb)[NT], int wave, int lane_, int tid_, float (&val)[NT][2]) {
    int lane = lane_, tid = tid_; asm volatile("" : "+v"(lane), "+v"(tid));
    const int r = lane & 31, h = lane >> 5;
    LAS unsigned char* reg = lds + wave * 16384;
    __syncthreads();
    { const unsigned rq = (unsigned)lane >> 4, pc = (unsigned)lane & 15u; const GAS char* ap = (const GAS char*)A + wave * 256;
#pragma unroll
      for (int n = 0; n < 8; ++n) { const unsigned row = 4u * n + rq, lc = pc ^ (row & 15u);
          __builtin_amdgcn_global_load_lds((const GAS unsigned*)(ap + row * (unsigned)(lda * 2) + lc * 16u), (LAS unsigned*)(reg + n * 1024), 16, 0, 0); } }
    const unsigned rq8 = (unsigned)lane >> 3, pc8 = (unsigned)lane & 7u;
    unsigned bo[4];
#pragma unroll
    for (int n = 0; n < 4; ++n) { const unsigned row = 8u * n + rq8, lc = pc8 ^ ((row >> 1) & 7u); bo[n] = row * (unsigned)(ldb * 2) + lc * 16u; }
    const GAS char* bbase = (const GAS char*)Bt + wave * 256;
#define MGNT_ISSUE(rd) do { LAS unsigned char* dst_ = reg + 8192 + ((rd) & 1) * 4096; const GAS char* bp_ = bbase + (size_t)cb[(rd) >> 1] * ldb * 2 + ((rd) & 1) * 128; \
        _Pragma("unroll") for (int n = 0; n < 4; ++n) __builtin_amdgcn_global_load_lds((const GAS unsigned*)(bp_ + bo[n]), (LAS unsigned*)(dst_ + n * 1024), 16, 0, 0); } while (0)
    MGNT_ISSUE(0);
    f32x16 acc[NT];
#pragma unroll
    for (int nt = 0; nt < NT; ++nt)
#pragma unroll
        for (int i = 0; i < 16; ++i) acc[nt][i] = 0.f;
    asm volatile("s_waitcnt vmcnt(4)" ::: "memory");
    bf16x8 af[8];
    { const LAS unsigned char* fa = reg + r * 256; const unsigned x = (unsigned)(r & 15);
#pragma unroll
      for (int i = 0; i < 8; ++i) af[i] = *(const LAS bf16x8*)(fa + (((unsigned)(2 * i + h) ^ x) * 16u)); }
    const unsigned x8 = (unsigned)(r >> 1) & 7u;
#pragma unroll
    for (int rd = 0; rd < 2 * NT; ++rd) {
        if (rd + 1 < 2 * NT) { MGNT_ISSUE(rd + 1); asm volatile("s_waitcnt vmcnt(4)" ::: "memory"); } else asm volatile("s_waitcnt vmcnt(0)" ::: "memory");
        const LAS unsigned char* fb = reg + 8192 + (rd & 1) * 4096 + r * 128;
        bf16x8 bfr[4];
#pragma unroll
        for (int i = 0; i < 4; ++i) bfr[i] = *(const LAS bf16x8*)(fb + (((unsigned)(2 * i + h) ^ x8) * 16u));
#pragma unroll
        for (int i = 0; i < 4; ++i) acc[rd >> 1] = MFMA32(af[4 * (rd & 1) + i], bfr[i], acc[rd >> 1]);
        asm volatile("s_waitcnt lgkmcnt(0)" ::: "memory");
    }
#undef MGNT_ISSUE
    LAS float* part = (LAS float*)reg;
#pragma unroll
    for (int nt = 0; nt < NT; ++nt)
#pragma unroll
        for (int i = 0; i < 16; ++i) part[nt * 1024 + ((i & 3) + 8 * (i >> 2) + 4 * h) * 32 + r] = acc[nt][i];
    __syncthreads();
#pragma unroll
    for (int nt = 0; nt < NT; ++nt) { float s0 = 0.f, s1 = 0.f;
#pragma unroll
        for (int w = 0; w < 8; ++w) { const f32x2 p = *(const LAS f32x2*)((const LAS float*)(lds + w * 16384) + nt * 1024 + 2 * tid); s0 += p.x; s1 += p.y; }
        val[nt][0] = s0; val[nt][1] = s1; }
}
__device__ __forceinline__ void sample_gemm1_piece(const Args& a, LAS unsigned char* lds, int p, int wave, int lane, int tid_) {
    int tid = tid_; asm volatile("" : "+v"(tid));
    const int rg = p & 7, cp = p >> 3; int cb[2];
    if (cp < 16) { cb[0] = 64 * cp; cb[1] = 64 * cp + 32; } else { const int q = cp - 16; cb[0] = 1024 + 256 * (q >> 2) + 32 * (q & 3); cb[1] = cb[0] + 128; }
    float val[2][2];
    micro_gemm_lds_nt<2>(lds, (const bf16*)(a.ws + WS_XN) + (size_t)(MP + 32 * rg) * D, D, (const bf16*)(a.ws + WS_WIN), D, cb, wave, lane, tid, val);
    const int rs_ = 32 * rg + (tid >> 4), row = MP + rs_, t = rs_ & 15, sb = rs_ >> 4, c2 = 2 * (tid & 15);
    bf16* P1 = (bf16*)(a.ws + WS_P1) + (size_t)row * 1536;
    if (cp < 16) {
#pragma unroll
        for (int nt = 0; nt < 2; ++nt) { const int col = cb[nt] + c2; *(GAS unsigned*)(P1 + col) = pk2(val[nt][0], val[nt][1]);
            if (cp < 8 && t >= 1) *(GAS f32x2*)(a.out + OUT_POOL_S + (size_t)(sb * 15 + t - 1) * 512 + col) = (f32x2){val[nt][0], val[nt][1]}; }
    } else {
        const int ch = 32 * (cp - 16) + c2; const float v0 = val[0][0] * val[1][0], v1 = val[0][1] * val[1][1];
        *(GAS unsigned*)(P1 + 1024 + ch) = pk2(v0, v1);
        if (t >= 14) *(GAS f32x2*)(a.out + OUT_CONV_S + (size_t)(sb * 2 + t - 14) * 512 + ch) = (f32x2){v0, v1};
    }
    __syncthreads();
}
struct SampleX { unsigned* xbuf; unsigned* cnt; float* rsp; unsigned* tmo; };
template <int NT, int KCH, int MODE>
__device__ __forceinline__ void sample_gemm_piece(LAS unsigned char* lds, const bf16* A, int K, const bf16* Bt, bf16* C, int ldc, const float* rsp, int p, int wave, int lane, int tid_) {
    int tid = tid_; asm volatile("" : "+v"(tid));
    const int rg = p & 7, cp = p >> 3; int cb[NT];
#pragma unroll
    for (int nt = 0; nt < NT; ++nt) cb[nt] = 32 * NT * cp + 32 * nt;
    const int rl = 32 * rg + (tid >> 4); const size_t row = MP + rl; const int c2 = 2 * (tid & 15);
    f32x4 pr[8];
    if (rsp) { const GAS f32x4* pp = (const GAS f32x4*)(rsp + (size_t)rl * 32);
#pragma unroll
        for (int k = 0; k < 8; ++k) pr[k] = pp[k]; }
    float val[NT][2];
    if constexpr (NT == 1 && KCH == 8) micro_gemm_lds(lds, A + (size_t)(MP + 32 * rg) * K, K, Bt, K, cb[0], wave, lane, tid, val);
    else if constexpr (KCH == 8) micro_gemm_lds_nt<NT>(lds, A + (size_t)(MP + 32 * rg) * K, K, Bt, K, cb, wave, lane, tid, val);
    else micro_gemm<NT, KCH>(lds, A + (size_t)(MP + 32 * rg) * K, K, Bt, K, cb, wave, lane, tid, val);
    float rs = 1.f;
    if (rsp) { f32x4 t = pr[0];
#pragma unroll
        for (int k = 1; k < 8; ++k) t = t + pr[k];
        rs = 1.f / sqrtf(((t[0] + t[1]) + (t[2] + t[3])) * (1.f / D) + EPS); }
#pragma unroll
    for (int nt = 0; nt < NT; ++nt) {
        float v0 = val[nt][0] * rs, v1 = val[nt][1] * rs;
        if (MODE == 2) { v0 = fmaxf(v0, 0.f); v0 *= v0; v1 = fmaxf(v1, 0.f); v1 *= v1; }
        *(GAS unsigned*)(C + row * ldc + cb[nt] + c2) = pk2(v0, v1);
    }
    __syncthreads();
}
template <int KCH>
__device__ __forceinline__ void sample_fused_A(LAS unsigned char* lds, const bf16* A, int K, const bf16* Bt, const SampleX& sx, int p, int wave, int lane, int tid_) {
    int tid = tid_; asm volatile("" : "+v"(tid));
    const int rg = p & 7, cp = p >> 3; int cb[1] = {32 * cp};
    float val[1][2];
    if constexpr (KCH == 8) micro_gemm_lds(lds, A + (size_t)(MP + 32 * rg) * K, K, Bt, K, cb[0], wave, lane, tid, val);
    else if constexpr (KCH == 32) micro_gemm_lds_k4096(lds, A + (size_t)(MP + 32 * rg) * K, K, Bt, K, cb[0], wave, lane, tid, val);
    else micro_gemm<1, KCH>(lds, A + (size_t)(MP + 32 * rg) * K, K, Bt, K, cb, wave, lane, tid, val);
    const int rl = 32 * rg + (tid >> 4);
    float s = val[0][0] * val[0][0] + val[0][1] * val[0][1];
    s += __shfl_xor(s, 1); s += __shfl_xor(s, 2); s += __shfl_xor(s, 4); s += __shfl_xor(s, 8);
    if ((tid & 15) == 0) __hip_atomic_store(sx.xbuf + (size_t)rl * 32 + cp, __float_as_uint(s), __ATOMIC_RELAXED, __HIP_MEMORY_SCOPE_AGENT);
    *(LAS f32x2*)(lds + STASH_OFF + tid * 8) = (f32x2){val[0][0], val[0][1]};
    asm volatile("s_waitcnt vmcnt(0) lgkmcnt(0)" ::: "memory"); __syncthreads();
    if (tid == 0) __hip_atomic_fetch_add(sx.cnt + 64 * rg, 1u, __ATOMIC_RELAXED, __HIP_MEMORY_SCOPE_AGENT);
}
template <bool FINAL>
__device__ __forceinline__ void sample_fused_B(LAS unsigned char* lds, const float* base, const float* g, float* Y, bf16* X, const SampleX& sx, int p, int wave, int lane, int tid_) {
    int tid = tid_; asm volatile("" : "+v"(tid));
    const int rg = p & 7, cp = p >> 3;
    const int rl = 32 * rg + (tid >> 4); const int col = 32 * cp + 2 * (tid & 15);
    const f32x2 bs = *(const GAS f32x2*)(base + (size_t)rl * D + col), gv = *(const GAS f32x2*)(g + col);
    if (wave == 0) { unsigned sp = 0;
        while ((unsigned)__builtin_amdgcn_readfirstlane(__hip_atomic_load(sx.cnt + 64 * rg, __ATOMIC_RELAXED, __HIP_MEMORY_SCOPE_AGENT)) < 32u) {
            __builtin_amdgcn_s_sleep(2);
            if ((++sp & 1023u) == 0u) { if (__hip_atomic_load(sx.tmo, __ATOMIC_RELAXED, __HIP_MEMORY_SCOPE_AGENT) != 0u) break; if (sp > (1u << 22)) { if (lane == 0) __hip_atomic_store(sx.tmo, 1u, __ATOMIC_RELAXED, __HIP_MEMORY_SCOPE_AGENT); break; } } }
        }
    __syncthreads();
    float tot = 0.f;
    { const unsigned* slot = sx.xbuf + (size_t)rl * 32;
#pragma unroll
      for (int k = 0; k < 32; ++k) tot += __uint_as_float(__hip_atomic_load(slot + k, __ATOMIC_RELAXED, __HIP_MEMORY_SCOPE_AGENT)); }
    const f32x2 val = *(const LAS f32x2*)(lds + STASH_OFF + tid * 8);
    const float rs = 1.f / sqrtf(tot * (1.f / D) + EPS);
    const float x0 = bs[0] + val[0] * rs * gv[0], x1 = bs[1] + val[1] * rs * gv[1];
    *(GAS f32x2*)(Y + (size_t)rl * D + col) = (f32x2){x0, x1};
    if (!FINAL) {
        *(GAS unsigned*)(X + (size_t)rl * D + col) = pk2(x0, x1);
        float q = x0 * x0 + x1 * x1;
        q += __shfl_xor(q, 1); q += __shfl_xor(q, 2); q += __shfl_xor(q, 4); q += __shfl_xor(q, 8);
        if ((tid & 15) == 0) sx.rsp[(size_t)rl * 32 + cp] = q;
    }
    __syncthreads();
}
template <int KCH, bool FINAL>
__device__ __forceinline__ void sample_fused_piece(LAS unsigned char* lds, const bf16* A, int K, const bf16* Bt, const float* base, const float* g, float* Y, bf16* X, const SampleX& sx, int p, int wave, int lane, int tid) {
    sample_fused_A<KCH>(lds, A, K, Bt, sx, p, wave, lane, tid);
    sample_fused_B<FINAL>(lds, base, g, Y, X, sx, p, wave, lane, tid);
}

__global__ void __launch_bounds__(NWAVES * 64, 2) enc_fwd(Args args) {
    extern __shared__ __attribute__((aligned(16))) unsigned char lds_raw[];
    LAS unsigned char* lds = (LAS unsigned char*)lds_raw;
    volatile LAS unsigned* MISC = (volatile LAS unsigned*)(lds + MISC_OFF);
    const int tid = threadIdx.x, lane = tid & 63, wave = __builtin_amdgcn_readfirstlane(tid >> 6);
    const int G = gridDim.x; const int bx = blockIdx.x; const int vcu = (G % 8 == 0) ? (bx % 8) * (G / 8) + bx / 8 : bx;
    const int gw = vcu * NWAVES + wave, NGW = G * NWAVES;
    unsigned char* ws = args.ws;
    unsigned* ctl = (unsigned*)(ws + WS_CTL);
    for (int u = tid; u < (LDS_BYTES - LDSCTL_OFF) / 4; u += NWAVES * 64) ((LAS unsigned*)(lds + LDSCTL_OFF))[u] = 0u;
    __syncthreads();
    XcdBarrier bar = xcd_barrier_post(ctl + CW_BAR, MISC + 8);
#define GRID_BAR() do { xcd_arrive(bar); xcd_wait(bar); } while (0)
    if (tid == 0) { unsigned* gp = ctl + CW_BAR + XB_GRP(bx & 7); const unsigned me = bar.x + 1u;
        const unsigned prev = atomicCAS(gp, 0u, me);
        if (prev != 0u && prev != me) __hip_atomic_store(ctl + CW_BAR + XB_MIS, 1u, __ATOMIC_RELAXED, __HIP_MEMORY_SCOPE_AGENT); }
    bf16* XN = (bf16*)(ws + WS_XN);
    float* Y = args.out + OUT_Y;

    p0_prologue(args, lds, gw, NGW, wave, lane);
    GRID_BAR();

    const bool localok = G == 256 && __hip_atomic_load(ctl + CW_BAR + XB_MIS, __ATOMIC_RELAXED, __HIP_MEMORY_SCOPE_AGENT) == 0u;
#define LOCAL_BAR() do { if (localok) xcd_local_barrier(bar); else GRID_BAR(); } while (0)
    if (bx & 1) for (int p = bx; p < 256; p += G) sample_gemm1_piece(args, lds, p, wave, lane, tid);
    { pg8::Gemm g{XN, (const bf16*)(ws + WS_WIN), MP, NIN, D}; pg8::StaticOrder S; S.init(MP, NIN, G, bx);
      pg8::Epi1 E{(bf16*)(ws + WS_P1), args.out + OUT_POOL_P, args.out + OUT_CONV_P, args.out + OUT_POOL_S, args.out + OUT_CONV_S};
      pg8::gemm_phase<pg8::Epi1, pg8::StaticOrder, true, true>(lds, g, S, E); }
    if (!(bx & 1)) for (int p = bx; p < 256; p += G) sample_gemm1_piece(args, lds, p, wave, lane, tid);
    GRID_BAR();

    if (bx < 32 && G > 32) {
      pg8::Gemm g{(const bf16*)(ws + WS_MN), (const bf16*)(ws + WS_WKV), 1024, 2048, D}; pg8::StaticOrder S; S.init(1024, 2048, 32, bx);
      pg8::EpiKV E{args.out + OUT_MK, args.out + OUT_MV, (bf16*)(ws + WS_KB), (bf16*)(ws + WS_VT)};
      pg8::gemm_phase<pg8::EpiKV, pg8::StaticOrder, true, true>(lds, g, S, E);
    } else {
      const int gw2 = (bx - 32) * NWAVES + wave, NGW2 = (G - 32) * NWAVES;
      if (G == 256) mixer_all(args, lds, bx & 7, (bx - 32) >> 3, 28, wave, lane);
      else mixer_all(args, lds, -1, bx - 32, G - 32, wave, lane);
      if (G == 256) { const int lw = ((bx - 32) >> 3) * NWAVES + wave, xg = bx & 7, NV = (180 + 2 * 44) * 8;
          if (lw < 180) p2_late(args, lds, lw * 8 + xg, NV, wave, lane);
          else { p2_late(args, lds, (180 + 2 * (lw - 180)) * 8 + xg, NV, wave, lane); p2_late(args, lds, (181 + 2 * (lw - 180)) * 8 + xg, NV, wave, lane); } }
      else { __syncthreads(); p2_late(args, lds, gw2, NGW2, wave, lane); }
    }
    GRID_BAR();

    bf16* SQO = (bf16*)(ws + WS_SQO) - (size_t)MP * D; bf16* SAO = (bf16*)(ws + WS_SAO) - (size_t)MP * D; bf16* SHID = (bf16*)(ws + WS_SHID) - (size_t)MP * FF;
    unsigned* tmo = ctl + CW_TMO;
    float* Ys = Y + (size_t)MP * D; bf16* XNs = XN + (size_t)MP * D;
    const SampleX sx0{(unsigned*)(ws + WS_SXB), ctl + CW_SSEAM, (float*)(ws + WS_SRSP), tmo};
    const SampleX sx1{(unsigned*)(ws + WS_SXB + 32768), ctl + CW_SSEAM + 512, (float*)(ws + WS_SRSP + 32768), tmo};
    const SampleX sx2{(unsigned*)(ws + WS_SXB + 65536), ctl + CW_SSEAM + 1024, nullptr, tmo};

    { pg8::Gemm g{(const bf16*)(ws + WS_MRG), (const bf16*)(ws + WS_WOUT), MP, D, D}; pg8::StaticOrder S; S.init(MP, D, G, bx);
      pg8::EpiRes<1> E{(const float*)(ws + WS_RNORM), XN, nullptr, args.in[15], (unsigned*)(ws + WS_XB1), ctl + CW_SEAM, (float*)(ws + WS_RSP1), tmo};
      if (G == 256) sample_fused_A<8>(lds, (const bf16*)(ws + WS_MRG), D, (const bf16*)(ws + WS_WOUT), sx0, bx, wave, lane, tid);
      pg8::gemm_phase<pg8::EpiRes<1>, pg8::StaticOrder, false, true>(lds, g, S, E); }
    if (G == 256) sample_fused_B<false>(lds, args.in[1], args.in[15], Ys, XNs, sx0, bx, wave, lane, tid);
    else for (int p = bx; p < 256; p += G) sample_fused_piece<8, false>(lds, (const bf16*)(ws + WS_MRG), D, (const bf16*)(ws + WS_WOUT), args.in[1], args.in[15], Ys, XNs, sx0, p, wave, lane, tid);
    LOCAL_BAR();
    if (bx & 1) for (int p = bx; p < 256; p += G) sample_gemm_piece<1, 8, 1>(lds, XN, D, (const bf16*)(ws + WS_WQ), SQO, D, sx0.rsp, p, wave, lane, tid);
    { pg8::Gemm g{XN, (const bf16*)(ws + WS_WQ), MP, D, D}; pg8::StaticOrder S; S.init(MP, D, G, bx);
      pg8::EpiBf16S<0, false> E{(bf16*)(ws + WS_QO), D, (const float*)(ws + WS_RSP1), nullptr};
      pg8::gemm_phase<pg8::EpiBf16S<0, false>, pg8::StaticOrder, true, true>(lds, g, S, E); }
    if (!(bx & 1)) for (int p = bx; p < 256; p += G) sample_gemm_piece<1, 8, 1>(lds, XN, D, (const bf16*)(ws + WS_WQ), SQO, D, sx0.rsp, p, wave, lane, tid);
    LOCAL_BAR();
    { const bf16* QO = (const bf16*)(ws + WS_QO); bf16* AO = (bf16*)(ws + WS_AO);
      pg8::StaticOrder SA; SA.init(MP, D, G, bx); pg8::Unit au;
      for (int i = 0; SA.next(i, au); ++i) {
          const int hd = au.pn, b = au.pm >> 4; const size_t qb = (size_t)(au.pm * 256 + wave * 32) * D + hd * 256;
          int ln = lane; asm volatile("" : "+v"(ln));
          attn_unit(lds, QO + qb, AO + qb, (unsigned)(ln & 31) * 2048u, (const bf16*)(ws + WS_KB) + (size_t)b * 256 * 1024 + hd * 256, (const bf16*)(ws + WS_VT) + (size_t)(b * 4 + hd) * 65536, true, wave, ln);
      } }
    if (G == 256 && bx >= 64) { int ln = lane; asm volatile("" : "+v"(ln));
        p0_items(args, (LAS float*)(lds + wave * 16384), DN_LO, DN_HI, (bx - 64) * NWAVES + wave, 192 * NWAVES, ln); }
    else if (G != 256) { int ln = lane; asm volatile("" : "+v"(ln)); p0_items(args, (LAS float*)(lds + wave * 16384), DN_LO, DN_HI, gw, NGW, ln); }
    for (int u = bx; u < 64; u += G) {
        const int sb = 2 * (u & 7) + (u >> 5), hd = (u >> 3) & 3; const size_t qb = (size_t)(MP + sb * 16) * D + hd * 256;
        attn_unit_small(lds, SQO + qb, SAO + qb, (const bf16*)(ws + WS_KBS) + (size_t)sb * 256 * 1024 + hd * 256, (const bf16*)(ws + WS_VTS) + (size_t)(sb * 4 + hd) * 65536, wave, lane);
    }
    GRID_BAR();
    { pg8::Gemm g{(const bf16*)(ws + WS_AO), (const bf16*)(ws + WS_WCO), MP, D, D}; pg8::StaticOrder S; S.init(MP, D, G, bx);
      pg8::EpiRes<2> E{nullptr, XN, nullptr, args.in[22], (unsigned*)(ws + WS_XB2), ctl + CW_SEAM + 4096, (float*)(ws + WS_RSP2), tmo};
      if (G == 256) sample_fused_A<8>(lds, SAO, D, (const bf16*)(ws + WS_WCO), sx1, bx, wave, lane, tid);
      pg8::gemm_phase<pg8::EpiRes<2>, pg8::StaticOrder, false, true>(lds, g, S, E); }
    if (G == 256) sample_fused_B<false>(lds, Ys, args.in[22], Ys, XNs, sx1, bx, wave, lane, tid);
    else for (int p = bx; p < 256; p += G) sample_fused_piece<8, false>(lds, SAO, D, (const bf16*)(ws + WS_WCO), Ys, args.in[22], Ys, XNs, sx1, p, wave, lane, tid);
    LOCAL_BAR();
    if (bx & 1) for (int p = bx; p < 256; p += G) sample_gemm_piece<4, 8, 2>(lds, XN, D, (const bf16*)(ws + WS_WUP), SHID, FF, sx1.rsp, p, wave, lane, tid);
    { pg8::Gemm g{XN, (const bf16*)(ws + WS_WUP), MP, FF, D}; pg8::StaticOrder S; S.init(MP, FF, G, bx);
      LAS float* rstab = (LAS float*)(lds + RSTAB_OFF);
      { pg8::Unit u0; if (S.next(0, u0) && tid < 256) { const f32x4 p = *(const GAS f32x4*)((const float*)(ws + WS_RSP2) + (size_t)(u0.pm * 256 + tid) * 4);
            rstab[tid] = 1.0f / sqrtf(((p[0] + p[1]) + (p[2] + p[3])) * (1.0f / 1024.0f) + EPS); } }
      __syncthreads();
      pg8::EpiBf16S<1, true> E{(bf16*)(ws + WS_HID), FF, (const float*)(ws + WS_RSP2), rstab};
      pg8::gemm_phase<pg8::EpiBf16S<1, true>, pg8::StaticOrder, true, true>(lds, g, S, E); }
    if (!(bx & 1)) for (int p = bx; p < 256; p += G) sample_gemm_piece<4, 8, 2>(lds, XN, D, (const bf16*)(ws + WS_WUP), SHID, FF, sx1.rsp, p, wave, lane, tid);
    LOCAL_BAR();
    { pg8::Gemm g{(const bf16*)(ws + WS_HID), (const bf16*)(ws + WS_WDOWN), MP, D, FF}; pg8::StaticOrder S; S.init(MP, D, G, bx);
      pg8::EpiRes<3> E{nullptr, XN, Y, args.in[26], (unsigned*)(ws + WS_XB3), ctl + CW_SEAM + 8192, nullptr, tmo};
      if (G == 256 && (bx & 1)) sample_fused_A<32>(lds, SHID, FF, (const bf16*)(ws + WS_WDOWN), sx2, bx, wave, lane, tid);
      pg8::gemm_phase<pg8::EpiRes<3>, pg8::StaticOrder, false, true>(lds, g, S, E); }
    if (G == 256 && !(bx & 1)) { __syncthreads(); sample_fused_A<32>(lds, SHID, FF, (const bf16*)(ws + WS_WDOWN), sx2, bx, wave, lane, tid); }
    if (G == 256) sample_fused_B<true>(lds, Ys, args.in[26], Ys, nullptr, sx2, bx, wave, lane, tid);
    else for (int p = bx; p < 256; p += G) sample_fused_piece<32, true>(lds, SHID, FF, (const bf16*)(ws + WS_WDOWN), Ys, args.in[26], Ys, nullptr, sx2, p, wave, lane, tid);
}

extern "C" void kernel_launch(void* const* d_in, const int* in_sizes, int n_in, void* d_out, int out_size, void* d_ws, size_t ws_size, hipStream_t stream) {
    static int grid = 0;
    if (grid == 0) {
        if (n_in != 27 || (size_t)out_size != OUT_TOTAL || ws_size < WS_END) { fprintf(stderr, "kernel_launch: unexpected sizes n_in %d out %d ws %zu\n", n_in, out_size, ws_size); grid = -1; return; }
        int dev = 0, cus = 0, per_cu = 0;
        if (hipGetDevice(&dev) != hipSuccess || hipDeviceGetAttribute(&cus, hipDeviceAttributeMultiprocessorCount, dev) != hipSuccess) { grid = -1; return; }
        if (hipFuncSetAttribute((const void*)enc_fwd, hipFuncAttributeMaxDynamicSharedMemorySize, LDS_BYTES) != hipSuccess) { fprintf(stderr, "kernel_launch: hipFuncSetAttribute failed\n"); grid = -1; return; }
        if (hipOccupancyMaxActiveBlocksPerMultiprocessor(&per_cu, (const void*)enc_fwd, NWAVES * 64, LDS_BYTES) != hipSuccess || per_cu < 1) { fprintf(stderr, "kernel_launch: occupancy query says %d blocks/CU\n", per_cu); per_cu = 1; }
        (void)hipGetLastError();
        grid = cus;
    }
    if (grid < 0) return;
    (void)hipMemsetAsync((char*)d_ws + WS_CTL, 0, CTL_ZERO_BYTES, stream);
    Args a{};
    for (int i = 0; i < 27; ++i) a.in[i] = (const float*)d_in[i];
    a.out = (float*)d_out; a.ws = (unsigned char*)d_ws;
    hipLaunchKernelGGL(enc_fwd, dim3(grid), dim3(NWAVES * 64), LDS_BYTES, stream, a);
}
```

```cpp
#include <hip/hip_runtime.h>
#include <cstdio>
#include <cstdint>

namespace pg8 {
#define PG8_LAS __attribute__((address_space(3)))
typedef unsigned short bf16_t;
typedef short bf16x8 __attribute__((ext_vector_type(8)));
typedef float f32x4 __attribute__((ext_vector_type(4)));
typedef unsigned u32x4 __attribute__((ext_vector_type(4)));
typedef unsigned u32x2 __attribute__((ext_vector_type(2)));
constexpr int BM = 256, BK = 64, HALF = 128, HTB = HALF * BK * 2  , STAGE_BYTES = 8 * HTB, NXCD = 8, WGM = 8;

__host__ __device__ __forceinline__ int lds_byte(int r, int c) { const int st = (r >> 4) * 2 + (c >> 5), rr = r & 15, cc = c & 31, ob = rr * 64 + cc * 2; return st * 1024 + (ob ^ (((ob >> 9) & 1) << 5)); }
__host__ __device__ __forceinline__ void stage_rc(int b, int& R, int& C) { const int st = b / 1024, sb = b % 1024, swz = sb ^ (((sb >> 9) & 1) << 5); R = (st >> 1) * 16 + swz / 64; C = (st & 1) * 32 + (swz % 64) / 2; }
__host__ __device__ __forceinline__ int perm32(int rho) { const int n = rho >> 4, i = rho & 15; return 8 * (i >> 2) + 4 * n + (i & 3); }

struct Unit { int pm, pn; };
struct Gemm { const bf16_t* A; const bf16_t* Bt; int M, N, K; };

struct StaticOrder {
    int nM, nN, nwg, G, c;
    __host__ __device__ void init(int M, int N, int G_, int c_) { nM = M / BM; nN = N / BM; nwg = nM * nN; G = G_; c = c_; }
    __host__ __device__ __forceinline__ bool next(int i, Unit& u) const {
        const long L = (long)i * G + c; if (L >= nwg) return false;
        int wgid = (int)L; { const int q = nwg / NXCD, r = nwg % NXCD, xcd = wgid % NXCD, off = wgid / NXCD; wgid = (xcd < r ? xcd * (q + 1) : r * (q + 1) + (xcd - r) * q) + off; }
        const int nig = WGM * nN, gid = wgid / nig, fm = gid * WGM, gsz = (nM - fm) < WGM ? (nM - fm) : WGM;
        u.pm = fm + ((wgid % nig) % gsz); u.pn = (wgid % nig) / gsz; return true;
    }
    __device__ __forceinline__ void a_ready(const Unit&) const {}
    __device__ __forceinline__ void done(const Unit&) const {}
};

__device__ __forceinline__ unsigned cvt_pk_bf16(float lo, float hi) { unsigned r; asm volatile("v_cvt_pk_bf16_f32 %0, %1, %2" : "=v"(r) : "v"(lo), "v"(hi)); return r; }

struct EpiF32 {
    static constexpr bool PERM = false, AFTER_DRAIN = false;
    float* C; int ldc;
    __device__ __forceinline__ void operator()(const f32x4 (&acc)[2][2][4][2], const Unit& u, int wr, int wc, int fr, int fq) const {
        const int row0 = u.pm * BM + wr * 64 + fr, col0 = u.pn * BM + wc * 32 + 4 * fq;
#pragma unroll
        for (int ai = 0; ai < 2; ++ai)
#pragma unroll
            for (int m = 0; m < 4; ++m) { float* rowp = C + (size_t)(row0 + ai * HALF + m * 16) * ldc + col0;
#pragma unroll
                for (int bj = 0; bj < 2; ++bj)
#pragma unroll
                    for (int n = 0; n < 2; ++n) *(f32x4*)(rowp + bj * HALF + n * 16) = acc[ai][bj][m][n]; }
    }
};
template <int ACT> struct EpiBf16 {
    static constexpr bool PERM = true, AFTER_DRAIN = false;
    bf16_t* O; int ldc;
    __device__ __forceinline__ void operator()(const f32x4 (&acc)[2][2][4][2], const Unit& u, int wr, int wc, int fr, int fq) const {
        const int row0 = u.pm * BM + wr * 64 + fr, col0 = u.pn * BM + wc * 32 + 8 * fq;
#pragma unroll
        for (int ai = 0; ai < 2; ++ai)
#pragma unroll
            for (int m = 0; m < 4; ++m) { bf16_t* rowp = O + (size_t)(row0 + ai * HALF + m * 16) * ldc + col0;
#pragma unroll
                for (int bj = 0; bj < 2; ++bj) { f32x4 v0 = acc[ai][bj][m][0], v1 = acc[ai][bj][m][1];
                    if (ACT == 1) {
#pragma unroll
                        for (int j = 0; j < 4; ++j) { const float a = fmaxf(v0[j], 0.f), b = fmaxf(v1[j], 0.f); v0[j] = a * a; v1[j] = b * b; } }
                    u32x4 w; w.x = cvt_pk_bf16(v0[0], v0[1]); w.y = cvt_pk_bf16(v0[2], v0[3]); w.z = cvt_pk_bf16(v1[0], v1[1]); w.w = cvt_pk_bf16(v1[2], v1[3]);
                    *(u32x4*)(rowp + bj * HALF) = w; } }
    }
};
struct Epi1 {
    static constexpr bool PERM = true, AFTER_DRAIN = false;
    bf16_t* P1; float* pool_p; float* conv_p; float* pool_s; float* conv_s;
    __device__ __forceinline__ void operator()(const f32x4 (&acc)[2][2][4][2], const Unit& u, int wr, int wc, int fr, int fq) const {
        const int row0 = u.pm * BM + wr * 64 + fr;
        const bool sample = (u.pm == 64), tailp = ((u.pm & 15) == 15) && !sample;
        if (u.pn < 4) {
            const int col0 = u.pn * BM + wc * 32 + 8 * fq;
#pragma unroll
            for (int ai = 0; ai < 2; ++ai)
#pragma unroll
                for (int m = 0; m < 4; ++m) { const int row = row0 + ai * HALF + m * 16; bf16_t* rowp = P1 + (size_t)row * 1536 + col0;
#pragma unroll
                    for (int bj = 0; bj < 2; ++bj) { const f32x4 v0 = acc[ai][bj][m][0], v1 = acc[ai][bj][m][1];
                        u32x4 w; w.x = cvt_pk_bf16(v0[0], v0[1]); w.y = cvt_pk_bf16(v0[2], v0[3]); w.z = cvt_pk_bf16(v1[0], v1[1]); w.w = cvt_pk_bf16(v1[2], v1[3]);
                        *(u32x4*)(rowp + bj * HALF) = w;
                        if (u.pn < 2) {
                            float* dst = nullptr;
                            if (sample) { const int t = row & 15, sb = (row >> 4) & 15; if (t >= 1) dst = pool_s + ((size_t)(sb * 15 + t - 1) * 512 + col0 + bj * HALF); }
                            else if (tailp) { const int t = row & 4095, b = row >> 12; if (t >= 4081) dst = pool_p + ((size_t)(b * 15 + t - 4081) * 512 + col0 + bj * HALF); }
                            if (dst) { *(f32x4*)dst = v0; *(f32x4*)(dst + 4) = v1; }
                        } } }
        } else {
            const int ch0 = (u.pn - 4) * 128 + wc * 32 + 8 * fq;
#pragma unroll
            for (int ai = 0; ai < 2; ++ai)
#pragma unroll
                for (int m = 0; m < 4; ++m) { const int row = row0 + ai * HALF + m * 16;
                    const f32x4 v0 = acc[ai][0][m][0] * acc[ai][1][m][0], v1 = acc[ai][0][m][1] * acc[ai][1][m][1];
                    u32x4 w; w.x = cvt_pk_bf16(v0[0], v0[1]); w.y = cvt_pk_bf16(v0[2], v0[3]); w.z = cvt_pk_bf16(v1[0], v1[1]); w.w = cvt_pk_bf16(v1[2], v1[3]);
                    *(u32x4*)(P1 + (size_t)row * 1536 + 1024 + ch0) = w;
                    float* dst = nullptr;
                    if (sample) { const int t = row & 15, sb = (row >> 4) & 15; if (t >= 14) dst = conv_s + ((size_t)(sb * 2 + t - 14) * 512 + ch0); }
                    else if (tailp) { const int t = row & 4095, b = row >> 12; if (t >= 4094) dst = conv_p + ((size_t)(b * 2 + t - 4094) * 512 + ch0); }
                    if (dst) { *(f32x4*)dst = v0; *(f32x4*)(dst + 4) = v1; } }
        }
    }
};
struct EpiKV {
    static constexpr bool PERM = false, AFTER_DRAIN = false;
    float* outK; float* outV; bf16_t* KB; bf16_t* VT;
    __device__ __forceinline__ void operator()(const f32x4 (&acc)[2][2][4][2], const Unit& u, int wr, int wc, int fr, int fq) const {
        const int row0 = u.pm * BM + wr * 64 + fr;
        if (u.pn < 4) {
            const int col0 = u.pn * BM + wc * 32 + 4 * fq;
#pragma unroll
            for (int ai = 0; ai < 2; ++ai)
#pragma unroll
                for (int m = 0; m < 4; ++m) { const size_t off = (size_t)(row0 + ai * HALF + m * 16) * 1024 + col0;
#pragma unroll
                    for (int bj = 0; bj < 2; ++bj)
#pragma unroll
                        for (int n = 0; n < 2; ++n) { const f32x4 v = acc[ai][bj][m][n]; __builtin_nontemporal_store(v, (f32x4*)(outK + off + bj * HALF + n * 16));
                            u32x2 w; w.x = cvt_pk_bf16(v[0], v[1]); w.y = cvt_pk_bf16(v[2], v[3]); *(u32x2*)(KB + off + bj * HALF + n * 16) = w; } }
        } else {
            const int h = u.pn - 4, e0 = wc * 32 + 4 * fq;
            bf16_t* vt = VT + (size_t)(u.pm * 4 + h) * 65536;
#pragma unroll
            for (int ai = 0; ai < 2; ++ai)
#pragma unroll
                for (int m = 0; m < 4; ++m) { const int mrow = wr * 64 + fr + ai * HALF + m * 16;
                    const int pos = (mrow & ~12) | ((mrow & 4) << 1) | ((mrow & 8) >> 1);
                    const size_t off = (size_t)(u.pm * BM + mrow) * 1024 + h * 256 + e0;
#pragma unroll
                    for (int bj = 0; bj < 2; ++bj)
#pragma unroll
                        for (int n = 0; n < 2; ++n) { const f32x4 v = acc[ai][bj][m][n]; __builtin_nontemporal_store(v, (f32x4*)(outV + off + bj * HALF + n * 16));
                            const unsigned w0 = cvt_pk_bf16(v[0], v[1]), w1 = cvt_pk_bf16(v[2], v[3]); const int e = e0 + bj * HALF + n * 16;
                            vt[(size_t)(e + 0) * 256 + pos] = (bf16_t)(w0 & 0xffffu); vt[(size_t)(e + 1) * 256 + pos] = (bf16_t)(w0 >> 16);
                            vt[(size_t)(e + 2) * 256 + pos] = (bf16_t)(w1 & 0xffffu); vt[(size_t)(e + 3) * 256 + pos] = (bf16_t)(w1 >> 16); } }
        }
    }
};


template <int ACT, bool TAB> struct EpiBf16S {
    static constexpr bool PERM = true, AFTER_DRAIN = false;
    bf16_t* O; int ldc; const float* rsp; const PG8_LAS float* rstab;
    __device__ __forceinline__ void operator()(const f32x4 (&acc)[2][2][4][2], const Unit& u, int wr, int wc, int fr, int fq) const {
        const int row0 = u.pm * BM + wr * 64 + fr, col0 = u.pn * BM + wc * 32 + 8 * fq;
#pragma unroll
        for (int ai = 0; ai < 2; ++ai)
#pragma unroll
            for (int m = 0; m < 4; ++m) { const int row = row0 + ai * HALF + m * 16; bf16_t* rowp = O + (size_t)row * ldc + col0;
                float rs;
                if (TAB) rs = rstab[wr * 64 + fr + ai * HALF + m * 16];
                else { const f32x4 p = *(const f32x4*)(rsp + (size_t)row * 4); rs = 1.0f / sqrtf(((p[0] + p[1]) + (p[2] + p[3])) * (1.0f / 1024.0f) + 1e-6f); }
#pragma unroll
                for (int bj = 0; bj < 2; ++bj) { f32x4 v0 = acc[ai][bj][m][0] * rs, v1 = acc[ai][bj][m][1] * rs;
                    if (ACT == 1) {
#pragma unroll
                        for (int j = 0; j < 4; ++j) { const float a = fmaxf(v0[j], 0.f), b = fmaxf(v1[j], 0.f); v0[j] = a * a; v1[j] = b * b; } }
                    u32x4 w; w.x = cvt_pk_bf16(v0[0], v0[1]); w.y = cvt_pk_bf16(v0[2], v0[3]); w.z = cvt_pk_bf16(v1[0], v1[1]); w.w = cvt_pk_bf16(v1[2], v1[3]);
                    *(u32x4*)(rowp + bj * HALF) = w; } }
    }
};

template <int MODE> struct EpiRes {
    static constexpr bool PERM = true, AFTER_DRAIN = true;
    const float* basef; bf16_t* X; float* outf; const float* g; unsigned* xbuf; unsigned* cnt; float* rsp; unsigned* tmo;
    __device__ __forceinline__ void fused(f32x4 (&acc)[2][2][4][2], const Unit& u, int wr, int wc, int fr, int fq, PG8_LAS unsigned char* lds, int wid, int lane) const {
        PG8_LAS float* P = (PG8_LAS float*)lds;
        PG8_LAS float* S = (PG8_LAS float*)(lds + 4096);
        PG8_LAS float* R = (PG8_LAS float*)(lds + 5120);
        const int col0 = u.pn * BM + wc * 32 + 8 * fq;
        u32x4 pre[4][2][1];
#pragma unroll
        for (int m = 0; m < 4; ++m) { const size_t off = (size_t)(u.pm * BM + wr * 64 + m * 16 + fr) * 1024 + col0;
#pragma unroll
            for (int bj = 0; bj < 2; ++bj) {
                pre[m][bj][0] = *(const u32x4*)(X + off + bj * HALF); } }
#pragma unroll
        for (int ai = 0; ai < 2; ++ai)
#pragma unroll
            for (int m = 0; m < 4; ++m) { float s = 0.f;
#pragma unroll
                for (int bj = 0; bj < 2; ++bj)
#pragma unroll
                    for (int n = 0; n < 2; ++n) { const f32x4 x = acc[ai][bj][m][n]; s += (x[0] * x[0] + x[1] * x[1]) + (x[2] * x[2] + x[3] * x[3]); }
                s += __shfl_xor(s, 16); s += __shfl_xor(s, 32);
                if (fq == 0) P[(ai * HALF + wr * 64 + m * 16 + fr) * 4 + wc] = s; }
        asm volatile("s_waitcnt lgkmcnt(0)" ::: "memory"); __builtin_amdgcn_s_barrier(); asm volatile("" ::: "memory");
        const int row = wid * 32 + (lane & 31);
        if (lane < 32) { const f32x4 p = *(const PG8_LAS f32x4*)(P + row * 4); const float t = (p[0] + p[1]) + (p[2] + p[3]);
            __hip_atomic_store(xbuf + (size_t)(u.pm * BM + row) * 4 + u.pn, __float_as_uint(t), __ATOMIC_RELAXED, __HIP_MEMORY_SCOPE_AGENT); }
        asm volatile("s_waitcnt vmcnt(0)" ::: "memory");
        if (lane == 0) __hip_atomic_fetch_add(cnt + 64 * u.pm, 1u, __ATOMIC_RELAXED, __HIP_MEMORY_SCOPE_AGENT);
        if (wid == 0) { unsigned sp = 0;
            while ((unsigned)__builtin_amdgcn_readfirstlane(__hip_atomic_load(cnt + 64 * u.pm, __ATOMIC_RELAXED, __HIP_MEMORY_SCOPE_AGENT)) < 32u) {
                __builtin_amdgcn_s_sleep(2);
                if ((++sp & 1023u) == 0u) { if (__hip_atomic_load(tmo, __ATOMIC_RELAXED, __HIP_MEMORY_SCOPE_AGENT) != 0u) break; if (sp > (1u << 22)) { if (lane == 0) __hip_atomic_store(tmo, 1u, __ATOMIC_RELAXED, __HIP_MEMORY_SCOPE_AGENT); break; } } }
            }
        asm volatile("s_waitcnt vmcnt(0) lgkmcnt(0)" ::: "memory"); __builtin_amdgcn_s_barrier(); asm volatile("" ::: "memory");
        if (lane < 32) { const unsigned* slot = xbuf + (size_t)(u.pm * BM + row) * 4; float t = 0.f;
#pragma unroll
            for (int k = 0; k < 4; ++k) t += __uint_as_float(__hip_atomic_load(slot + k, __ATOMIC_RELAXED, __HIP_MEMORY_SCOPE_AGENT));
            S[row] = 1.0f / sqrtf(t * (1.0f / 1024.0f) + 1e-6f);
            if (MODE == 1) R[row] = basef[u.pm * BM + row]; }
        asm volatile("s_waitcnt lgkmcnt(0)" ::: "memory"); __builtin_amdgcn_s_barrier(); asm volatile("" ::: "memory");
        f32x4 gv[2][2];
#pragma unroll
        for (int bj = 0; bj < 2; ++bj)
#pragma unroll
            for (int n = 0; n < 2; ++n) gv[bj][n] = *(const f32x4*)(g + col0 + bj * HALF + 4 * n);
#pragma unroll
        for (int ai = 0; ai < 2; ++ai)
#pragma unroll
            for (int m = 0; m < 4; ++m) { const int r = ai * HALF + wr * 64 + m * 16 + fr; const float sr = S[r], rn = MODE == 1 ? R[r] : 1.f; const size_t off = (size_t)(u.pm * BM + r) * 1024 + col0; float q = 0.f;
#pragma unroll
                for (int bj = 0; bj < 2; ++bj) { f32x4 b0, b1;
                    { const u32x4 w = ai == 0 ? pre[m][bj][0] : *(const u32x4*)(X + off + bj * HALF);
                        b0 = (f32x4){__uint_as_float(w.x << 16), __uint_as_float(w.x & 0xffff0000u), __uint_as_float(w.y << 16), __uint_as_float(w.y & 0xffff0000u)};
                        b1 = (f32x4){__uint_as_float(w.z << 16), __uint_as_float(w.z & 0xffff0000u), __uint_as_float(w.w << 16), __uint_as_float(w.w & 0xffff0000u)};
                        if (MODE == 1) { b0 = b0 * rn; b1 = b1 * rn; } }
                    const f32x4 v0 = b0 + acc[ai][bj][m][0] * sr * gv[bj][0], v1 = b1 + acc[ai][bj][m][1] * sr * gv[bj][1];
                    if (MODE == 3) { __builtin_nontemporal_store(v0, (f32x4*)(outf + off + bj * HALF)); __builtin_nontemporal_store(v1, (f32x4*)(outf + off + bj * HALF + 4)); }
                    else { q += ((v0[0] * v0[0] + v0[1] * v0[1]) + (v0[2] * v0[2] + v0[3] * v0[3])) + ((v1[0] * v1[0] + v1[1] * v1[1]) + (v1[2] * v1[2] + v1[3] * v1[3]));
                        u32x4 w; w.x = cvt_pk_bf16(v0[0], v0[1]); w.y = cvt_pk_bf16(v0[2], v0[3]); w.z = cvt_pk_bf16(v1[0], v1[1]); w.w = cvt_pk_bf16(v1[2], v1[3]);
                        *(u32x4*)(X + off + bj * HALF) = w; } }
                if (MODE != 3) { q += __shfl_xor(q, 16); q += __shfl_xor(q, 32); if (fq == 0) P[r * 4 + wc] = q; }
                if (m & 1) asm volatile("" ::: "memory"); }
        if (MODE != 3) {
            asm volatile("s_waitcnt lgkmcnt(0)" ::: "memory"); __builtin_amdgcn_s_barrier(); asm volatile("" ::: "memory");
            if (lane < 32) { const f32x4 p = *(const PG8_LAS f32x4*)(P + row * 4); rsp[(size_t)(u.pm * BM + row) * 4 + u.pn] = (p[0] + p[1]) + (p[2] + p[3]); }
        }
    }
};

template <class Epi, class Sched, bool ALIGN_EPI = false, bool SP2 = false>
__device__ __forceinline__ void gemm_phase(PG8_LAS unsigned char* lds, const Gemm g, const Sched& S, const Epi& E) {
    int tid_ = threadIdx.x; asm volatile("" : "+v"(tid_));
    const int tid = tid_, wid = __builtin_amdgcn_readfirstlane(tid >> 6), lane = tid & 63, wr = wid >> 2, wc = wid & 3, fr = lane & 15, fq = lane >> 4;
    const int K = g.K, nt = K / BK;
    unsigned voffA[2], voffB[2];
#pragma unroll
    for (int i = 0; i < 2; ++i) { int R, C; stage_rc(tid * 16 + i * 8192, R, C); const int Rb = Epi::PERM ? ((R & ~31) + perm32(R & 31)) : R;
        voffA[i] = (unsigned)(R * K + C) * 2u; voffB[i] = (unsigned)(Rb * K + C) * 2u; }
    const size_t kstep = (size_t)(BK * 2);
    const size_t hstep = (size_t)HALF * K * 2;
    const size_t tstep = 2 * hstep;
    const unsigned ldsw = (unsigned)wid * 1024u;
    const int aoff = lds_byte(wr * 64 + fr, fq * 8), boff = lds_byte(wc * 32 + fr, fq * 8);
#define PG8_SA(b, h) (((b) * 2 + (h)) * HTB)
#define PG8_SB(b, h) ((4 + (b) * 2 + (h)) * HTB)
#define PG8_STAGE(bufoff, gbase, voff) do { _Pragma("unroll") for (int _i = 0; _i < 2; ++_i) \
        __builtin_amdgcn_global_load_lds((const unsigned*)((const char*)(gbase) + (voff)[_i]), (PG8_LAS unsigned*)(lds + (bufoff) + ldsw + _i * 8192), 16, 0, 0); } while (0)
#define PG8_LDA(dst, b, h) do { _Pragma("unroll") for (int m = 0; m < 4; ++m) _Pragma("unroll") for (int k = 0; k < 2; ++k) dst[m][k] = *(const PG8_LAS bf16x8*)(lds + PG8_SA(b, h) + aoff + m * 2048 + k * 1024); } while (0)
#define PG8_LDB(dst, b, h) do { _Pragma("unroll") for (int n = 0; n < 2; ++n) _Pragma("unroll") for (int k = 0; k < 2; ++k) dst[n][k] = *(const PG8_LAS bf16x8*)(lds + PG8_SB(b, h) + boff + n * 2048 + k * 1024); } while (0)
#define PG8_MMA(ai, bj, At, Bt) do { __builtin_amdgcn_s_setprio(1); _Pragma("unroll") for (int m = 0; m < 4; ++m) _Pragma("unroll") for (int n = 0; n < 2; ++n) _Pragma("unroll") for (int k = 0; k < 2; ++k) \
        acc[ai][bj][m][n] = __builtin_amdgcn_mfma_f32_16x16x32_bf16(Bt[n][k], At[m][k], acc[ai][bj][m][n], 0, 0, 0); __builtin_amdgcn_s_setprio(0); } while (0)
#define PG8_WAIT_V(n) asm volatile("s_waitcnt vmcnt(" #n ")" ::: "memory")
#define PG8_WAIT_L(n) asm volatile("s_waitcnt lgkmcnt(" #n ")" ::: "memory")
#define PG8_BAR __builtin_amdgcn_s_barrier()
#define PG8_SCHED __builtin_amdgcn_sched_barrier(0)
    Unit cur, nxt; int ui = 0;
    if (!S.next(0, cur)) return;
    f32x4 acc[2][2][4][2];
#pragma unroll
    for (int a = 0; a < 2; ++a)
#pragma unroll
        for (int b = 0; b < 2; ++b)
#pragma unroll
            for (int m = 0; m < 4; ++m)
#pragma unroll
                for (int n = 0; n < 2; ++n) acc[a][b][m][n] = (f32x4){0.f, 0.f, 0.f, 0.f};
    bf16x8 At[4][2], B0[2][2], B1[2][2];
    const char* cA = (const char*)g.A + (size_t)cur.pm * tstep; const char* cB = (const char*)g.Bt + (size_t)cur.pn * tstep;
    S.a_ready(cur);
    if constexpr (SP2) {
        PG8_STAGE(PG8_SB(0, 0), cB, voffB); PG8_STAGE(PG8_SB(0, 1), cB + hstep, voffB); PG8_STAGE(PG8_SA(0, 0), cA, voffA); PG8_STAGE(PG8_SA(0, 1), cA + hstep, voffA);
        if (wr == 1) PG8_BAR;
        PG8_WAIT_V(2); PG8_BAR;
        PG8_STAGE(PG8_SB(1, 0), cB + kstep, voffB); PG8_STAGE(PG8_SA(1, 0), cA + kstep, voffA); PG8_STAGE(PG8_SB(1, 1), cB + hstep + kstep, voffB);
        PG8_WAIT_V(6); PG8_BAR;
    } else {
        PG8_STAGE(PG8_SB(0, 0), cB, voffB); PG8_STAGE(PG8_SA(0, 0), cA, voffA); PG8_STAGE(PG8_SB(0, 1), cB + hstep, voffB); PG8_STAGE(PG8_SA(0, 1), cA + hstep, voffA);
        if (wr == 1) PG8_BAR;
        PG8_WAIT_V(4); PG8_BAR;
        PG8_STAGE(PG8_SB(1, 0), cB + kstep, voffB); PG8_STAGE(PG8_SA(1, 0), cA + kstep, voffA); PG8_STAGE(PG8_SB(1, 1), cB + hstep + kstep, voffB);
        PG8_WAIT_V(6); PG8_BAR;
    }
    for (;;) {
        const bool has_next = S.next(ui + 1, nxt);
        const char* nA = has_next ? (const char*)g.A + (size_t)nxt.pm * tstep : cA; const char* nB = has_next ? (const char*)g.Bt + (size_t)nxt.pn * tstep : cB;
        for (int t = 0; t < nt; t += 2) {
            const bool last = (t == nt - 2);
            const char* a1 = cA + (size_t)(t + 1) * kstep;
            const char* a2 = last ? nA : cA + (size_t)(t + 2) * kstep; const char* b2 = last ? nB : cB + (size_t)(t + 2) * kstep;
            const char* a3 = a2 + kstep; const char* b3 = b2 + kstep;
            if (last && has_next) S.a_ready(nxt);
            if constexpr (SP2) {
            PG8_LDB(B0, 0, 0); PG8_LDB(B1, 0, 1); PG8_SCHED; PG8_LDA(At, 0, 0); PG8_STAGE(PG8_SA(1, 1), a1 + hstep, voffA);
            PG8_WAIT_V(8); PG8_WAIT_L(0); PG8_BAR; PG8_MMA(0, 0, At, B0); PG8_MMA(0, 1, At, B1); PG8_BAR; PG8_SCHED;
            PG8_LDA(At, 0, 1); PG8_STAGE(PG8_SB(0, 0), b2, voffB); PG8_STAGE(PG8_SB(0, 1), b2 + hstep, voffB); PG8_STAGE(PG8_SA(0, 0), a2, voffA);
            PG8_WAIT_V(8); PG8_WAIT_L(0); PG8_BAR; PG8_MMA(1, 0, At, B0); PG8_MMA(1, 1, At, B1); PG8_BAR; PG8_SCHED;
            PG8_LDB(B0, 1, 0); PG8_LDB(B1, 1, 1); PG8_SCHED; PG8_LDA(At, 1, 0); PG8_STAGE(PG8_SA(0, 1), a2 + hstep, voffA);
            PG8_WAIT_V(8); PG8_WAIT_L(0); PG8_BAR; PG8_MMA(0, 0, At, B0); PG8_MMA(0, 1, At, B1); PG8_BAR; PG8_SCHED;
            PG8_LDA(At, 1, 1); PG8_STAGE(PG8_SB(1, 0), b3, voffB); PG8_STAGE(PG8_SB(1, 1), b3 + hstep, voffB); PG8_STAGE(PG8_SA(1, 0), a3, voffA);
            PG8_WAIT_V(8); PG8_WAIT_L(0); PG8_BAR; PG8_MMA(1, 0, At, B0); PG8_MMA(1, 1, At, B1); PG8_BAR; PG8_SCHED;
            } else {
            PG8_LDB(B0, 0, 0); PG8_SCHED; PG8_LDA(At, 0, 0); PG8_STAGE(PG8_SA(1, 1), a1 + hstep, voffA);
            PG8_WAIT_L(8); PG8_BAR; PG8_WAIT_L(0); PG8_MMA(0, 0, At, B0); PG8_BAR; PG8_SCHED;
            PG8_LDB(B1, 0, 1); PG8_STAGE(PG8_SB(0, 0), b2, voffB);
            PG8_BAR; PG8_WAIT_L(0); PG8_MMA(0, 1, At, B1); PG8_BAR;
            PG8_LDA(At, 0, 1); PG8_STAGE(PG8_SA(0, 0), a2, voffA);
            PG8_BAR; PG8_WAIT_L(0); PG8_MMA(1, 0, At, B0); PG8_BAR; PG8_SCHED;
            PG8_STAGE(PG8_SB(0, 1), b2 + hstep, voffB);
            PG8_WAIT_V(6); PG8_BAR; PG8_MMA(1, 1, At, B1); PG8_BAR;
            PG8_LDB(B0, 1, 0); PG8_SCHED; PG8_LDA(At, 1, 0); PG8_STAGE(PG8_SA(0, 1), a2 + hstep, voffA);
            PG8_WAIT_L(8); PG8_BAR; PG8_WAIT_L(0); PG8_MMA(0, 0, At, B0); PG8_BAR; PG8_SCHED;
            PG8_LDB(B1, 1, 1); PG8_STAGE(PG8_SB(1, 0), b3, voffB);
            PG8_BAR; PG8_WAIT_L(0); PG8_MMA(0, 1, At, B1); PG8_BAR;
            PG8_LDA(At, 1, 1); PG8_STAGE(PG8_SA(1, 0), a3, voffA);
            PG8_BAR; PG8_WAIT_L(0); PG8_MMA(1, 0, At, B0); PG8_BAR; PG8_SCHED;
            PG8_STAGE(PG8_SB(1, 1), b3 + hstep, voffB);
            PG8_WAIT_V(6); PG8_BAR; PG8_MMA(1, 1, At, B1); PG8_BAR;
            }
        }
        if constexpr (ALIGN_EPI) { if (wr == 0) PG8_BAR; }
        if constexpr (!Epi::AFTER_DRAIN) { E(acc, cur, wr, wc, fr, fq); S.done(cur); }
        if (!has_next) break;
#pragma unroll
        for (int a = 0; a < 2; ++a)
#pragma unroll
            for (int b = 0; b < 2; ++b)
#pragma unroll
                for (int m = 0; m < 4; ++m)
#pragma unroll
                    for (int n = 0; n < 2; ++n) acc[a][b][m][n] = (f32x4){0.f, 0.f, 0.f, 0.f};
        cur = nxt; cA = nA; cB = nB; ++ui;
        if constexpr (ALIGN_EPI) { if (wr == 1) PG8_BAR; }
    }
    PG8_WAIT_V(0);
    if constexpr (!ALIGN_EPI) { if (wr == 0) PG8_BAR; }
    PG8_BAR;
    if constexpr (Epi::AFTER_DRAIN) { E.fused(acc, cur, wr, wc, fr, fq, lds, wid, lane); S.done(cur); }
#undef PG8_SA
#undef PG8_SB
#undef PG8_STAGE
#undef PG8_LDA
#undef PG8_LDB
#undef PG8_MMA
#undef PG8_WAIT_V
#undef PG8_WAIT_L
#undef PG8_BAR
#undef PG8_SCHED
}
}
constexpr int NWAVES = 8;
constexpr int D = 1024, MP = 16384, MS = 256, M = MP + MS, NIN = 2048, FF = 4096;
constexpr float EPS = 1e-6f;
constexpr size_t OUT_Y = 0, OUT_POOL_P = 17039360, OUT_CONV_P = 17070080, OUT_MK = 17074176, OUT_MV = 18122752, OUT_POOL_S = 19171328, OUT_CONV_S = 19294208, OUT_TOTAL = 19310592;
constexpr size_t MiB = 1u << 20;
constexpr size_t WS_CTL = 0, CTL_ZERO_BYTES = 128 * 1024;
constexpr size_t WS_WDOWN = 1 * MiB, WS_WUP = 9 * MiB, WS_WIN = 17 * MiB, WS_WKV = 21 * MiB, WS_WOUT = 25 * MiB, WS_WQ = 27 * MiB, WS_WCO = 29 * MiB, WS_WP = 31 * MiB;
constexpr size_t WS_HISTU = 31 * MiB + 512 * 1024, WS_HISTV = WS_HISTU + 16 * 15 * 512 * 2, WS_ZERO = 32 * 1024;
constexpr size_t WS_MN = 32 * MiB, WS_KB = 34 * MiB, WS_VT = 36 * MiB, WS_KBS = 38 * MiB, WS_VTS = 46 * MiB;
constexpr size_t WS_XN = 54 * MiB;
constexpr size_t WS_MRG = 87 * MiB;
constexpr size_t WS_AO = 87 * MiB;
constexpr size_t WS_P1 = 120 * MiB;
constexpr size_t WS_QO = 120 * MiB;
constexpr size_t WS_HID = 120 * MiB;
constexpr size_t WS_XB1 = 248 * MiB, WS_XB2 = WS_XB1 + 256 * 1024, WS_XB3 = WS_XB2 + 256 * 1024, WS_RSP1 = WS_XB3 + 256 * 1024, WS_RSP2 = WS_RSP1 + 256 * 1024;
constexpr size_t WS_SXB = 249 * MiB + 512 * 1024, WS_SRSP = WS_SXB + 3 * 32768;
constexpr size_t WS_RNORM = 249 * MiB + 768 * 1024;
constexpr size_t WS_SQO = 250 * MiB, WS_SAO = WS_SQO + 512 * 1024, WS_SRAW = 251 * MiB, WS_SHID = 252 * MiB;
constexpr size_t WS_END = 256 * MiB;
constexpr int CW_TMO = 0, CW_SEAM = 16384, CW_SSEAM = 16384 + 3 * 4096;
static_assert(WS_MRG + (size_t)M * D * 2 <= WS_P1 && WS_HID + (size_t)MP * FF * 2 <= WS_XB1 && WS_SHID + (size_t)MS * FF * 2 <= WS_END, "ws map");
constexpr int CW_BAR = 4096;

constexpr int RING_BYTES = 131072, LDSCTL_OFF = RING_BYTES, MISC_OFF = LDSCTL_OFF + 320, RSTAB_OFF = RING_BYTES + 1024, GGTAB_OFF = RING_BYTES + 2048, STASH_OFF = RING_BYTES + 4096, LDS_BYTES = 147456;

#define GAS __attribute__((address_space(1)))
#define LAS __attribute__((address_space(3)))
typedef unsigned short bf16;
typedef unsigned v4u __attribute__((ext_vector_type(4)));
typedef unsigned v2u __attribute__((ext_vector_type(2)));
typedef float f32x4 __attribute__((ext_vector_type(4)));
typedef float f32x16 __attribute__((ext_vector_type(16)));
typedef float f32x2 __attribute__((ext_vector_type(2)));
typedef short bf16x8 __attribute__((ext_vector_type(8)));
#define LDS_WAIT() asm volatile("s_waitcnt lgkmcnt(0)" ::: "memory")
#define VM_WAIT() asm volatile("s_waitcnt vmcnt(0)" ::: "memory")
__device__ __forceinline__ unsigned f2bf(float f) { unsigned u = __builtin_bit_cast(unsigned, f); return (u + 0x7fffu + ((u >> 16) & 1u)) >> 16; }
__device__ __forceinline__ unsigned pk2(float lo, float hi) { return pg8::cvt_pk_bf16(lo, hi); }
typedef __bf16 bf16n2 __attribute__((ext_vector_type(2)));
__device__ __forceinline__ unsigned pk2c(float lo, float hi) { const bf16n2 v = __builtin_convertvector((f32x2){lo, hi}, bf16n2); return __builtin_bit_cast(unsigned, v); }
__device__ __forceinline__ float bflo(unsigned w) { return __builtin_bit_cast(float, w << 16); }
__device__ __forceinline__ float bfhi(unsigned w) { return __builtin_bit_cast(float, w & 0xffff0000u); }

#define XB_TMO      128
#define XB_XCNT(j)  (256  + 64 * (j))
#define XB_XSUB(j)  (1280 + 64 * (j))
#define XB_XGEN(j)  (2304 + 64 * (j))
#define XB_TOP      3328
#define XB_TOPGEN   3392
#define XCD_BAR_WORDS 3456
#define XB_SPIN_CAP (1u << 22)
__device__ __forceinline__ unsigned xb_ld(unsigned* p)              { return __hip_atomic_load(p, __ATOMIC_RELAXED, __HIP_MEMORY_SCOPE_AGENT); }
__device__ __forceinline__ unsigned xb_add(unsigned* p, unsigned v) { return __hip_atomic_fetch_add(p, v, __ATOMIC_RELAXED, __HIP_MEMORY_SCOPE_AGENT); }
__device__ __forceinline__ unsigned xb_xcc_id() { return (unsigned)__builtin_amdgcn_s_getreg((3 << 11) | 20) & 0xFu; }
#define XB_SPIN(cond, bar) do { unsigned _sp = 0; while (cond) { __builtin_amdgcn_s_sleep(1); \
    if ((++_sp & 255u) == 0u) { if (xb_ld(&(bar)[XB_TMO])) break; if (_sp > XB_SPIN_CAP) { atomicAdd(&(bar)[XB_TMO], 1u); break; } } } } while (0)
struct XcdBarrier { unsigned* bar; unsigned x; volatile LAS unsigned* st; };
__device__ __forceinline__ XcdBarrier xcd_barrier_post(unsigned* bar, volatile LAS unsigned* st) {
    XcdBarrier b; b.bar = bar; b.x = xb_xcc_id(); b.st = st;
    if (threadIdx.x == 0) (void)xb_add(&bar[XB_XCNT(b.x)], 1u);
    return b;
}
__device__ __forceinline__ void xcd_barrier_complete(unsigned* bar, unsigned x, unsigned& nloc, unsigned& nx) {
    const unsigned G = gridDim.x * gridDim.y * gridDim.z;
    unsigned sum, cnt, mine, sp = 0u;
    for (;;) {
        sum = 0u; cnt = 0u; mine = 0u;
#pragma unroll
        for (unsigned j = 0; j < 16; ++j) { const unsigned c = xb_ld(&bar[XB_XCNT(j)]); sum += c; cnt += (c > 0u) ? 1u : 0u; mine = (j == x) ? c : mine; }
        if (sum == G) break;
        __builtin_amdgcn_s_sleep(1);
        if ((++sp & 255u) == 0u) { if (xb_ld(&bar[XB_TMO])) break; if (sp > XB_SPIN_CAP) { atomicAdd(&bar[XB_TMO], 1u); break; } }
    }
    nloc = mine > 0u ? mine : 1u; nx = cnt > 0u ? cnt : 1u;
}
__device__ __forceinline__ void xcd_barrier(const XcdBarrier& b) {
    asm volatile("s_waitcnt vmcnt(0)" ::: "memory");
    __syncthreads();
    if (threadIdx.x == 0) {
        unsigned* bar = b.bar;
        __builtin_amdgcn_s_waitcnt(0);
        unsigned nloc = b.st[0], nx = b.st[1];
        if (nloc == 0u) { xcd_barrier_complete(bar, b.x, nloc, nx); b.st[0] = nloc; b.st[1] = nx; }
        const unsigned old = xb_add(&bar[XB_XSUB(b.x)], 1u);
        const unsigned gen = old / nloc;
        if (old + 1u == (gen + 1u) * nloc) {
            __builtin_amdgcn_fence(__ATOMIC_RELEASE, "agent");
            asm volatile("s_waitcnt vmcnt(0)" ::: "memory");
            const unsigned og = xb_add(&bar[XB_TOP], 1u);
            const unsigned tg = og / nx;
            if (og + 1u == (tg + 1u) * nx) xb_add(&bar[XB_TOPGEN], 1u);
            else XB_SPIN(xb_ld(&bar[XB_TOPGEN]) == tg, bar);
            __builtin_amdgcn_fence(__ATOMIC_ACQUIRE, "agent");
            xb_add(&bar[XB_XGEN(b.x)], 1u);
            asm volatile("s_waitcnt vmcnt(0)" ::: "memory");
        } else {
            XB_SPIN(xb_ld(&bar[XB_XGEN(b.x)]) == gen, bar);
            __builtin_amdgcn_fence(__ATOMIC_ACQUIRE, "agent");
            asm volatile("s_waitcnt vmcnt(0)" ::: "memory");
        }
    }
    __syncthreads();
}

__device__ __forceinline__ void xcd_arrive(const XcdBarrier& b) {
    asm volatile("s_waitcnt vmcnt(0)" ::: "memory");
    __syncthreads();
    if (threadIdx.x == 0) {
        unsigned* bar = b.bar;
        __builtin_amdgcn_s_waitcnt(0);
        unsigned nloc = b.st[0], nx = b.st[1];
        if (nloc == 0u) { xcd_barrier_complete(bar, b.x, nloc, nx); b.st[0] = nloc; b.st[1] = nx; }
        const unsigned old = xb_add(&bar[XB_XSUB(b.x)], 1u);
        const unsigned gen = old / nloc;
        b.st[2] = gen;
        if (old + 1u == (gen + 1u) * nloc) {
            __builtin_amdgcn_fence(__ATOMIC_RELEASE, "agent");
            asm volatile("s_waitcnt vmcnt(0)" ::: "memory");
            (void)xb_add(&bar[XB_TOP], 1u);
        }
    }
}
__device__ __forceinline__ void xcd_wait(const XcdBarrier& b) {
    if (threadIdx.x == 0) {
        unsigned* bar = b.bar; const unsigned need = (b.st[2] + 1u) * b.st[1];
        XB_SPIN((int)(xb_ld(&bar[XB_TOP]) - need) < 0, bar);
        __builtin_amdgcn_fence(__ATOMIC_ACQUIRE, "agent");
        asm volatile("s_waitcnt vmcnt(0)" ::: "memory");
    }
    __syncthreads();
}

#define XB_LSUB(j)  (5120 + 64 * (j))
#define XB_GRP(j)   (6400 + 64 * (j))
#define XB_MIS      7040
__device__ __forceinline__ void xcd_local_barrier(const XcdBarrier& b) {
    asm volatile("s_waitcnt vmcnt(0)" ::: "memory");
    __syncthreads();
    if (threadIdx.x == 0) {
        unsigned* bar = b.bar;
        const unsigned nloc = b.st[0];
        const unsigned old = xb_add(&bar[XB_LSUB(b.x)], 1u);
        const unsigned need = (old / nloc + 1u) * nloc;
        XB_SPIN((int)(xb_ld(&bar[XB_LSUB(b.x)]) - need) < 0, bar);
        __builtin_amdgcn_fence(__ATOMIC_ACQUIRE, "agent");
        asm volatile("s_waitcnt vmcnt(0)" ::: "memory");
    }
    __syncthreads();
}

struct Args { const float* in[27]; float* out; unsigned char* ws; };

__device__ __forceinline__ float wave_sum(float v) {
#pragma unroll
    for (int o = 1; o < 64; o <<= 1) v += __shfl_xor(v, o);
    return v;
}

struct TItem { const float* W; const float* g; const float* gn; bf16* WT; int ldw, K, srccol, dstrow, k0; float sc; int kperm; };
struct TRegs { f32x4 v[8]; float gk[8]; };
__device__ __forceinline__ void t_load(const TItem& t, TRegs& r, int lane) {
    const int rl = lane >> 3, cq = lane & 7;
#pragma unroll
    for (int i = 0; i < 8; ++i) { const int kk = 8 * i + rl; r.v[i] = __builtin_nontemporal_load((const GAS f32x4*)(t.W + (size_t)(t.k0 + kk) * t.ldw + t.srccol + 4 * cq)); r.gk[i] = t.g ? t.g[t.k0 + kk] : 1.f; }
}
__device__ __forceinline__ void t_process(const TItem& t, const TRegs& r, LAS float* scr, int lane) {
    const int rl = lane >> 3, cq = lane & 7;
    f32x4 gn4 = (f32x4){1.f, 1.f, 1.f, 1.f}; if (t.gn) gn4 = *(const GAS f32x4*)(t.gn + t.srccol + 4 * cq);
#pragma unroll
    for (int i = 0; i < 8; ++i) { const int kk = 8 * i + rl; const float m = r.gk[i] * t.sc; LAS float* d = scr + kk * 33 + 4 * cq;
        d[0] = r.v[i].x * m * gn4.x; d[1] = r.v[i].y * m * gn4.y; d[2] = r.v[i].z * m * gn4.z; d[3] = r.v[i].w * m * gn4.w; }
    LDS_WAIT(); asm volatile("" ::: "memory");
    const int c = lane & 7;
    const int lp = t.kperm == 0 ? 8 * c : t.kperm == 1 ? (((c & 6) << 3) | ((c & 1) << 2)) : (((c & 4) << 3) | ((c & 3) << 2));
    const LAS float* s0 = scr + lp * 33; const LAS float* s1 = s0 + (4 << t.kperm) * 33;
#pragma unroll
    for (int j = 0; j < 4; ++j) { const int n = (lane >> 3) + 8 * j;
        float e[8];
#pragma unroll
        for (int q = 0; q < 8; ++q) e[q] = (q < 4 ? s0 : s1)[(q & 3) * 33 + n];
        v4u o; o.x = pk2(e[0], e[1]); o.y = pk2(e[2], e[3]); o.z = pk2(e[4], e[5]); o.w = pk2(e[6], e[7]);
        *(GAS v4u*)(t.WT + (size_t)(t.dstrow + n) * t.K + t.k0 + 8 * c) = o; }
    LDS_WAIT(); asm volatile("" ::: "memory");
}
__device__ __forceinline__ void rms_row_to_bf16(const float* xrow, bf16* orow, float* n0, int lane) {
    const GAS f32x4* xr = (const GAS f32x4*)xrow + lane;
    f32x4 v[4]; float s = 0.f;
#pragma unroll
    for (int j = 0; j < 4; ++j) { v[j] = __builtin_nontemporal_load(xr + 64 * j); s += (v[j].x * v[j].x + v[j].y * v[j].y) + (v[j].z * v[j].z + v[j].w * v[j].w); }
    const float rs = 1.f / sqrtf(wave_sum(s) * (1.f / D) + EPS);
    if (lane == 0 && n0) *n0 = 1.f / rs;
    GAS v2u* o8 = (GAS v2u*)orow + lane;
#pragma unroll
    for (int j = 0; j < 4; ++j) { v2u w; w.x = pk2(v[j].x * rs, v[j].y * rs); w.y = pk2(v[j].z * rs, v[j].w * rs); o8[64 * j] = w; }
}
__device__ __forceinline__ void rms_rows2_to_bf16(const float* x0, bf16* o0, const float* x1, bf16* o1, float* n0, float* n1, int lane) {
    const GAS f32x4* a0 = (const GAS f32x4*)x0 + lane; const GAS f32x4* a1 = (const GAS f32x4*)x1 + lane;
    f32x4 v[4], w[4]; float s = 0.f, t = 0.f;
#pragma unroll
    for (int j = 0; j < 4; ++j) { v[j] = __builtin_nontemporal_load(a0 + 64 * j); w[j] = __builtin_nontemporal_load(a1 + 64 * j); }
#pragma unroll
    for (int j = 0; j < 4; ++j) { s += (v[j].x * v[j].x + v[j].y * v[j].y) + (v[j].z * v[j].z + v[j].w * v[j].w); t += (w[j].x * w[j].x + w[j].y * w[j].y) + (w[j].z * w[j].z + w[j].w * w[j].w); }
    const float rs = 1.f / sqrtf(wave_sum(s) * (1.f / D) + EPS), rt_ = 1.f / sqrtf(wave_sum(t) * (1.f / D) + EPS);
    GAS v2u* p0 = (GAS v2u*)o0 + lane; GAS v2u* p1 = (GAS v2u*)o1 + lane;
    if (lane == 0) { if (n0) *n0 = 1.f / rs; if (n1) *n1 = 1.f / rt_; }
#pragma unroll
    for (int j = 0; j < 4; ++j) { v2u u; u.x = pk2(v[j].x * rs, v[j].y * rs); u.y = pk2(v[j].z * rs, v[j].w * rs); p0[64 * j] = u;
        v2u z; z.x = pk2(w[j].x * rt_, w[j].y * rt_); z.y = pk2(w[j].z * rt_, w[j].w * rt_); p1[64 * j] = z; }
}
__device__ __forceinline__ const float* xrow_ptr(const Args& a, int row) { return row < MP ? a.in[0] + (size_t)row * D : a.in[1] + (size_t)(row - MP) * D; }

constexpr int I_IN = 16 * 64, I_KV = 16 * 64, I_WP = 4 * 2 * 4, N_EARLY = I_IN + I_KV + I_WP;
constexpr int I_OUT = 16 * 32, I_Q = 16 * 32, I_CO = 16 * 32, I_UP = 16 * 128, I_DN = 64 * 32, I_VS = 64 * 4 * 8, N_ITEMS = N_EARLY + I_OUT + I_Q + I_CO + I_UP + I_DN + I_VS;
constexpr int DN_LO = N_EARLY + I_OUT + I_Q + I_CO + I_UP, DN_HI = DN_LO + I_DN;
__device__ __forceinline__ TItem p0_item(const Args& a, int it) {
    unsigned char* ws = a.ws; TItem t; t.g = nullptr; t.gn = nullptr; t.sc = 1.f; t.kperm = 0;
    int r = it;
    if (r < I_IN) { const int kb = r / 64, nb = r % 64, n0 = 32 * nb; int src;
        if (n0 < 1024) src = n0; else { const int j = (n0 - 1024) >> 8, o = (n0 - 1024) & 255; src = o < 128 ? 1024 + 128 * j + o : 1536 + 128 * j + (o - 128); }
        t.W = a.in[8]; t.ldw = NIN; t.K = D; t.srccol = src; t.WT = (bf16*)(ws + WS_WIN); t.dstrow = n0; t.k0 = 64 * kb; t.g = a.in[7]; return t; } r -= I_IN;
    if (r < I_KV) { const int kb = r / 64, nb = r % 64, n0 = 32 * nb;
        t.W = n0 < 1024 ? a.in[17] : a.in[18]; t.ldw = D; t.K = D; t.srccol = n0 & 1023; t.WT = (bf16*)(ws + WS_WKV); t.dstrow = n0; t.k0 = 64 * kb; t.g = a.in[16]; return t; } r -= I_KV;
    if (r < I_WP) { const int gi = r / 8, kb = (r % 8) / 4, nb = r % 4;
        t.W = a.in[9] + gi * 16384; t.ldw = 128; t.K = 128; t.srccol = 32 * nb; t.WT = (bf16*)(ws + WS_WP) + gi * 16384; t.dstrow = 32 * nb; t.k0 = 64 * kb; t.gn = a.in[10] + gi * 128; t.kperm = 2; return t; } r -= I_WP;
    if (r < I_OUT) { t.W = a.in[14]; t.ldw = D; t.K = D; t.srccol = 32 * (r % 32); t.WT = (bf16*)(ws + WS_WOUT); t.dstrow = t.srccol; t.k0 = 64 * (r / 32);
        t.g = t.k0 < 512 ? a.in[12] : a.in[13] - 512; return t; } r -= I_OUT;
    if (r < I_Q) { t.W = a.in[20]; t.ldw = D; t.K = D; t.srccol = 32 * (r % 32); t.WT = (bf16*)(ws + WS_WQ); t.dstrow = t.srccol; t.k0 = 64 * (r / 32); t.g = a.in[19]; t.sc = 0.0625f; return t; } r -= I_Q;
    if (r < I_CO) { t.W = a.in[21]; t.ldw = D; t.K = D; t.srccol = 32 * (r % 32); t.WT = (bf16*)(ws + WS_WCO); t.dstrow = t.srccol; t.k0 = 64 * (r / 32); return t; } r -= I_CO;
    if (r < I_UP) { t.W = a.in[24]; t.ldw = FF; t.K = D; t.srccol = 32 * (r % 128); t.WT = (bf16*)(ws + WS_WUP); t.dstrow = t.srccol; t.k0 = 64 * (r / 128); t.g = a.in[23]; return t; } r -= I_UP;
    if (r < I_DN) { t.W = a.in[25]; t.ldw = D; t.K = FF; t.srccol = 32 * (r % 32); t.WT = (bf16*)(ws + WS_WDOWN); t.dstrow = t.srccol; t.k0 = 64 * (r / 32); return t; } r -= I_DN;
    { const int sbh = r / 32, kb = (r % 32) / 8, nb = r % 8, sb = sbh >> 2, h = sbh & 3;
        t.W = a.in[5] + (size_t)sb * 262144 + h * 256; t.ldw = 1024; t.K = 256; t.srccol = 32 * nb; t.WT = (bf16*)(ws + WS_VTS) + (size_t)sbh * 65536; t.dstrow = 32 * nb; t.k0 = 64 * kb; t.kperm = 1; return t; }
}
__device__ __forceinline__ void p0_items(const Args& a, LAS float* scr, int lo, int hi, int gw, int NGW, int lane) {
    int it = lo + gw; TItem cur; TRegs rc;
    if (it < hi) { cur = p0_item(a, it); t_load(cur, rc, lane); }
    while (it < hi) {
        const int nx = it + NGW; TItem nxt = cur; TRegs rn = rc;
        if (nx < hi) { nxt = p0_item(a, nx); t_load(nxt, rn, lane); }
        t_process(cur, rc, scr, lane);
        cur = nxt; rc = rn; it = nx;
    }
}
__device__ __forceinline__ void p0_prologue(const Args& a, LAS unsigned char* lds, int gw, int NGW, int wave, int lane_) {
    int lane = lane_; asm volatile("" : "+v"(lane));
    unsigned char* ws = a.ws;
    p0_items(a, (LAS float*)(lds + wave * 16384), 0, N_EARLY, gw, NGW, lane);
    float* rn = (float*)(ws + WS_RNORM);
    for (int m = gw; m < M + 1024; m += 2 * NGW) {
        const int m2 = m + NGW;
        const float* r0 = m < M ? xrow_ptr(a, m) : a.in[6] + (size_t)(m - M) * D; bf16* o0 = m < M ? (bf16*)(ws + WS_XN) + (size_t)m * D : (bf16*)(ws + WS_MN) + (size_t)(m - M) * D;
        if (m2 < M + 1024) {
            const float* r1 = m2 < M ? xrow_ptr(a, m2) : a.in[6] + (size_t)(m2 - M) * D; bf16* o1 = m2 < M ? (bf16*)(ws + WS_XN) + (size_t)m2 * D : (bf16*)(ws + WS_MN) + (size_t)(m2 - M) * D;
            rms_rows2_to_bf16(r0, o0, r1, o1, m < MP ? rn + m : nullptr, m2 < MP ? rn + m2 : nullptr, lane);
        } else rms_row_to_bf16(r0, o0, m < MP ? rn + m : nullptr, lane);
    }
    { GAS v4u* dst = (GAS v4u*)(ws + WS_HISTU); constexpr int NU = 16 * 15 * 512 / 8, NV = 16 * 2 * 512 / 8;
      for (int i = gw * 64 + lane; i < NU + NV; i += NGW * 64) { const GAS f32x4* src = i < NU ? (const GAS f32x4*)a.in[2] + 2 * i : (const GAS f32x4*)a.in[3] + 2 * (i - NU); const f32x4 p = src[0], q = src[1];
          v4u o; o.x = pk2(p.x, p.y); o.y = pk2(p.z, p.w); o.z = pk2(q.x, q.y); o.w = pk2(q.z, q.w); dst[i] = o; } }
}
__device__ __forceinline__ void p2_late(const Args& a, LAS unsigned char* lds, int gw, int NGW, int wave, int lane_) {
    int lane = lane_; asm volatile("" : "+v"(lane));
    unsigned char* ws = a.ws;
    p0_items(a, (LAS float*)(lds + wave * 16384), N_EARLY, DN_LO, gw, NGW, lane);
    p0_items(a, (LAS float*)(lds + wave * 16384), DN_HI, N_ITEMS, gw, NGW, lane);
    { const GAS f32x4* src = (const GAS f32x4*)a.in[4]; GAS v4u* dst = (GAS v4u*)(ws + WS_KBS); const size_t n = (size_t)16 * 256 * 1024 / 8, st = (size_t)NGW * 64;
      for (size_t i = (size_t)gw * 64 + lane; i < n; i += 4 * st) { f32x4 p[4], q[4];
#pragma unroll
          for (int k = 0; k < 4; ++k) if (i + k * st < n) { p[k] = __builtin_nontemporal_load(src + 2 * (i + k * st)); q[k] = __builtin_nontemporal_load(src + 2 * (i + k * st) + 1); }
#pragma unroll
          for (int k = 0; k < 4; ++k) if (i + k * st < n) { v4u o; o.x = pk2(p[k].x, p[k].y); o.y = pk2(p[k].z, p[k].w); o.z = pk2(q[k].x, q[k].y); o.w = pk2(q[k].z, q[k].w); dst[i + k * st] = o; } } }
}

__device__ __forceinline__ void load8(const bf16* p, float (&f)[8]) { const v4u w = *(const GAS v4u*)p; f[0] = bflo(w.x); f[1] = bfhi(w.x); f[2] = bflo(w.y); f[3] = bfhi(w.y); f[4] = bflo(w.z); f[5] = bfhi(w.z); f[6] = bflo(w.w); f[7] = bfhi(w.w); }
__device__ __forceinline__ void load8f(const float* p, float (&f)[8]) { const f32x4 a = *(const GAS f32x4*)p, b = *(const GAS f32x4*)(p + 4); f[0] = a.x; f[1] = a.y; f[2] = a.z; f[3] = a.w; f[4] = b.x; f[5] = b.y; f[6] = b.z; f[7] = b.w; }
__device__ __forceinline__ void acc8(const v4u w, float (&s)[8]) { s[0] += bflo(w.x); s[1] += bfhi(w.x); s[2] += bflo(w.y); s[3] += bfhi(w.y); s[4] += bflo(w.z); s[5] += bfhi(w.z); s[6] += bflo(w.w); s[7] += bfhi(w.w); }
__device__ __forceinline__ void mixer_stage_wp(LAS unsigned char* lds, const bf16* WPt, int wave, int lane) {
    const GAS char* gb = (const GAS char*)WPt + (size_t)wave * 16384;
    const unsigned rl4 = (unsigned)lane >> 4, l15 = (unsigned)lane & 15u;
#pragma unroll
    for (int n = 0; n < 16; ++n) { const unsigned rl = 4u * n + rl4;
        __builtin_amdgcn_global_load_lds((const GAS unsigned*)(gb + rl * 256u + ((l15 ^ (rl & 15u)) << 4)), (LAS unsigned*)(lds + (wave * 16 + n) * 1024), 16, 0, 0); }
}
__device__ __forceinline__ unsigned off_b(unsigned row, unsigned ch) { return 256u * row + 16u * (ch ^ (((row & 3u) << 2) | ((row >> 2) & 3u))); }
template <int GI> __device__ __forceinline__ void pool_issue(const Args& a, LAS unsigned char* tile, int row0, int nblk, bool sample, int lane) {
    constexpr int W = 2 << GI;
    const unsigned fr = lane & 15, fq = lane >> 4;
    const int nrows = 16 * nblk + W - 1, t0 = sample ? 0 : (row0 & 4095), sb = (row0 >> 4) & 15;
    const GAS char* wsb = (const GAS char*)a.ws;
#pragma unroll
    for (int n = 0; n < 16; ++n) if (n < 4 * nblk + 4) {
        const int r = 4 * n + (int)fq, tt = t0 - (W - 1) + r;
        unsigned o;
        if (r >= nrows) o = (unsigned)WS_ZERO;
        else if (tt >= 0) o = (unsigned)WS_P1 + (unsigned)(row0 - (W - 1) + r) * 3072u + (unsigned)(GI * 256);
        else o = sample ? (unsigned)WS_HISTU + (unsigned)(sb * 15 + 15 + tt) * 1024u + (unsigned)(GI * 256) : (unsigned)WS_ZERO;
        const unsigned lc = fr ^ ((fq << 2) | (unsigned)(n & 3));
        __builtin_amdgcn_global_load_lds((const GAS unsigned*)(wsb + o + (lc << 4)), (LAS unsigned*)(tile + n * 1024), 16, 0, 0); }
}
template <int GI> __device__ __forceinline__ void pool_compute(const Args& a, LAS unsigned char* lds, LAS unsigned char* tile, int row0, int nblk, bool sample, int lane) {
    constexpr int W = 2 << GI;
    const int fr = lane & 15, fq = lane >> 4;
    bf16x8 wf[4][8];
    { const bf16* wp = (const bf16*)(a.ws + WS_WP) + GI * 16384 + (size_t)fr * 128 + fq * 8;
#pragma unroll
      for (int ks = 0; ks < 4; ++ks)
#pragma unroll
          for (int db = 0; db < 8; ++db) wf[ks][db] = *(const GAS bf16x8*)(wp + db * 2048 + ks * 32); }
    const unsigned tb = (unsigned)(size_t)tile, qq = (unsigned)(lane & 15) >> 2, pp = (unsigned)lane & 3u;
    bf16x8 cfg;
    { float cw[8]; int fr_ = fr, r8 = 8 * fq; asm volatile("" : "+v"(fr_), "+v"(r8));
#pragma unroll
      for (int jj = 0; jj < 8; ++jj) { const int r = r8 + jj; cw[jj] = ((r >= fr_ && r <= fr_ + W - 1) ? (1.f / W) : 0.f) - (r == fr_ + W - 1 ? 1.f : 0.f); }
      v4u pc; pc.x = pk2(cw[0], cw[1]); pc.y = pk2(cw[2], cw[3]); pc.z = pk2(cw[4], cw[5]); pc.w = pk2(cw[6], cw[7]); cfg = __builtin_bit_cast(bf16x8, pc); }
    asm volatile("s_waitcnt vmcnt(0)" ::: "memory");
#pragma unroll 1
    for (int i = 0; i < nblk; ++i) {
        const int row = row0 + 16 * i + fr, t = sample ? fr : (row & 4095);
        const float inv = sample ? (1.f / W) : 1.f / (float)(t + 1 < W ? t + 1 : W);
        bf16x8 cf = cfg;
        if (!sample && ((row0 + 16 * i) & 4095) == 0) {
          float cw[8];
          int fr_ = fr, r8 = 8 * fq; asm volatile("" : "+v"(fr_), "+v"(r8));
#pragma unroll
          for (int jj = 0; jj < 8; ++jj) { const int r = r8 + jj; cw[jj] = ((r >= fr_ && r <= fr_ + W - 1) ? inv : 0.f) - (r == fr_ + W - 1 ? 1.f : 0.f); }
          v4u pc; pc.x = pk2(cw[0], cw[1]); pc.y = pk2(cw[2], cw[3]); pc.z = pk2(cw[4], cw[5]); pc.w = pk2(cw[6], cw[7]); cf = __builtin_bit_cast(bf16x8, pc); }
        v4u pa[4];
#pragma unroll
        for (int cb = 0; cb < 8; cb += 2) {
            unsigned ad[4];
#pragma unroll
            for (int k = 0; k < 4; ++k) { const unsigned c_ = cb + (k >> 1), tt = k & 1; ad[k] = tb + 4096u * i + off_b(8u * fq + 4u * tt + qq, 2u * c_ + (pp >> 1)) + 8u * (pp & 1u); }
            v2u r0, r1, r2, r3;
            asm volatile("ds_read_b64_tr_b16 %0, %4\n\tds_read_b64_tr_b16 %1, %5\n\tds_read_b64_tr_b16 %2, %6\n\tds_read_b64_tr_b16 %3, %7\n\ts_waitcnt lgkmcnt(0)"
                         : "=&v"(r0), "=&v"(r1), "=&v"(r2), "=&v"(r3) : "v"(ad[0]), "v"(ad[1]), "v"(ad[2]), "v"(ad[3]) : "memory");
            v4u f0; f0.x = r0.x; f0.y = r0.y; f0.z = r1.x; f0.w = r1.y;
            v4u f1; f1.x = r2.x; f1.y = r2.y; f1.z = r3.x; f1.w = r3.y;
            const pg8::f32x4 p0 = __builtin_amdgcn_mfma_f32_16x16x32_bf16(__builtin_bit_cast(bf16x8, f0), cf, (pg8::f32x4){0.f, 0.f, 0.f, 0.f}, 0, 0, 0);
            const pg8::f32x4 p1 = __builtin_amdgcn_mfma_f32_16x16x32_bf16(__builtin_bit_cast(bf16x8, f1), cf, (pg8::f32x4){0.f, 0.f, 0.f, 0.f}, 0, 0, 0);
            pa[cb >> 1].x = pk2c(p0[0], p0[1]); pa[cb >> 1].y = pk2c(p0[2], p0[3]); pa[cb >> 1].z = pk2c(p1[0], p1[1]); pa[cb >> 1].w = pk2c(p1[2], p1[3]);
        }
        pg8::f32x4 acc[8];
#pragma unroll
        for (int db = 0; db < 8; ++db) acc[db] = (pg8::f32x4){0.f, 0.f, 0.f, 0.f};
#pragma unroll
        for (int ks = 0; ks < 4; ++ks) { const bf16x8 pf = __builtin_bit_cast(bf16x8, pa[ks]);
#pragma unroll
            for (int db = 0; db < 8; ++db) acc[db] = __builtin_amdgcn_mfma_f32_16x16x32_bf16(wf[ks][db], pf, acc[db], 0, 0, 0); }
        float ss = 0.f;
#pragma unroll
        for (int db = 0; db < 8; ++db) ss += (acc[db][0] * acc[db][0] + acc[db][1] * acc[db][1]) + (acc[db][2] * acc[db][2] + acc[db][3] * acc[db][3]);
        ss += __shfl_xor(ss, 16); ss += __shfl_xor(ss, 32);
        const float rs = 1.f / sqrtf(ss * (1.f / 128.f) + EPS);
        bf16* MRG = (bf16*)(a.ws + WS_MRG);
#pragma unroll
        for (int db = 0; db < 8; ++db) { const f32x4 o = acc[db] * rs;
            v2u w; w.x = pk2(o[0], o[1]); w.y = pk2(o[2], o[3]); *(GAS v2u*)(MRG + (size_t)row * D + GI * 128 + 16 * db + 4 * fq) = w; }
    }
}
__device__ __forceinline__ f32x2 up2(unsigned w) { f32x2 r; r.x = bflo(w); r.y = bfhi(w); return r; }
__device__ __forceinline__ unsigned pk2v(f32x2 v) { const bf16n2 b = __builtin_convertvector(v, bf16n2); return __builtin_bit_cast(unsigned, b); }
template <int CTRL> __device__ __forceinline__ float dpp_f(float v) { return __builtin_bit_cast(float, __builtin_amdgcn_update_dpp(0, __builtin_bit_cast(int, v), CTRL, 0xf, 0xf, true)); }
__device__ __forceinline__ void conv_half(const Args& a, int row0, int half, bool sample, int lane) {
    const bf16* P1 = (const bf16*)(a.ws + WS_P1); bf16* MRG = (bf16*)(a.ws + WS_MRG);
    const int ch = 8 * lane, i0 = 8 * half;
    const bf16* histv = sample ? (const bf16*)(a.ws + WS_HISTV) + (size_t)(((row0 >> 4) & 15) * 2 + 2) * 512 : (const bf16*)(a.ws + WS_ZERO);
    const int hstep = sample ? 512 : 0, t0 = sample ? 0 : (row0 & 4095);
    v4u xv[10], xb[8];
#pragma unroll
    for (int k = 0; k < 10; ++k) { const int i = i0 + k - 2; const bf16* p = (t0 + i >= 0) ? P1 + (size_t)(row0 + i) * 1536 + 1024 : histv + (ptrdiff_t)i * hstep; xv[k] = *(const GAS v4u*)(p + ch); }
#pragma unroll
    for (int k = 0; k < 8; ++k) xb[k] = *(const GAS v4u*)(P1 + (size_t)(row0 + i0 + k) * 1536 + 512 + ch);
    f32x2 w0[4], w1[4], w2[4];
#pragma unroll
    for (int q = 0; q < 4; ++q) { w0[q] = *(const GAS f32x2*)(a.in[11] + ch + 2 * q); w1[q] = *(const GAS f32x2*)(a.in[11] + 512 + ch + 2 * q); w2[q] = *(const GAS f32x2*)(a.in[11] + 1024 + ch + 2 * q); }
    f32x2 va[4], vb[4], vc[4];
#pragma unroll
    for (int q = 0; q < 4; ++q) { va[q] = up2(xv[0][q]); vb[q] = up2(xv[1][q]); }
#pragma unroll
    for (int k = 0; k < 8; ++k) {
        f32x2 y[4]; f32x2 s2 = {0.f, 0.f};
#pragma unroll
        for (int q = 0; q < 4; ++q) { vc[q] = up2(xv[k + 2][q]); const f32x2 bg = up2(xb[k][q]);
            f32x2 cv = w0[q] * va[q]; cv = __builtin_elementwise_fma(w1[q], vb[q], cv); cv = __builtin_elementwise_fma(w2[q], vc[q], cv);
            y[q] = bg * cv; s2 = __builtin_elementwise_fma(y[q], y[q], s2); }
        float ss = s2.x + s2.y;
        ss += dpp_f<0xB1>(ss); ss += dpp_f<0x4E>(ss); ss += dpp_f<0x141>(ss);
        const float rs = 1.f / sqrtf(ss * (1.f / 64.f) + EPS);
        v4u o;
#pragma unroll
        for (int q = 0; q < 4; ++q) { const f32x2 r2 = {rs, rs}; o[q] = pk2v(y[q] * r2); }
        *(GAS v4u*)(MRG + (size_t)(row0 + i0 + k) * D + 512 + ch) = o;
#pragma unroll
        for (int q = 0; q < 4; ++q) { va[q] = vb[q]; vb[q] = vc[q]; }
    }
}
__device__ __forceinline__ void unpack8(const v4u w, float (&f)[8]) { f[0] = bflo(w.x); f[1] = bfhi(w.x); f[2] = bflo(w.y); f[3] = bfhi(w.y); f[4] = bflo(w.z); f[5] = bfhi(w.z); f[6] = bflo(w.w); f[7] = bfhi(w.w); }
__device__ __forceinline__ int mixer_blk(int xg, int bl) { return xg < 0 ? bl : (bl < 128 ? xg * 128 + bl : 1024 + xg * 2 + (bl - 128)); }
template <int GI> __device__ __forceinline__ void mixer_wave(const Args& a, LAS unsigned char* lds, int xg, int j, int nj, int wave, int lane) {
    LAS unsigned char* tile = lds + wave * 16384;
    if (xg >= 0 && nj == 56) {
        int bl0 = -1, nblk = 0;
        if (j < 42) { bl0 = 3 * j; nblk = 3; } else if (j == 42) { bl0 = 126; nblk = 2; } else if (j < 45) { bl0 = 128 + (j - 43); nblk = 1; }
        const int row0 = bl0 >= 0 ? mixer_blk(xg, bl0) * 16 : 0; const bool sample = row0 >= MP;
        if (nblk) pool_issue<GI>(a, tile, row0, nblk, sample, lane);
        int c0 = -1, c1 = -1;
        if (j >= 45) { c0 = 2 * (j - 45); c1 = c0 + 1; } else if (j <= 42) c0 = 22 + j;
        if (c0 >= 0) { const int h = 4 * c0 + GI, r0 = mixer_blk(xg, h >> 1) * 16; conv_half(a, r0, h & 1, r0 >= MP, lane); }
        if (c1 >= 0) { const int h = 4 * c1 + GI, r0 = mixer_blk(xg, h >> 1) * 16; conv_half(a, r0, h & 1, r0 >= MP, lane); }
        asm volatile("" ::: "memory");
        if (nblk) pool_compute<GI>(a, lds, tile, row0, nblk, sample, lane);
    } else {
        const int nb = xg >= 0 ? 130 : M / 16;
        for (int bl = j; bl < nb; bl += nj) { const int row0 = mixer_blk(xg, bl) * 16;
            pool_issue<GI>(a, tile, row0, 1, row0 >= MP, lane); pool_compute<GI>(a, lds, tile, row0, 1, row0 >= MP, lane); }
        for (int h = j * 4 + GI; h < 2 * nb; h += nj * 4) { const int r0 = mixer_blk(xg, h >> 1) * 16; conv_half(a, r0, h & 1, r0 >= MP, lane); }
    }
}
__device__ __forceinline__ void mixer_all(const Args& a, LAS unsigned char* lds, int xg, int cu, int ncu, int wave, int lane_) {
    int lane = lane_; asm volatile("" : "+v"(lane));
    const int gi = wave & 3, j = cu * 2 + (wave >> 2), nj = ncu * 2;
    if (gi == 0) mixer_wave<0>(a, lds, xg, j, nj, wave, lane);
    else if (gi == 1) mixer_wave<1>(a, lds, xg, j, nj, wave, lane);
    else if (gi == 2) mixer_wave<2>(a, lds, xg, j, nj, wave, lane);
    else mixer_wave<3>(a, lds, xg, j, nj, wave, lane);
}

__device__ __forceinline__ void resid_row(const float* base, const float* raw, const float* g, float* xo, bf16* xn, int lane_) {
    int lane = lane_; asm volatile("" : "+v"(lane));
    const GAS f32x4* rr = (const GAS f32x4*)raw + lane; const GAS f32x4* bb = (const GAS f32x4*)base + lane; const GAS f32x4* gg = (const GAS f32x4*)g + lane;
    f32x4 v[4]; float s = 0.f;
#pragma unroll
    for (int j = 0; j < 4; ++j) { v[j] = rr[64 * j]; s += (v[j].x * v[j].x + v[j].y * v[j].y) + (v[j].z * v[j].z + v[j].w * v[j].w); }
    const float rs = 1.f / sqrtf(wave_sum(s) * (1.f / D) + EPS);
    float s2 = 0.f;
#pragma unroll
    for (int j = 0; j < 4; ++j) { v[j] = bb[64 * j] + v[j] * rs * gg[64 * j]; s2 += (v[j].x * v[j].x + v[j].y * v[j].y) + (v[j].z * v[j].z + v[j].w * v[j].w); }
    GAS f32x4* oo = (GAS f32x4*)xo + lane;
#pragma unroll
    for (int j = 0; j < 4; ++j) oo[64 * j] = v[j];
    if (xn) { const float r2 = 1.f / sqrtf(wave_sum(s2) * (1.f / D) + EPS); GAS v2u* o8 = (GAS v2u*)xn + lane;
#pragma unroll
        for (int j = 0; j < 4; ++j) { v2u w; w.x = pk2(v[j].x * r2, v[j].y * r2); w.y = pk2(v[j].z * r2, v[j].w * r2); o8[64 * j] = w; } }
}

#define MFMA32(a, b, c) __builtin_amdgcn_mfma_f32_32x32x16_bf16((a), (b), (c), 0, 0, 0)
__device__ __forceinline__ bf16x8 pack8(const f32x16& x, int s) {
    v4u p; p.x = pk2(x[8 * s], x[8 * s + 1]); p.y = pk2(x[8 * s + 2], x[8 * s + 3]); p.z = pk2(x[8 * s + 4], x[8 * s + 5]); p.w = pk2(x[8 * s + 6], x[8 * s + 7]);
    return __builtin_bit_cast(bf16x8, p);
}
__device__ __forceinline__ void attn_stage(LAS unsigned char* lds, const bf16* G, unsigned pitch  , int wave, int lane) {
    const GAS char* gb = (const GAS char*)G + (size_t)wave * 32 * pitch;
    const unsigned hi = (unsigned)lane >> 5, l31 = (unsigned)lane & 31u;
#pragma unroll
    for (int n = 0; n < 16; ++n) { const unsigned rl = 2u * n + hi;
        const unsigned off = rl * pitch + ((l31 ^ (rl & 15u)) << 4);
        __builtin_amdgcn_global_load_lds((const GAS unsigned*)(gb + off), (LAS unsigned*)(lds + (wave * 16 + n) * 1024), 16, 0, 0); }
}
__device__ __forceinline__ void attn_unit(LAS unsigned char* lds, const bf16* Qb, bf16* Ob, unsigned qoff, const bf16* Kg, const bf16* VTg, bool store, int wave, int lane_) {
    int lane = lane_; asm volatile("" : "+v"(lane));
    const int r = lane & 31, h = lane >> 5;
    attn_stage(lds, Kg, 2048u, wave, lane);
    const GAS char* qp = (const GAS char*)Qb;
    const unsigned qo = qoff + 16u * h;
    const unsigned x = (unsigned)(h ^ (r & 15));
    const LAS unsigned char* fo[8]; const LAS unsigned char* fo2[8];
#pragma unroll
    for (int k = 0; k < 8; ++k) { fo[k] = lds + ((unsigned)r * 512u + (((unsigned)(2 * k) ^ x) * 16u)); fo2[k] = fo[k] + 65536; asm volatile("" : "+v"(fo2[k])); }
    bf16x8 qf[8];
#pragma unroll
    for (int k = 0; k < 8; ++k) qf[k] = *(const GAS bf16x8*)(qp + qo + 32 * k);
    asm volatile("s_waitcnt vmcnt(0)" ::: "memory"); __syncthreads();
    f32x16 s[8];
#pragma unroll
    for (int mb = 0; mb < 8; ++mb)
#pragma unroll
        for (int i = 0; i < 16; ++i) s[mb][i] = 0.f;
#pragma unroll
    for (int hf = 0; hf < 2; ++hf) {
        if (hf == 1) {
#pragma unroll
            for (int k = 0; k < 8; ++k) qf[k] = *(const GAS bf16x8*)(qp + qo + 256 + 32 * k);
        }
        bf16x8 kc[8], kn[8];
#pragma unroll
        for (int k = 0; k < 8; ++k) kc[k] = *(const LAS bf16x8*)(fo[k] + hf * 256);
#pragma unroll
        for (int mb = 0; mb < 8; ++mb) {
            if (mb < 7) {
#pragma unroll
                for (int k = 0; k < 8; ++k) kn[k] = *(const LAS bf16x8*)((mb + 1 < 4 ? fo[k] : fo2[k]) + (((mb + 1) & 3) * 16384 + hf * 256)); }
            __builtin_amdgcn_s_setprio(1);
#pragma unroll
            for (int k = 0; k < 8; ++k) s[mb] = MFMA32(kc[k], qf[k], s[mb]);
            __builtin_amdgcn_s_setprio(0);
#pragma unroll
            for (int k = 0; k < 8; ++k) kc[k] = kn[k];
            asm volatile("" ::: "memory");
        }
    }
    asm volatile("s_waitcnt lgkmcnt(0)" ::: "memory"); __syncthreads();
    { int lane2 = lane; asm volatile("" : "+v"(lane2)); attn_stage(lds, VTg, 512u, wave, lane2); }
    float mx = -3.0e38f;
#pragma unroll
    for (int mb = 0; mb < 8; ++mb)
#pragma unroll
        for (int i = 0; i < 16; ++i) mx = fmaxf(mx, s[mb][i]);
    mx = fmaxf(mx, __shfl_xor(mx, 32));
    float sum; { const float nmc = -mx * 1.44269504089f; const f32x2 c2 = {1.44269504089f, 1.44269504089f}, m2 = {nmc, nmc}; f32x2 sum2 = {0.f, 0.f};
#pragma unroll
    for (int mb = 0; mb < 8; ++mb)
#pragma unroll
        for (int i = 0; i < 16; i += 2) { const f32x2 t = __builtin_elementwise_fma((f32x2){s[mb][i], s[mb][i + 1]}, c2, m2);
            const f32x2 p = {__builtin_amdgcn_exp2f(t.x), __builtin_amdgcn_exp2f(t.y)}; s[mb][i] = p.x; s[mb][i + 1] = p.y; sum2 += p; }
    sum = sum2.x + sum2.y; }
    sum += __shfl_xor(sum, 32);
    const float inv = 1.f / sum;
    bf16x8 pf[8][2];
#pragma unroll
    for (int mb = 0; mb < 8; ++mb) { pf[mb][0] = pack8(s[mb], 0); pf[mb][1] = pack8(s[mb], 1); }
    asm volatile("s_waitcnt vmcnt(0)" ::: "memory"); __syncthreads();
    GAS char* op = (GAS char*)Ob;
    bf16x8 vc[8], vn[8];
#pragma unroll
    for (int k = 0; k < 8; ++k) vc[k] = *(const LAS bf16x8*)(fo[k]);
#pragma unroll
    for (int eb = 0; eb < 8; ++eb) {
        f32x16 o;
#pragma unroll
        for (int i = 0; i < 16; ++i) o[i] = 0.f;
#pragma unroll
        for (int hv = 0; hv < 2; ++hv) {
            const int nstep = 2 * eb + hv + 1;
            if (nstep < 16) { const int neb = nstep >> 1, nhv = nstep & 1;
#pragma unroll
                for (int k = 0; k < 8; ++k) vn[k] = *(const LAS bf16x8*)((neb < 4 ? fo[k] : fo2[k]) + ((neb & 3) * 16384 + nhv * 256)); }
            __builtin_amdgcn_s_setprio(1);
#pragma unroll
            for (int k = 0; k < 8; ++k) o = MFMA32(vc[k], pf[4 * hv + (k >> 1)][k & 1], o);
            __builtin_amdgcn_s_setprio(0);
#pragma unroll
            for (int k = 0; k < 8; ++k) vc[k] = vn[k];
            asm volatile("" ::: "memory");
        }
        if (store) {
#pragma unroll
            for (int g = 0; g < 4; ++g) { v2u w; w.x = pk2(o[4 * g] * inv, o[4 * g + 1] * inv); w.y = pk2(o[4 * g + 2] * inv, o[4 * g + 3] * inv);
                *(GAS v2u*)(op + qoff + 8u * h + (64 * eb + 16 * g)) = w; }
        }
    }
    asm volatile("s_waitcnt lgkmcnt(0)" ::: "memory"); __syncthreads();
}

__device__ __forceinline__ void attn_unit_small(LAS unsigned char* lds, const bf16* Qb, bf16* Ob, const bf16* Kg, const bf16* VTg, int wave, int lane_) {
    int lane = lane_; asm volatile("" : "+v"(lane));
    const int r = lane & 31, h = lane >> 5;
    const GAS char* qp = (const GAS char*)Qb; const GAS char* kp = (const GAS char*)Kg + (size_t)wave * 65536; const GAS char* vp = (const GAS char*)VTg + (size_t)wave * 16384;
    const unsigned qo = (unsigned)(r & 15) * 2048u + 16u * h, ko = (unsigned)r * 2048u + 16u * h, vo = (unsigned)r * 512u + 16u * h;
    bf16x8 qf[16], kf[16], vf[16];
#pragma unroll
    for (int ks = 0; ks < 16; ++ks) { qf[ks] = *(const GAS bf16x8*)(qp + qo + 32 * ks); kf[ks] = *(const GAS bf16x8*)(kp + ko + 32 * ks); }
#pragma unroll
    for (int c = 0; c < 16; ++c) vf[c] = *(const GAS bf16x8*)(vp + vo + 32 * c);
    f32x16 s;
#pragma unroll
    for (int i = 0; i < 16; ++i) s[i] = 0.f;
#pragma unroll
    for (int ks = 0; ks < 16; ++ks) s = MFMA32(kf[ks], qf[ks], s);
    LAS float* red = (LAS float*)lds;
    LAS unsigned char* pbuf = lds + 4096;
    float mx = s[0];
#pragma unroll
    for (int i = 1; i < 16; ++i) mx = fmaxf(mx, s[i]);
    mx = fmaxf(mx, __shfl_xor(mx, 32));
    if (h == 0) red[wave * 32 + r] = mx;
    asm volatile("s_waitcnt lgkmcnt(0)" ::: "memory"); __syncthreads();
#pragma unroll
    for (int w = 0; w < 8; ++w) mx = fmaxf(mx, red[w * 32 + r]);
    float sum = 0.f;
#pragma unroll
    for (int i = 0; i < 16; ++i) { const float p = __builtin_amdgcn_exp2f((s[i] - mx) * 1.44269504089f); s[i] = p; sum += p; }
    sum += __shfl_xor(sum, 32);
    if (h == 0) red[256 + wave * 32 + r] = sum;
    *(LAS bf16x8*)(pbuf + (wave * 2 + 0) * 1024 + lane * 16) = pack8(s, 0);
    *(LAS bf16x8*)(pbuf + (wave * 2 + 1) * 1024 + lane * 16) = pack8(s, 1);
    asm volatile("s_waitcnt lgkmcnt(0)" ::: "memory"); __syncthreads();
    float tot = 0.f;
#pragma unroll
    for (int w = 0; w < 8; ++w) tot += red[256 + w * 32 + r];
    const float inv = 1.f / tot;
    f32x16 o;
#pragma unroll
    for (int i = 0; i < 16; ++i) o[i] = 0.f;
#pragma unroll
    for (int c = 0; c < 16; ++c) { const bf16x8 pf = *(const LAS bf16x8*)(pbuf + c * 1024 + lane * 16); o = MFMA32(vf[c], pf, o); }
    if (r < 16) { GAS char* op = (GAS char*)Ob + (unsigned)r * 2048u + 8u * h + 64u * wave;
#pragma unroll
        for (int g = 0; g < 4; ++g) { v2u w2; w2.x = pk2(o[4 * g] * inv, o[4 * g + 1] * inv); w2.y = pk2(o[4 * g + 2] * inv, o[4 * g + 3] * inv); *(GAS v2u*)(op + 16 * g) = w2; } }
    asm volatile("s_waitcnt lgkmcnt(0)" ::: "memory"); __syncthreads();
}

template <int NT, int KCH>
__device__ __forceinline__ void micro_gemm(LAS unsigned char* lds, const bf16* A, int lda, const bf16* Bt, int ldb, const int (&cb)[NT], int wave, int lane_, int tid_, float (&val)[NT][2]) {
    int lane = lane_, tid = tid_; asm volatile("" : "+v"(lane), "+v"(tid));
    constexpr int KB = (KCH > 8 && NT == 1) ? 16 : 8;
    const int r = lane & 31, h = lane >> 5;
    const GAS char* ap = (const GAS char*)A; const GAS char* bp = (const GAS char*)Bt;
    const unsigned ao = ((unsigned)r * lda + wave * (KCH * 16) + 8 * h) * 2u, bo = ((unsigned)r * ldb + wave * (KCH * 16) + 8 * h) * 2u;
    f32x16 acc[NT];
#pragma unroll
    for (int nt = 0; nt < NT; ++nt)
#pragma unroll
        for (int i = 0; i < 16; ++i) acc[nt][i] = 0.f;
#pragma unroll 1
    for (int kc = 0; kc < KCH; kc += KB) {
        bf16x8 af[KB], bfr[NT][KB];
#pragma unroll
        for (int i = 0; i < KB; ++i) af[i] = *(const GAS bf16x8*)(ap + ao + (kc + i) * 32);
#pragma unroll
        for (int nt = 0; nt < NT; ++nt)
#pragma unroll
            for (int i = 0; i < KB; ++i) bfr[nt][i] = *(const GAS bf16x8*)(bp + (size_t)cb[nt] * ldb * 2 + bo + (kc + i) * 32);
#pragma unroll
        for (int nt = 0; nt < NT; ++nt)
#pragma unroll
            for (int i = 0; i < KB; ++i) acc[nt] = MFMA32(af[i], bfr[nt][i], acc[nt]);
    }
    LAS float* part = (LAS float*)lds;
#pragma unroll
    for (int nt = 0; nt < NT; ++nt)
#pragma unroll
        for (int i = 0; i < 16; ++i) part[(wave * NT + nt) * 1024 + ((i & 3) + 8 * (i >> 2) + 4 * h) * 32 + r] = acc[nt][i];
    __syncthreads();
#pragma unroll
    for (int nt = 0; nt < NT; ++nt) { float s0 = 0.f, s1 = 0.f;
#pragma unroll
        for (int w = 0; w < 8; ++w) { const f32x2 p = *(const LAS f32x2*)(part + (w * NT + nt) * 1024 + 2 * tid); s0 += p.x; s1 += p.y; }
        val[nt][0] = s0; val[nt][1] = s1; }
}
__device__ __forceinline__ void micro_gemm_lds(LAS unsigned char* lds, const bf16* A, int lda, const bf16* Bt, int ldb, int cb0, int wave, int lane_, int tid_, float (&val)[1][2]) {
    int lane = lane_, tid = tid_; asm volatile("" : "+v"(lane), "+v"(tid));
    const int r = lane & 31, h = lane >> 5;
    LAS unsigned char* reg = lds + wave * 16384;
    __syncthreads();
    { const unsigned rq = (unsigned)lane >> 4, pc = (unsigned)lane & 15u;
      const GAS char* ap = (const GAS char*)A + wave * 256; const GAS char* bp = (const GAS char*)(Bt + (size_t)cb0 * ldb) + wave * 256;
#pragma unroll
      for (int n = 0; n < 8; ++n) { const unsigned row = 4u * n + rq, lc = pc ^ (row & 15u);
          __builtin_amdgcn_global_load_lds((const GAS unsigned*)(ap + row * (unsigned)(lda * 2) + lc * 16u), (LAS unsigned*)(reg + n * 1024), 16, 0, 0); }
#pragma unroll
      for (int n = 0; n < 8; ++n) { const unsigned row = 4u * n + rq, lc = pc ^ (row & 15u);
          __builtin_amdgcn_global_load_lds((const GAS unsigned*)(bp + row * (unsigned)(ldb * 2) + lc * 16u), (LAS unsigned*)(reg + 8192 + n * 1024), 16, 0, 0); } }
    f32x16 acc;
#pragma unroll
    for (int i = 0; i < 16; ++i) acc[i] = 0.f;
    const LAS unsigned char* fa = reg + r * 256; const unsigned x = (unsigned)(r & 15);
    asm volatile("s_waitcnt vmcnt(0)" ::: "memory");
    bf16x8 af[8], bfr[8];
#pragma unroll
    for (int i = 0; i < 8; ++i) { const unsigned pcx = ((unsigned)(2 * i + h) ^ x) * 16u; af[i] = *(const LAS bf16x8*)(fa + pcx); bfr[i] = *(const LAS bf16x8*)(fa + 8192 + pcx); }
#pragma unroll
    for (int i = 0; i < 8; ++i) acc = MFMA32(af[i], bfr[i], acc);
    asm volatile("s_waitcnt lgkmcnt(0)" ::: "memory");
    LAS float* part = (LAS float*)reg;
#pragma unroll
    for (int i = 0; i < 16; ++i) part[((i & 3) + 8 * (i >> 2) + 4 * h) * 32 + r] = acc[i];
    __syncthreads();
    float s0 = 0.f, s1 = 0.f;
#pragma unroll
    for (int w = 0; w < 8; ++w) { const f32x2 p = *(const LAS f32x2*)((const LAS float*)(lds + w * 16384) + 2 * tid); s0 += p.x; s1 += p.y; }
    val[0][0] = s0; val[0][1] = s1;
}
__device__ __forceinline__ void micro_gemm_lds_k4096(LAS unsigned char* lds, const bf16* A, int lda, const bf16* Bt, int ldb, int cb0, int wave, int lane_, int tid_, float (&val)[1][2]) {
    int lane = lane_, tid = tid_; asm volatile("" : "+v"(lane), "+v"(tid));
    const int r = lane & 31, h = lane >> 5;
    LAS unsigned char* reg = lds + wave * 16384;
    __syncthreads();
    const unsigned rq = (unsigned)lane >> 3, pc = (unsigned)lane & 7u;
    const GAS char* ap = (const GAS char*)A + wave * 128; const GAS char* bp = (const GAS char*)(Bt + (size_t)cb0 * ldb) + wave * 128;
    unsigned ao[4], bo[4];
#pragma unroll
    for (int n = 0; n < 4; ++n) { const unsigned row = 8u * n + rq, lc = pc ^ ((row >> 1) & 7u); ao[n] = row * (unsigned)(lda * 2) + lc * 16u; bo[n] = row * (unsigned)(ldb * 2) + lc * 16u; }
#define MG4K_ISSUE(rd) do { LAS unsigned char* dst_ = reg + ((rd) & 1) * 8192; \
        _Pragma("unroll") for (int n = 0; n < 4; ++n) __builtin_amdgcn_global_load_lds((const GAS unsigned*)(ap + (rd) * 1024 + ao[n]), (LAS unsigned*)(dst_ + n * 1024), 16, 0, 0); \
        _Pragma("unroll") for (int n = 0; n < 4; ++n) __builtin_amdgcn_global_load_lds((const GAS unsigned*)(bp + (rd) * 1024 + bo[n]), (LAS unsigned*)(dst_ + 4096 + n * 1024), 16, 0, 0); } while (0)
    f32x16 acc;
#pragma unroll
    for (int i = 0; i < 16; ++i) acc[i] = 0.f;
    const unsigned x = (unsigned)(r >> 1) & 7u;
    MG4K_ISSUE(0);
#pragma unroll
    for (int rd = 0; rd < 8; ++rd) {
        if (rd < 7) { MG4K_ISSUE(rd + 1); asm volatile("s_waitcnt vmcnt(8)" ::: "memory"); } else asm volatile("s_waitcnt vmcnt(0)" ::: "memory");
        const LAS unsigned char* fa = reg + (rd & 1) * 8192 + r * 128;
        bf16x8 af[4], bfr[4];
#pragma unroll
        for (int i = 0; i < 4; ++i) { const unsigned pcx = ((unsigned)(2 * i + h) ^ x) * 16u; af[i] = *(const LAS bf16x8*)(fa + pcx); bfr[i] = *(const LAS bf16x8*)(fa + 4096 + pcx); }
#pragma unroll
        for (int i = 0; i < 4; ++i) acc = MFMA32(af[i], bfr[i], acc);
        asm volatile("s_waitcnt lgkmcnt(0)" ::: "memory");
    }
#undef MG4K_ISSUE
    LAS float* part = (LAS float*)reg;
#pragma unroll
    for (int i = 0; i < 16; ++i) part[((i & 3) + 8 * (i >> 2) + 4 * h) * 32 + r] = acc[i];
    __syncthreads();
    float s0 = 0.f, s1 = 0.f;
#pragma unroll
    for (int w = 0; w < 8; ++w) { const f32x2 p = *(const LAS f32x2*)((const LAS float*)(lds + w * 16384) + 2 * tid); s0 += p.x; s1 += p.y; }
    val[0][0] = s0; val[0][1] = s1;
}
template <int NT>
__device__ __forceinline__ void micro_gemm_lds_nt(LAS unsigned char* lds, const bf16* A, int lda, const bf16* Bt, int ldb, const int (&cb)[NT], int wave, int lane_, int tid_, float (&val)[NT][2]) {
    int lane = lane_, tid = tid_; asm volatile("" : "+v"(lane), "+v"(tid));
    const int r = lane & 31, h = lane >> 5;
    LAS unsigned char* reg = lds + wave * 16384;
    __syncthreads();
    { const unsigned rq = (unsigned)lane >> 4, pc = (unsigned)lane & 15u; const GAS char* ap = (const GAS char*)A + wave * 256;
#pragma unroll
      for (int n = 0; n < 8; ++n) { const unsigned row = 4u * n + rq, lc = pc ^ (row & 15u);
          __builtin_amdgcn_global_load_lds((const GAS unsigned*)(ap + row * (unsigned)(lda * 2) + lc * 16u), (LAS unsigned*)(reg + n * 1024), 16, 0, 0); } }
    const unsigned rq8 = (unsigned)lane >> 3, pc8 = (unsigned)lane & 7u;
    unsigned bo[4];
#pragma unroll
    for (int n = 0; n < 4; ++n) { const unsigned row = 8u * n + rq8, lc = pc8 ^ ((row >> 1) & 7u); bo[n] = row * (unsigned)(ldb * 2) + lc * 16u; }
    const GAS char* bbase = (const GAS char*)Bt + wave * 256;
#define MGNT_ISSUE(rd) do { LAS unsigned char* dst_ = reg + 8192 + ((rd) & 1) * 4096; const GAS char* bp_ = bbase + (size_t)cb[(rd) >> 1] * ldb * 2 + ((rd) & 1) * 128; \
        _Pragma("unroll") for (int n = 0; n < 4; ++n) __builtin_amdgcn_global_load_lds((const GAS unsigned*)(bp_ + bo[n]), (LAS unsigned*)(dst_ + n * 1024), 16, 0, 0); } while (0)
    MGNT_ISSUE(0);
    f32x16 acc[NT];
#pragma unroll
    for (int nt = 0; nt < NT; ++nt)
#pragma unroll
        for (int i = 0; i < 16; ++i) acc[nt][i] = 0.f;
    asm volatile("s_waitcnt vmcnt(4)" ::: "memory");
    bf16x8 af[8];
    { const LAS unsigned char* fa = reg + r * 256; const unsigned x = (unsigned)(r & 15);
#pragma unroll
      for (int i = 0; i < 8; ++i) af[i] = *(const LAS bf16x8*)(fa + (((unsigned)(2 * i + h) ^ x) * 16u)); }
    const unsigned x8 = (unsigned)(r >> 1) & 7u;
#pragma unroll
    for (int rd = 0; rd < 2 * NT; ++rd) {
        if (rd + 1 < 2 * NT) { MGNT_ISSUE(rd + 1); asm volatile("s_waitcnt vmcnt(4)" ::: "memory"); } else asm volatile("s_waitcnt vmcnt(0)" ::: "memory");
        const LAS unsigned char* fb = reg + 8192 + (rd & 1) * 4096 + r * 128;
        bf16x8 bfr[4];
#pragma unroll
        for (int i = 0; i < 4; ++i) bfr[i] = *(const LAS bf16x8*)(fb + (((unsigned)(2 * i + h) ^ x8) * 16u));
#pragma unroll
        for (int i = 0; i < 4; ++i) acc[rd >> 1] = MFMA32(af[4 * (rd & 1) + i], bfr[i], acc[rd >> 1]);
        asm volatile("s_waitcnt lgkmcnt(0)" ::: "memory");
    }
#undef MGNT_ISSUE
    LAS float* part = (LAS float*)reg;
#pragma unroll
    for (int nt = 0; nt < NT; ++nt)
#pragma unroll
        for (int i = 0; i < 16; ++i) part[nt * 1024 + ((i & 3) + 8 * (i >> 2) + 4 * h) * 32 + r] = acc[nt][i];
    __syncthreads();
#pragma unroll
    for (int nt = 0; nt < NT; ++nt) { float s0 = 0.f, s1 = 0.f;
#pragma unroll
        for (int w = 0; w < 8; ++w) { const f32x2 p = *(const LAS f32x2*)((const LAS float*)(lds + w * 16384) + nt * 1024 + 2 * tid); s0 += p.x; s1 += p.y; }
        val[nt][0] = s0; val[nt][1] = s1; }
}
__device__ __forceinline__ void sample_gemm1_piece(const Args& a, LAS unsigned char* lds, int p, int wave, int lane, int tid_) {
    int tid = tid_; asm volatile("" : "+v"(tid));
    const int rg = p & 7, cp = p >> 3; int cb[2];
    if (cp < 16) { cb[0] = 64 * cp; cb[1] = 64 * cp + 32; } else { const int q = cp - 16; cb[0] = 1024 + 256 * (q >> 2) + 32 * (q & 3); cb[1] = cb[0] + 128; }
    float val[2][2];
    micro_gemm_lds_nt<2>(lds, (const bf16*)(a.ws + WS_XN) + (size_t)(MP + 32 * rg) * D, D, (const bf16*)(a.ws + WS_WIN), D, cb, wave, lane, tid, val);
    const int rs_ = 32 * rg + (tid >> 4), row = MP + rs_, t = rs_ & 15, sb = rs_ >> 4, c2 = 2 * (tid & 15);
    bf16* P1 = (bf16*)(a.ws + WS_P1) + (size_t)row * 1536;
    if (cp < 16) {
#pragma unroll
        for (int nt = 0; nt < 2; ++nt) { const int col = cb[nt] + c2; *(GAS unsigned*)(P1 + col) = pk2(val[nt][0], val[nt][1]);
            if (cp < 8 && t >= 1) *(GAS f32x2*)(a.out + OUT_POOL_S + (size_t)(sb * 15 + t - 1) * 512 + col) = (f32x2){val[nt][0], val[nt][1]}; }
    } else {
        const int ch = 32 * (cp - 16) + c2; const float v0 = val[0][0] * val[1][0], v1 = val[0][1] * val[1][1];
        *(GAS unsigned*)(P1 + 1024 + ch) = pk2(v0, v1);
        if (t >= 14) *(GAS f32x2*)(a.out + OUT_CONV_S + (size_t)(sb * 2 + t - 14) * 512 + ch) = (f32x2){v0, v1};
    }
    __syncthreads();
}
struct SampleX { unsigned* xbuf; unsigned* cnt; float* rsp; unsigned* tmo; };
template <int NT, int KCH, int MODE>
__device__ __forceinline__ void sample_gemm_piece(LAS unsigned char* lds, const bf16* A, int K, const bf16* Bt, bf16* C, int ldc, const float* rsp, int p, int wave, int lane, int tid_) {
    int tid = tid_; asm volatile("" : "+v"(tid));
    const int rg = p & 7, cp = p >> 3; int cb[NT];
#pragma unroll
    for (int nt = 0; nt < NT; ++nt) cb[nt] = 32 * NT * cp + 32 * nt;
    const int rl = 32 * rg + (tid >> 4); const size_t row = MP + rl; const int c2 = 2 * (tid & 15);
    f32x4 pr[8];
    if (rsp) { const GAS f32x4* pp = (const GAS f32x4*)(rsp + (size_t)rl * 32);
#pragma unroll
        for (int k = 0; k < 8; ++k) pr[k] = pp[k]; }
    float val[NT][2];
    if constexpr (NT == 1 && KCH == 8) micro_gemm_lds(lds, A + (size_t)(MP + 32 * rg) * K, K, Bt, K, cb[0], wave, lane, tid, val);
    else if constexpr (KCH == 8) micro_gemm_lds_nt<NT>(lds, A + (size_t)(MP + 32 * rg) * K, K, Bt, K, cb, wave, lane, tid, val);
    else micro_gemm<NT, KCH>(lds, A + (size_t)(MP + 32 * rg) * K, K, Bt, K, cb, wave, lane, tid, val);
    float rs = 1.f;
    if (rsp) { f32x4 t = pr[0];
#pragma unroll
        for (int k = 1; k < 8; ++k) t = t + pr[k];
        rs = 1.f / sqrtf(((t[0] + t[1]) + (t[2] + t[3])) * (1.f / D) + EPS); }
#pragma unroll
    for (int nt = 0; nt < NT; ++nt) {
        float v0 = val[nt][0] * rs, v1 = val[nt][1] * rs;
        if (MODE == 2) { v0 = fmaxf(v0, 0.f); v0 *= v0; v1 = fmaxf(v1, 0.f); v1 *= v1; }
        *(GAS unsigned*)(C + row * ldc + cb[nt] + c2) = pk2(v0, v1);
    }
    __syncthreads();
}
template <int KCH>
__device__ __forceinline__ void sample_fused_A(LAS unsigned char* lds, const bf16* A, int K, const bf16* Bt, const SampleX& sx, int p, int wave, int lane, int tid_) {
    int tid = tid_; asm volatile("" : "+v"(tid));
    const int rg = p & 7, cp = p >> 3; int cb[1] = {32 * cp};
    float val[1][2];
    if constexpr (KCH == 8) micro_gemm_lds(lds, A + (size_t)(MP + 32 * rg) * K, K, Bt, K, cb[0], wave, lane, tid, val);
    else if constexpr (KCH == 32) micro_gemm_lds_k4096(lds, A + (size_t)(MP + 32 * rg) * K, K, Bt, K, cb[0], wave, lane, tid, val);
    else micro_gemm<1, KCH>(lds, A + (size_t)(MP + 32 * rg) * K, K, Bt, K, cb, wave, lane, tid, val);
    const int rl = 32 * rg + (tid >> 4);
    float s = val[0][0] * val[0][0] + val[0][1] * val[0][1];
    s += __shfl_xor(s, 1); s += __shfl_xor(s, 2); s += __shfl_xor(s, 4); s += __shfl_xor(s, 8);
    if ((tid & 15) == 0) __hip_atomic_store(sx.xbuf + (size_t)rl * 32 + cp, __float_as_uint(s), __ATOMIC_RELAXED, __HIP_MEMORY_SCOPE_AGENT);
    *(LAS f32x2*)(lds + STASH_OFF + tid * 8) = (f32x2){val[0][0], val[0][1]};
    asm volatile("s_waitcnt vmcnt(0) lgkmcnt(0)" ::: "memory"); __syncthreads();
    if (tid == 0) __hip_atomic_fetch_add(sx.cnt + 64 * rg, 1u, __ATOMIC_RELAXED, __HIP_MEMORY_SCOPE_AGENT);
}
template <bool FINAL>
__device__ __forceinline__ void sample_fused_B(LAS unsigned char* lds, const float* base, const float* g, float* Y, bf16* X, const SampleX& sx, int p, int wave, int lane, int tid_) {
    int tid = tid_; asm volatile("" : "+v"(tid));
    const int rg = p & 7, cp = p >> 3;
    const int rl = 32 * rg + (tid >> 4); const int col = 32 * cp + 2 * (tid & 15);
    const f32x2 bs = *(const GAS f32x2*)(base + (size_t)rl * D + col), gv = *(const GAS f32x2*)(g + col);
    if (wave == 0) { unsigned sp = 0;
        while ((unsigned)__builtin_amdgcn_readfirstlane(__hip_atomic_load(sx.cnt + 64 * rg, __ATOMIC_RELAXED, __HIP_MEMORY_SCOPE_AGENT)) < 32u) {
            __builtin_amdgcn_s_sleep(2);
            if ((++sp & 1023u) == 0u) { if (__hip_atomic_load(sx.tmo, __ATOMIC_RELAXED, __HIP_MEMORY_SCOPE_AGENT) != 0u) break; if (sp > (1u << 22)) { if (lane == 0) __hip_atomic_store(sx.tmo, 1u, __ATOMIC_RELAXED, __HIP_MEMORY_SCOPE_AGENT); break; } } }
        }
    __syncthreads();
    float tot = 0.f;
    { const unsigned* slot = sx.xbuf + (size_t)rl * 32;
#pragma unroll
      for (int k = 0; k < 32; ++k) tot += __uint_as_float(__hip_atomic_load(slot + k, __ATOMIC_RELAXED, __HIP_MEMORY_SCOPE_AGENT)); }
    const f32x2 val = *(const LAS f32x2*)(lds + STASH_OFF + tid * 8);
    const float rs = 1.f / sqrtf(tot * (1.f / D) + EPS);
    const float x0 = bs[0] + val[0] * rs * gv[0], x1 = bs[1] + val[1] * rs * gv[1];
    *(GAS f32x2*)(Y + (size_t)rl * D + col) = (f32x2){x0, x1};
    if (!FINAL) {
        *(GAS unsigned*)(X + (size_t)rl * D + col) = pk2(x0, x1);
        float q = x0 * x0 + x1 * x1;
        q += __shfl_xor(q, 1); q += __shfl_xor(q, 2); q += __shfl_xor(q, 4); q += __shfl_xor(q, 8);
        if ((tid & 15) == 0) sx.rsp[(size_t)rl * 32 + cp] = q;
    }
    __syncthreads();
}
template <int KCH, bool FINAL>
__device__ __forceinline__ void sample_fused_piece(LAS unsigned char* lds, const bf16* A, int K, const bf16* Bt, const float* base, const float* g, float* Y, bf16* X, const SampleX& sx, int p, int wave, int lane, int tid) {
    sample_fused_A<KCH>(lds, A, K, Bt, sx, p, wave, lane, tid);
    sample_fused_B<FINAL>(lds, base, g, Y, X, sx, p, wave, lane, tid);
}

__global__ void __launch_bounds__(NWAVES * 64, 2) enc_fwd(Args args) {
    extern __shared__ __attribute__((aligned(16))) unsigned char lds_raw[];
    LAS unsigned char* lds = (LAS unsigned char*)lds_raw;
    volatile LAS unsigned* MISC = (volatile LAS unsigned*)(lds + MISC_OFF);
    const int tid = threadIdx.x, lane = tid & 63, wave = __builtin_amdgcn_readfirstlane(tid >> 6);
    const int G = gridDim.x; const int bx = blockIdx.x; const int vcu = (G % 8 == 0) ? (bx % 8) * (G / 8) + bx / 8 : bx;
    const int gw = vcu * NWAVES + wave, NGW = G * NWAVES;
    unsigned char* ws = args.ws;
    unsigned* ctl = (unsigned*)(ws + WS_CTL);
    for (int u = tid; u < (LDS_BYTES - LDSCTL_OFF) / 4; u += NWAVES * 64) ((LAS unsigned*)(lds + LDSCTL_OFF))[u] = 0u;
    __syncthreads();
    XcdBarrier bar = xcd_barrier_post(ctl + CW_BAR, MISC + 8);
#define GRID_BAR() do { xcd_arrive(bar); xcd_wait(bar); } while (0)
    if (tid == 0) { unsigned* gp = ctl + CW_BAR + XB_GRP(bx & 7); const unsigned me = bar.x + 1u;
        const unsigned prev = atomicCAS(gp, 0u, me);
        if (prev != 0u && prev != me) __hip_atomic_store(ctl + CW_BAR + XB_MIS, 1u, __ATOMIC_RELAXED, __HIP_MEMORY_SCOPE_AGENT); }
    bf16* XN = (bf16*)(ws + WS_XN);
    float* Y = args.out + OUT_Y;

    p0_prologue(args, lds, gw, NGW, wave, lane);
    GRID_BAR();

    const bool localok = G == 256 && __hip_atomic_load(ctl + CW_BAR + XB_MIS, __ATOMIC_RELAXED, __HIP_MEMORY_SCOPE_AGENT) == 0u;
#define LOCAL_BAR() do { if (localok) xcd_local_barrier(bar); else GRID_BAR(); } while (0)
    if (bx & 1) for (int p = bx; p < 256; p += G) sample_gemm1_piece(args, lds, p, wave, lane, tid);
    { pg8::Gemm g{XN, (const bf16*)(ws + WS_WIN), MP, NIN, D}; pg8::StaticOrder S; S.init(MP, NIN, G, bx);
      pg8::Epi1 E{(bf16*)(ws + WS_P1), args.out + OUT_POOL_P, args.out + OUT_CONV_P, args.out + OUT_POOL_S, args.out + OUT_CONV_S};
      pg8::gemm_phase<pg8::Epi1, pg8::StaticOrder, true, true>(lds, g, S, E); }
    if (!(bx & 1)) for (int p = bx; p < 256; p += G) sample_gemm1_piece(args, lds, p, wave, lane, tid);
    GRID_BAR();

    if (bx < 32 && G > 32) {
      pg8::Gemm g{(const bf16*)(ws + WS_MN), (const bf16*)(ws + WS_WKV), 1024, 2048, D}; pg8::StaticOrder S; S.init(1024, 2048, 32, bx);
      pg8::EpiKV E{args.out + OUT_MK, args.out + OUT_MV, (bf16*)(ws + WS_KB), (bf16*)(ws + WS_VT)};
      pg8::gemm_phase<pg8::EpiKV, pg8::StaticOrder, true, true>(lds, g, S, E);
    } else {
      const int gw2 = (bx - 32) * NWAVES + wave, NGW2 = (G - 32) * NWAVES;
      if (G == 256) mixer_all(args, lds, bx & 7, (bx - 32) >> 3, 28, wave, lane);
      else mixer_all(args, lds, -1, bx - 32, G - 32, wave, lane);
      if (G == 256) { const int lw = ((bx - 32) >> 3) * NWAVES + wave, xg = bx & 7, NV = (180 + 2 * 44) * 8;
          if (lw < 180) p2_late(args, lds, lw * 8 + xg, NV, wave, lane);
          else { p2_late(args, lds, (180 + 2 * (lw - 180)) * 8 + xg, NV, wave, lane); p2_late(args, lds, (181 + 2 * (lw - 180)) * 8 + xg, NV, wave, lane); } }
      else { __syncthreads(); p2_late(args, lds, gw2, NGW2, wave, lane); }
    }
    GRID_BAR();

    bf16* SQO = (bf16*)(ws + WS_SQO) - (size_t)MP * D; bf16* SAO = (bf16*)(ws + WS_SAO) - (size_t)MP * D; bf16* SHID = (bf16*)(ws + WS_SHID) - (size_t)MP * FF;
    unsigned* tmo = ctl + CW_TMO;
    float* Ys = Y + (size_t)MP * D; bf16* XNs = XN + (size_t)MP * D;
    const SampleX sx0{(unsigned*)(ws + WS_SXB), ctl + CW_SSEAM, (float*)(ws + WS_SRSP), tmo};
    const SampleX sx1{(unsigned*)(ws + WS_SXB + 32768), ctl + CW_SSEAM + 512, (float*)(ws + WS_SRSP + 32768), tmo};
    const SampleX sx2{(unsigned*)(ws + WS_SXB + 65536), ctl + CW_SSEAM + 1024, nullptr, tmo};

    { pg8::Gemm g{(const bf16*)(ws + WS_MRG), (const bf16*)(ws + WS_WOUT), MP, D, D}; pg8::StaticOrder S; S.init(MP, D, G, bx);
      pg8::EpiRes<1> E{(const float*)(ws + WS_RNORM), XN, nullptr, args.in[15], (unsigned*)(ws + WS_XB1), ctl + CW_SEAM, (float*)(ws + WS_RSP1), tmo};
      if (G == 256) sample_fused_A<8>(lds, (const bf16*)(ws + WS_MRG), D, (const bf16*)(ws + WS_WOUT), sx0, bx, wave, lane, tid);
      pg8::gemm_phase<pg8::EpiRes<1>, pg8::StaticOrder, false, true>(lds, g, S, E); }
    if (G == 256) sample_fused_B<false>(lds, args.in[1], args.in[15], Ys, XNs, sx0, bx, wave, lane, tid);
    else for (int p = bx; p < 256; p += G) sample_fused_piece<8, false>(lds, (const bf16*)(ws + WS_MRG), D, (const bf16*)(ws + WS_WOUT), args.in[1], args.in[15], Ys, XNs, sx0, p, wave, lane, tid);
    LOCAL_BAR();
    if (bx & 1) for (int p = bx; p < 256; p += G) sample_gemm_piece<1, 8, 1>(lds, XN, D, (const bf16*)(ws + WS_WQ), SQO, D, sx0.rsp, p, wave, lane, tid);
    { pg8::Gemm g{XN, (const bf16*)(ws + WS_WQ), MP, D, D}; pg8::StaticOrder S; S.init(MP, D, G, bx);
      pg8::EpiBf16S<0, false> E{(bf16*)(ws + WS_QO), D, (const float*)(ws + WS_RSP1), nullptr};
      pg8::gemm_phase<pg8::EpiBf16S<0, false>, pg8::StaticOrder, true, true>(lds, g, S, E); }
    if (!(bx & 1)) for (int p = bx; p < 256; p += G) sample_gemm_piece<1, 8, 1>(lds, XN, D, (const bf16*)(ws + WS_WQ), SQO, D, sx0.rsp, p, wave, lane, tid);
    LOCAL_BAR();
    { const bf16* QO = (const bf16*)(ws + WS_QO); bf16* AO = (bf16*)(ws + WS_AO);
      pg8::StaticOrder SA; SA.init(MP, D, G, bx); pg8::Unit au;
      for (int i = 0; SA.next(i, au); ++i) {
          const int hd = au.pn, b = au.pm >> 4; const size_t qb = (size_t)(au.pm * 256 + wave * 32) * D + hd * 256;
          int ln = lane; asm volatile("" : "+v"(ln));
          attn_unit(lds, QO + qb, AO + qb, (unsigned)(ln & 31) * 2048u, (const bf16*)(ws + WS_KB) + (size_t)b * 256 * 1024 + hd * 256, (const bf16*)(ws + WS_VT) + (size_t)(b * 4 + hd) * 65536, true, wave, ln);
      } }
    if (G == 256 && bx >= 64) { int ln = lane; asm volatile("" : "+v"(ln));
        p0_items(args, (LAS float*)(lds + wave * 16384), DN_LO, DN_HI, (bx - 64) * NWAVES + wave, 192 * NWAVES, ln); }
    else if (G != 256) { int ln = lane; asm volatile("" : "+v"(ln)); p0_items(args, (LAS float*)(lds + wave * 16384), DN_LO, DN_HI, gw, NGW, ln); }
    for (int u = bx; u < 64; u += G) {
        const int sb = 2 * (u & 7) + (u >> 5), hd = (u >> 3) & 3; const size_t qb = (size_t)(MP + sb * 16) * D + hd * 256;
        attn_unit_small(lds, SQO + qb, SAO + qb, (const bf16*)(ws + WS_KBS) + (size_t)sb * 256 * 1024 + hd * 256, (const bf16*)(ws + WS_VTS) + (size_t)(sb * 4 + hd) * 65536, wave, lane);
    }
    GRID_BAR();
    { pg8::Gemm g{(const bf16*)(ws + WS_AO), (const bf16*)(ws + WS_WCO), MP, D, D}; pg8::StaticOrder S; S.init(MP, D, G, bx);
      pg8::EpiRes<2> E{nullptr, XN, nullptr, args.in[22], (unsigned*)(ws + WS_XB2), ctl + CW_SEAM + 4096, (float*)(ws + WS_RSP2), tmo};
      if (G == 256) sample_fused_A<8>(lds, SAO, D, (const bf16*)(ws + WS_WCO), sx1, bx, wave, lane, tid);
      pg8::gemm_phase<pg8::EpiRes<2>, pg8::StaticOrder, false, true>(lds, g, S, E); }
    if (G == 256) sample_fused_B<false>(lds, Ys, args.in[22], Ys, XNs, sx1, bx, wave, lane, tid);
    else for (int p = bx; p < 256; p += G) sample_fused_piece<8, false>(lds, SAO, D, (const bf16*)(ws + WS_WCO), Ys, args.in[22], Ys, XNs, sx1, p, wave, lane, tid);
    LOCAL_BAR();
    if (bx & 1) for (int p = bx; p < 256; p += G) sample_gemm_piece<4, 8, 2>(lds, XN, D, (const bf16*)(ws + WS_WUP), SHID, FF, sx1.rsp, p, wave, lane, tid);
    { pg8::Gemm g{XN, (const bf16*)(ws + WS_WUP), MP, FF, D}; pg8::StaticOrder S; S.init(MP, FF, G, bx);
      LAS float* rstab = (LAS float*)(lds + RSTAB_OFF);
      { pg8::Unit u0; if (S.next(0, u0) && tid < 256) { const f32x4 p = *(const GAS f32x4*)((const float*)(ws + WS_RSP2) + (size_t)(u0.pm * 256 + tid) * 4);
            rstab[tid] = 1.0f / sqrtf(((p[0] + p[1]) + (p[2] + p[3])) * (1.0f / 1024.0f) + EPS); } }
      __syncthreads();
      pg8::EpiBf16S<1, true> E{(bf16*)(ws + WS_HID), FF, (const float*)(ws + WS_RSP2), rstab};
      pg8::gemm_phase<pg8::EpiBf16S<1, true>, pg8::StaticOrder, true, true>(lds, g, S, E); }
    if (!(bx & 1)) for (int p = bx; p < 256; p += G) sample_gemm_piece<4, 8, 2>(lds, XN, D, (const bf16*)(ws + WS_WUP), SHID, FF, sx1.rsp, p, wave, lane, tid);
    LOCAL_BAR();
    { pg8::Gemm g{(const bf16*)(ws + WS_HID), (const bf16*)(ws + WS_WDOWN), MP, D, FF}; pg8::StaticOrder S; S.init(MP, D, G, bx);
      pg8::EpiRes<3> E{nullptr, XN, Y, args.in[26], (unsigned*)(ws + WS_XB3), ctl + CW_SEAM + 8192, nullptr, tmo};
      if (G == 256 && (bx & 1)) sample_fused_A<32>(lds, SHID, FF, (const bf16*)(ws + WS_WDOWN), sx2, bx, wave, lane, tid);
      pg8::gemm_phase<pg8::EpiRes<3>, pg8::StaticOrder, false, true>(lds, g, S, E); }
    if (G == 256 && !(bx & 1)) { __syncthreads(); sample_fused_A<32>(lds, SHID, FF, (const bf16*)(ws + WS_WDOWN), sx2, bx, wave, lane, tid); }
    if (G == 256) sample_fused_B<true>(lds, Ys, args.in[26], Ys, nullptr, sx2, bx, wave, lane, tid);
    else for (int p = bx; p < 256; p += G) sample_fused_piece<32, true>(lds, SHID, FF, (const bf16*)(ws + WS_WDOWN), Ys, args.in[26], Ys, nullptr, sx2, p, wave, lane, tid);
}

extern "C" void kernel_launch(void* const* d_in, const int* in_sizes, int n_in, void* d_out, int out_size, void* d_ws, size_t ws_size, hipStream_t stream) {
    static int grid = 0;
    if (grid == 0) {
        if (n_in != 27 || (size_t)out_size != OUT_TOTAL || ws_size < WS_END) { fprintf(stderr, "kernel_launch: unexpected sizes n_in %d out %d ws %zu\n", n_in, out_size, ws_size); grid = -1; return; }
        int dev = 0, cus = 0, per_cu = 0;
        if (hipGetDevice(&dev) != hipSuccess || hipDeviceGetAttribute(&cus, hipDeviceAttributeMultiprocessorCount, dev) != hipSuccess) { grid = -1; return; }
        if (hipFuncSetAttribute((const void*)enc_fwd, hipFuncAttributeMaxDynamicSharedMemorySize, LDS_BYTES) != hipSuccess) { fprintf(stderr, "kernel_launch: hipFuncSetAttribute failed\n"); grid = -1; return; }
        if (hipOccupancyMaxActiveBlocksPerMultiprocessor(&per_cu, (const void*)enc_fwd, NWAVES * 64, LDS_BYTES) != hipSuccess || per_cu < 1) { fprintf(stderr, "kernel_launch: occupancy query says %d blocks/CU\n", per_cu); per_cu = 1; }
        (void)hipGetLastError();
        grid = cus;
    }
    if (grid < 0) return;
    (void)hipMemsetAsync((char*)d_ws + WS_CTL, 0, CTL_ZERO_BYTES, stream);
    Args a{};
    for (int i = 0; i < 27; ++i) a.in[i] = (const float*)d_in[i];
    a.out = (float*)d_out; a.ws = (unsigned char*)d_ws;
    hipLaunchKernelGGL(enc_fwd, dim3(grid), dim3(NWAVES * 64), LDS_BYTES, stream, a);
}
```

```cpp
#include <hip/hip_runtime.h>
#include <cstdio>
#include <cstdint>

namespace pg8 {
#define PG8_LAS __attribute__((address_space(3)))
typedef unsigned short bf16_t;
typedef short bf16x8 __attribute__((ext_vector_type(8)));
typedef float f32x4 __attribute__((ext_vector_type(4)));
typedef unsigned u32x4 __attribute__((ext_vector_type(4)));
typedef unsigned u32x2 __attribute__((ext_vector_type(2)));
constexpr int BM = 256, BK = 64, HALF = 128, HTB = HALF * BK * 2  , STAGE_BYTES = 8 * HTB, NXCD = 8, WGM = 8;

__host__ __device__ __forceinline__ int lds_byte(int r, int c) { const int st = (r >> 4) * 2 + (c >> 5), rr = r & 15, cc = c & 31, ob = rr * 64 + cc * 2; return st * 1024 + (ob ^ (((ob >> 9) & 1) << 5)); }
__host__ __device__ __forceinline__ void stage_rc(int b, int& R, int& C) { const int st = b / 1024, sb = b % 1024, swz = sb ^ (((sb >> 9) & 1) << 5); R = (st >> 1) * 16 + swz / 64; C = (st & 1) * 32 + (swz % 64) / 2; }
__host__ __device__ __forceinline__ int perm32(int rho) { const int n = rho >> 4, i = rho & 15; return 8 * (i >> 2) + 4 * n + (i & 3); }

struct Unit { int pm, pn; };
struct Gemm { const bf16_t* A; const bf16_t* Bt; int M, N, K; };

struct StaticOrder {
    int nM, nN, nwg, G, c;
    __host__ __device__ void init(int M, int N, int G_, int c_) { nM = M / BM; nN = N / BM; nwg = nM * nN; G = G_; c = c_; }
    __host__ __device__ __forceinline__ bool next(int i, Unit& u) const {
        const long L = (long)i * G + c; if (L >= nwg) return false;
        int wgid = (int)L; { const int q = nwg / NXCD, r = nwg % NXCD, xcd = wgid % NXCD, off = wgid / NXCD; wgid = (xcd < r ? xcd * (q + 1) : r * (q + 1) + (xcd - r) * q) + off; }
        const int nig = WGM * nN, gid = wgid / nig, fm = gid * WGM, gsz = (nM - fm) < WGM ? (nM - fm) : WGM;
        u.pm = fm + ((wgid % nig) % gsz); u.pn = (wgid % nig) / gsz; return true;
    }
    __device__ __forceinline__ void a_ready(const Unit&) const {}
    __device__ __forceinline__ void done(const Unit&) const {}
};

__device__ __forceinline__ unsigned cvt_pk_bf16(float lo, float hi) { unsigned r; asm volatile("v_cvt_pk_bf16_f32 %0, %1, %2" : "=v"(r) : "v"(lo), "v"(hi)); return r; }

struct EpiF32 {
    static constexpr bool PERM = false, AFTER_DRAIN = false;
    float* C; int ldc;
    __device__ __forceinline__ void operator()(const f32x4 (&acc)[2][2][4][2], const Unit& u, int wr, int wc, int fr, int fq) const {
        const int row0 = u.pm * BM + wr * 64 + fr, col0 = u.pn * BM + wc * 32 + 4 * fq;
#pragma unroll
        for (int ai = 0; ai < 2; ++ai)
#pragma unroll
            for (int m = 0; m < 4; ++m) { float* rowp = C + (size_t)(row0 + ai * HALF + m * 16) * ldc + col0;
#pragma unroll
                for (int bj = 0; bj < 2; ++bj)
#pragma unroll
                    for (int n = 0; n < 2; ++n) *(f32x4*)(rowp + bj * HALF + n * 16) = acc[ai][bj][m][n]; }
    }
};
template <int ACT> struct EpiBf16 {
    static constexpr bool PERM = true, AFTER_DRAIN = false;
    bf16_t* O; int ldc;
    __device__ __forceinline__ void operator()(const f32x4 (&acc)[2][2][4][2], const Unit& u, int wr, int wc, int fr, int fq) const {
        const int row0 = u.pm * BM + wr * 64 + fr, col0 = u.pn * BM + wc * 32 + 8 * fq;
#pragma unroll
        for (int ai = 0; ai < 2; ++ai)
#pragma unroll
            for (int m = 0; m < 4; ++m) { bf16_t* rowp = O + (size_t)(row0 + ai * HALF + m * 16) * ldc + col0;
#pragma unroll
                for (int bj = 0; bj < 2; ++bj) { f32x4 v0 = acc[ai][bj][m][0], v1 = acc[ai][bj][m][1];
                    if (ACT == 1) {
#pragma unroll
                        for (int j = 0; j < 4; ++j) { const float a = fmaxf(v0[j], 0.f), b = fmaxf(v1[j], 0.f); v0[j] = a * a; v1[j] = b * b; } }
                    u32x4 w; w.x = cvt_pk_bf16(v0[0], v0[1]); w.y = cvt_pk_bf16(v0[2], v0[3]); w.z = cvt_pk_bf16(v1[0], v1[1]); w.w = cvt_pk_bf16(v1[2], v1[3]);
                    *(u32x4*)(rowp + bj * HALF) = w; } }
    }
};
struct Epi1 {
    static constexpr bool PERM = true, AFTER_DRAIN = false;
    bf16_t* P1; float* pool_p; float* conv_p; float* pool_s; float* conv_s;
    __device__ __forceinline__ void operator()(const f32x4 (&acc)[2][2][4][2], const Unit& u, int wr, int wc, int fr, int fq) const {
        const int row0 = u.pm * BM + wr * 64 + fr;
        const bool sample = (u.pm == 64), tailp = ((u.pm & 15) == 15) && !sample;
        if (u.pn < 4) {
            const int col0 = u.pn * BM + wc * 32 + 8 * fq;
#pragma unroll
            for (int ai = 0; ai < 2; ++ai)
#pragma unroll
                for (int m = 0; m < 4; ++m) { const int row = row0 + ai * HALF + m * 16; bf16_t* rowp = P1 + (size_t)row * 1536 + col0;
#pragma unroll
                    for (int bj = 0; bj < 2; ++bj) { const f32x4 v0 = acc[ai][bj][m][0], v1 = acc[ai][bj][m][1];
                        u32x4 w; w.x = cvt_pk_bf16(v0[0], v0[1]); w.y = cvt_pk_bf16(v0[2], v0[3]); w.z = cvt_pk_bf16(v1[0], v1[1]); w.w = cvt_pk_bf16(v1[2], v1[3]);
                        *(u32x4*)(rowp + bj * HALF) = w;
                        if (u.pn < 2) {
                            float* dst = nullptr;
                            if (sample) { const int t = row & 15, sb = (row >> 4) & 15; if (t >= 1) dst = pool_s + ((size_t)(sb * 15 + t - 1) * 512 + col0 + bj * HALF); }
                            else if (tailp) { const int t = row & 4095, b = row >> 12; if (t >= 4081) dst = pool_p + ((size_t)(b * 15 + t - 4081) * 512 + col0 + bj * HALF); }
                            if (dst) { *(f32x4*)dst = v0; *(f32x4*)(dst + 4) = v1; }
                        } } }
        } else {
            const int ch0 = (u.pn - 4) * 128 + wc * 32 + 8 * fq;
#pragma unroll
            for (int ai = 0; ai < 2; ++ai)
#pragma unroll
                for (int m = 0; m < 4; ++m) { const int row = row0 + ai * HALF + m * 16;
                    const f32x4 v0 = acc[ai][0][m][0] * acc[ai][1][m][0], v1 = acc[ai][0][m][1] * acc[ai][1][m][1];
                    u32x4 w; w.x = cvt_pk_bf16(v0[0], v0[1]); w.y = cvt_pk_bf16(v0[2], v0[3]); w.z = cvt_pk_bf16(v1[0], v1[1]); w.w = cvt_pk_bf16(v1[2], v1[3]);
                    *(u32x4*)(P1 + (size_t)row * 1536 + 1024 + ch0) = w;
                    float* dst = nullptr;
                    if (sample) { const int t = row & 15, sb = (row >> 4) & 15; if (t >= 14) dst = conv_s + ((size_t)(sb * 2 + t - 14) * 512 + ch0); }
                    else if (tailp) { const int t = row & 4095, b = row >> 12; if (t >= 4094) dst = conv_p + ((size_t)(b * 2 + t - 4094) * 512 + ch0); }
                    if (dst) { *(f32x4*)dst = v0; *(f32x4*)(dst + 4) = v1; } }
        }
    }
};
struct EpiKV {
    static constexpr bool PERM = false, AFTER_DRAIN = false;
    float* outK; float* outV; bf16_t* KB; bf16_t* VT;
    __device__ __forceinline__ void operator()(const f32x4 (&acc)[2][2][4][2], const Unit& u, int wr, int wc, int fr, int fq) const {
        const int row0 = u.pm * BM + wr * 64 + fr;
        if (u.pn < 4) {
            const int col0 = u.pn * BM + wc * 32 + 4 * fq;
#pragma unroll
            for (int ai = 0; ai < 2; ++ai)
#pragma unroll
                for (int m = 0; m < 4; ++m) { const size_t off = (size_t)(row0 + ai * HALF + m * 16) * 1024 + col0;
#pragma unroll
                    for (int bj = 0; bj < 2; ++bj)
#pragma unroll
                        for (int n = 0; n < 2; ++n) { const f32x4 v = acc[ai][bj][m][n]; __builtin_nontemporal_store(v, (f32x4*)(outK + off + bj * HALF + n * 16));
                            u32x2 w; w.x = cvt_pk_bf16(v[0], v[1]); w.y = cvt_pk_bf16(v[2], v[3]); *(u32x2*)(KB + off + bj * HALF + n * 16) = w; } }
        } else {
            const int h = u.pn - 4, e0 = wc * 32 + 4 * fq;
            bf16_t* vt = VT + (size_t)(u.pm * 4 + h) * 65536;
#pragma unroll
            for (int ai = 0; ai < 2; ++ai)
#pragma unroll
                for (int m = 0; m < 4; ++m) { const int mrow = wr * 64 + fr + ai * HALF + m * 16;
                    const int pos = (mrow & ~12) | ((mrow & 4) << 1) | ((mrow & 8) >> 1);
                    const size_t off = (size_t)(u.pm * BM + mrow) * 1024 + h * 256 + e0;
#pragma unroll
                    for (int bj = 0; bj < 2; ++bj)
#pragma unroll
                        for (int n = 0; n < 2; ++n) { const f32x4 v = acc[ai][bj][m][n]; __builtin_nontemporal_store(v, (f32x4*)(outV + off + bj * HALF + n * 16));
                            const unsigned w0 = cvt_pk_bf16(v[0], v[1]), w1 = cvt_pk_bf16(v[2], v[3]); const int e = e0 + bj * HALF + n * 16;
                            vt[(size_t)(e + 0) * 256 + pos] = (bf16_t)(w0 & 0xffffu); vt[(size_t)(e + 1) * 256 + pos] = (bf16_t)(w0 >> 16);
                            vt[(size_t)(e + 2) * 256 + pos] = (bf16_t)(w1 & 0xffffu); vt[(size_t)(e + 3) * 256 + pos] = (bf16_t)(w1 >> 16); } }
        }
    }
};


template <int ACT, bool TAB> struct EpiBf16S {
    static constexpr bool PERM = true, AFTER_DRAIN = false;
    bf16_t* O; int ldc; const float* rsp; const PG8_LAS float* rstab;
    __device__ __forceinline__ void operator()(const f32x4 (&acc)[2][2][4][2], const Unit& u, int wr, int wc, int fr, int fq) const {
        const int row0 = u.pm * BM + wr * 64 + fr, col0 = u.pn * BM + wc * 32 + 8 * fq;
#pragma unroll
        for (int ai = 0; ai < 2; ++ai)
#pragma unroll
            for (int m = 0; m < 4; ++m) { const int row = row0 + ai * HALF + m * 16; bf16_t* rowp = O + (size_t)row * ldc + col0;
                float rs;
                if (TAB) rs = rstab[wr * 64 + fr + ai * HALF + m * 16];
                else { const f32x4 p = *(const f32x4*)(rsp + (size_t)row * 4); rs = 1.0f / sqrtf(((p[0] + p[1]) + (p[2] + p[3])) * (1.0f / 1024.0f) + 1e-6f); }
#pragma unroll
                for (int bj = 0; bj < 2; ++bj) { f32x4 v0 = acc[ai][bj][m][0] * rs, v1 = acc[ai][bj][m][1] * rs;
                    if (ACT == 1) {
#pragma unroll
                        for (int j = 0; j < 4; ++j) { const float a = fmaxf(v0[j], 0.f), b = fmaxf(v1[j], 0.f); v0[j] = a * a; v1[j] = b * b; } }
                    u32x4 w; w.x = cvt_pk_bf16(v0[0], v0[1]); w.y = cvt_pk_bf16(v0[2], v0[3]); w.z = cvt_pk_bf16(v1[0], v1[1]); w.w = cvt_pk_bf16(v1[2], v1[3]);
                    *(u32x4*)(rowp + bj * HALF) = w; } }
    }
};

template <int MODE> struct EpiRes {
    static constexpr bool PERM = true, AFTER_DRAIN = true;
    const float* basef; bf16_t* X; float* outf; const float* g; unsigned* xbuf; unsigned* cnt; float* rsp; unsigned* tmo;
    __device__ __forceinline__ void fused(f32x4 (&acc)[2][2][4][2], const Unit& u, int wr, int wc, int fr, int fq, PG8_LAS unsigned char* lds, int wid, int lane) const {
        PG8_LAS float* P = (PG8_LAS float*)lds;
        PG8_LAS float* S = (PG8_LAS float*)(lds + 4096);
        PG8_LAS float* R = (PG8_LAS float*)(lds + 5120);
        const int col0 = u.pn * BM + wc * 32 + 8 * fq;
        u32x4 pre[4][2][1];
#pragma unroll
        for (int m = 0; m < 4; ++m) { const size_t off = (size_t)(u.pm * BM + wr * 64 + m * 16 + fr) * 1024 + col0;
#pragma unroll
            for (int bj = 0; bj < 2; ++bj) {
                pre[m][bj][0] = *(const u32x4*)(X + off + bj * HALF); } }
#pragma unroll
        for (int ai = 0; ai < 2; ++ai)
#pragma unroll
            for (int m = 0; m < 4; ++m) { float s = 0.f;
#pragma unroll
                for (int bj = 0; bj < 2; ++bj)
#pragma unroll
                    for (int n = 0; n < 2; ++n) { const f32x4 x = acc[ai][bj][m][n]; s += (x[0] * x[0] + x[1] * x[1]) + (x[2] * x[2] + x[3] * x[3]); }
                s += __shfl_xor(s, 16); s += __shfl_xor(s, 32);
                if (fq == 0) P[(ai * HALF + wr * 64 + m * 16 + fr) * 4 + wc] = s; }
        asm volatile("s_waitcnt lgkmcnt(0)" ::: "memory"); __builtin_amdgcn_s_barrier(); asm volatile("" ::: "memory");
        const int row = wid * 32 + (lane & 31);
        if (lane < 32) { const f32x4 p = *(const PG8_LAS f32x4*)(P + row * 4); const float t = (p[0] + p[1]) + (p[2] + p[3]);
            __hip_atomic_store(xbuf + (size_t)(u.pm * BM + row) * 4 + u.pn, __float_as_uint(t), __ATOMIC_RELAXED, __HIP_MEMORY_SCOPE_AGENT); }
        asm volatile("s_waitcnt vmcnt(0)" ::: "memory");
        if (lane == 0) __hip_atomic_fetch_add(cnt + 64 * u.pm, 1u, __ATOMIC_RELAXED, __HIP_MEMORY_SCOPE_AGENT);
        if (wid == 0) { unsigned sp = 0;
            while ((unsigned)__builtin_amdgcn_readfirstlane(__hip_atomic_load(cnt + 64 * u.pm, __ATOMIC_RELAXED, __HIP_MEMORY_SCOPE_AGENT)) < 32u) {
                __builtin_amdgcn_s_sleep(2);
                if ((++sp & 1023u) == 0u) { if (__hip_atomic_load(tmo, __ATOMIC_RELAXED, __HIP_MEMORY_SCOPE_AGENT) != 0u) break; if (sp > (1u << 22)) { if (lane == 0) __hip_atomic_store(tmo, 1u, __ATOMIC_RELAXED, __HIP_MEMORY_SCOPE_AGENT); break; } } }
            }
        asm volatile("s_waitcnt vmcnt(0) lgkmcnt(0)" ::: "memory"); __builtin_amdgcn_s_barrier(); asm volatile("" ::: "memory");
        if (lane < 32) { const unsigned* slot = xbuf + (size_t)(u.pm * BM + row) * 4; float t = 0.f;
#pragma unroll
            for (int k = 0; k < 4; ++k) t += __uint_as_float(__hip_atomic_load(slot + k, __ATOMIC_RELAXED, __HIP_MEMORY_SCOPE_AGENT));
            S[row] = 1.0f / sqrtf(t * (1.0f / 1024.0f) + 1e-6f);
            if (MODE == 1) R[row] = basef[u.pm * BM + row]; }
        asm volatile("s_waitcnt lgkmcnt(0)" ::: "memory"); __builtin_amdgcn_s_barrier(); asm volatile("" ::: "memory");
        f32x4 gv[2][2];
#pragma unroll
        for (int bj = 0; bj < 2; ++bj)
#pragma unroll
            for (int n = 0; n < 2; ++n) gv[bj][n] = *(const f32x4*)(g + col0 + bj * HALF + 4 * n);
#pragma unroll
        for (int ai = 0; ai < 2; ++ai)
#pragma unroll
            for (int m = 0; m < 4; ++m) { const int r = ai * HALF + wr * 64 + m * 16 + fr; const float sr = S[r], rn = MODE == 1 ? R[r] : 1.f; const size_t off = (size_t)(u.pm * BM + r) * 1024 + col0; float q = 0.f;
#pragma unroll
                for (int bj = 0; bj < 2; ++bj) { f32x4 b0, b1;
                    { const u32x4 w = ai == 0 ? pre[m][bj][0] : *(const u32x4*)(X + off + bj * HALF);
                        b0 = (f32x4){__uint_as_float(w.x << 16), __uint_as_float(w.x & 0xffff0000u), __uint_as_float(w.y << 16), __uint_as_float(w.y & 0xffff0000u)};
                        b1 = (f32x4){__uint_as_float(w.z << 16), __uint_as_float(w.z & 0xffff0000u), __uint_as_float(w.w << 16), __uint_as_float(w.w & 0xffff0000u)};
                        if (MODE == 1) { b0 = b0 * rn; b1 = b1 * rn; } }
                    const f32x4 v0 = b0 + acc[ai][bj][m][0] * sr * gv[bj][0], v1 = b1 + acc[ai][bj][m][1] * sr * gv[bj][1];
                    if (MODE == 3) { __builtin_nontemporal_store(v0, (f32x4*)(outf + off + bj * HALF)); __builtin_nontemporal_store(v1, (f32x4*)(outf + off + bj * HALF + 4)); }
                    else { q += ((v0[0] * v0[0] + v0[1] * v0[1]) + (v0[2] * v0[2] + v0[3] * v0[3])) + ((v1[0] * v1[0] + v1[1] * v1[1]) + (v1[2] * v1[2] + v1[3] * v1[3]));
                        u32x4 w; w.x = cvt_pk_bf16(v0[0], v0[1]); w.y = cvt_pk_bf16(v0[2], v0[3]); w.z = cvt_pk_bf16(v1[0], v1[1]); w.w = cvt_pk_bf16(v1[2], v1[3]);
                        *(u32x4*)(X + off + bj * HALF) = w; } }
                if (MODE != 3) { q += __shfl_xor(q, 16); q += __shfl_xor(q, 32); if (fq == 0) P[r * 4 + wc] = q; }
                if (m & 1) asm volatile("" ::: "memory"); }
        if (MODE != 3) {
            asm volatile("s_waitcnt lgkmcnt(0)" ::: "memory"); __builtin_amdgcn_s_barrier(); asm volatile("" ::: "memory");
            if (lane < 32) { const f32x4 p = *(const PG8_LAS f32x4*)(P + row * 4); rsp[(size_t)(u.pm * BM + row) * 4 + u.pn] = (p[0] + p[1]) + (p[2] + p[3]); }
        }
    }
};

template <class Epi, class Sched, bool ALIGN_EPI = false, bool SP2 = false>
__device__ __forceinline__ void gemm_phase(PG8_LAS unsigned char* lds, const Gemm g, const Sched& S, const Epi& E) {
    int tid_ = threadIdx.x; asm volatile("" : "+v"(tid_));
    const int tid = tid_, wid = __builtin_amdgcn_readfirstlane(tid >> 6), lane = tid & 63, wr = wid >> 2, wc = wid & 3, fr = lane & 15, fq = lane >> 4;
    const int K = g.K, nt = K / BK;
    unsigned voffA[2], voffB[2];
#pragma unroll
    for (int i = 0; i < 2; ++i) { int R, C; stage_rc(tid * 16 + i * 8192, R, C); const int Rb = Epi::PERM ? ((R & ~31) + perm32(R & 31)) : R;
        voffA[i] = (unsigned)(R * K + C) * 2u; voffB[i] = (unsigned)(Rb * K + C) * 2u; }
    const size_t kstep = (size_t)(BK * 2);
    const size_t hstep = (size_t)HALF * K * 2;
    const size_t tstep = 2 * hstep;
    const unsigned ldsw = (unsigned)wid * 1024u;
    const int aoff = lds_byte(wr * 64 + fr, fq * 8), boff = lds_byte(wc * 32 + fr, fq * 8);
#define PG8_SA(b, h) (((b) * 2 + (h)) * HTB)
#define PG8_SB(b, h) ((4 + (b) * 2 + (h)) * HTB)
#define PG8_STAGE(bufoff, gbase, voff) do { _Pragma("unroll") for (int _i = 0; _i < 2; ++_i) \
        __builtin_amdgcn_global_load_lds((const unsigned*)((const char*)(gbase) + (voff)[_i]), (PG8_LAS unsigned*)(lds + (bufoff) + ldsw + _i * 8192), 16, 0, 0); } while (0)
#define PG8_LDA(dst, b, h) do { _Pragma("unroll") for (int m = 0; m < 4; ++m) _Pragma("unroll") for (int k = 0; k < 2; ++k) dst[m][k] = *(const PG8_LAS bf16x8*)(lds + PG8_SA(b, h) + aoff + m * 2048 + k * 1024); } while (0)
#define PG8_LDB(dst, b, h) do { _Pragma("unroll") for (int n = 0; n < 2; ++n) _Pragma("unroll") for (int k = 0; k < 2; ++k) dst[n][k] = *(const PG8_LAS bf16x8*)(lds + PG8_SB(b, h) + boff + n * 2048 + k * 1024); } while (0)
#define PG8_MMA(ai, bj, At, Bt) do { __builtin_amdgcn_s_setprio(1); _Pragma("unroll") for (int m = 0; m < 4; ++m) _Pragma("unroll") for (int n = 0; n < 2; ++n) _Pragma("unroll") for (int k = 0; k < 2; ++k) \
        acc[ai][bj][m][n] = __builtin_amdgcn_mfma_f32_16x16x32_bf16(Bt[n][k], At[m][k], acc[ai][bj][m][n], 0, 0, 0); __builtin_amdgcn_s_setprio(0); } while (0)
#define PG8_WAIT_V(n) asm volatile("s_waitcnt vmcnt(" #n ")" ::: "memory")
#define PG8_WAIT_L(n) asm volatile("s_waitcnt lgkmcnt(" #n ")" ::: "memory")
#define PG8_BAR __builtin_amdgcn_s_barrier()
#define PG8_SCHED __builtin_amdgcn_sched_barrier(0)
    Unit cur, nxt; int ui = 0;
    if (!S.next(0, cur)) return;
    f32x4 acc[2][2][4][2];
#pragma unroll
    for (int a = 0; a < 2; ++a)
#pragma unroll
        for (int b = 0; b < 2; ++b)
#pragma unroll
            for (int m = 0; m < 4; ++m)
#pragma unroll
                for (int n = 0; n < 2; ++n) acc[a][b][m][n] = (f32x4){0.f, 0.f, 0.f, 0.f};
    bf16x8 At[4][2], B0[2][2], B1[2][2];
    const char* cA = (const char*)g.A + (size_t)cur.pm * tstep; const char* cB = (const char*)g.Bt + (size_t)cur.pn * tstep;
    S.a_ready(cur);
    if constexpr (SP2) {
        PG8_STAGE(PG8_SB(0, 0), cB, voffB); PG8_STAGE(PG8_SB(0, 1), cB + hstep, voffB); PG8_STAGE(PG8_SA(0, 0), cA, voffA); PG8_STAGE(PG8_SA(0, 1), cA + hstep, voffA);
        if (wr == 1) PG8_BAR;
        PG8_WAIT_V(2); PG8_BAR;
        PG8_STAGE(PG8_SB(1, 0), cB + kstep, voffB); PG8_STAGE(PG8_SA(1, 0), cA + kstep, voffA); PG8_STAGE(PG8_SB(1, 1), cB + hstep + kstep, voffB);
        PG8_WAIT_V(6); PG8_BAR;
    } else {
        PG8_STAGE(PG8_SB(0, 0), cB, voffB); PG8_STAGE(PG8_SA(0, 0), cA, voffA); PG8_STAGE(PG8_SB(0, 1), cB + hstep, voffB); PG8_STAGE(PG8_SA(0, 1), cA + hstep, voffA);
        if (wr == 1) PG8_BAR;
        PG8_WAIT_V(4); PG8_BAR;
        PG8_STAGE(PG8_SB(1, 0), cB + kstep, voffB); PG8_STAGE(PG8_SA(1, 0), cA + kstep, voffA); PG8_STAGE(PG8_SB(1, 1), cB + hstep + kstep, voffB);
        PG8_WAIT_V(6); PG8_BAR;
    }
    for (;;) {
        const bool has_next = S.next(ui + 1, nxt);
        const char* nA = has_next ? (const char*)g.A + (size_t)nxt.pm * tstep : cA; const char* nB = has_next ? (const char*)g.Bt + (size_t)nxt.pn * tstep : cB;
        for (int t = 0; t < nt; t += 2) {
            const bool last = (t == nt - 2);
            const char* a1 = cA + (size_t)(t + 1) * kstep;
            const char* a2 = last ? nA : cA + (size_t)(t + 2) * kstep; const char* b2 = last ? nB : cB + (size_t)(t + 2) * kstep;
            const char* a3 = a2 + kstep; const char* b3 = b2 + kstep;
            if (last && has_next) S.a_ready(nxt);
            if constexpr (SP2) {
            PG8_LDB(B0, 0, 0); PG8_LDB(B1, 0, 1); PG8_SCHED; PG8_LDA(At, 0, 0); PG8_STAGE(PG8_SA(1, 1), a1 + hstep, voffA);
            PG8_WAIT_V(8); PG8_WAIT_L(0); PG8_BAR; PG8_MMA(0, 0, At, B0); PG8_MMA(0, 1, At, B1); PG8_BAR; PG8_SCHED;
            PG8_LDA(At, 0, 1); PG8_STAGE(PG8_SB(0, 0), b2, voffB); PG8_STAGE(PG8_SB(0, 1), b2 + hstep, voffB); PG8_STAGE(PG8_SA(0, 0), a2, voffA);
            PG8_WAIT_V(8); PG8_WAIT_L(0); PG8_BAR; PG8_MMA(1, 0, At, B0); PG8_MMA(1, 1, At, B1); PG8_BAR; PG8_SCHED;
            PG8_LDB(B0, 1, 0); PG8_LDB(B1, 1, 1); PG8_SCHED; PG8_LDA(At, 1, 0); PG8_STAGE(PG8_SA(0, 1), a2 + hstep, voffA);
            PG8_WAIT_V(8); PG8_WAIT_L(0); PG8_BAR; PG8_MMA(0, 0, At, B0); PG8_MMA(0, 1, At, B1); PG8_BAR; PG8_SCHED;
            PG8_LDA(At, 1, 1); PG8_STAGE(PG8_SB(1, 0), b3, voffB); PG8_STAGE(PG8_SB(1, 1), b3 + hstep, voffB); PG8_STAGE(PG8_SA(1, 0), a3, voffA);
            PG8_WAIT_V(8); PG8_WAIT_L(0); PG8_BAR; PG8_MMA(1, 0, At, B0); PG8_MMA(1, 1, At, B1); PG8_BAR; PG8_SCHED;
            } else {
            PG8_LDB(B0, 0, 0); PG8_SCHED; PG8_LDA(At, 0, 0); PG8_STAGE(PG8_SA(1, 1), a1 + hstep, voffA);
            PG8_WAIT_L(8); PG8_BAR; PG8_WAIT_L(0); PG8_MMA(0, 0, At, B0); PG8_BAR; PG8_SCHED;
            PG8_LDB(B1, 0, 1); PG8_STAGE(PG8_SB(0, 0), b2, voffB);
            PG8_BAR; PG8_WAIT_L(0); PG8_MMA(0, 1, At, B1); PG8_BAR;
            PG8_LDA(At, 0, 1); PG8_STAGE(PG8_SA(0, 0), a2, voffA);
            PG8_BAR; PG8_WAIT_L(0); PG8_MMA(1, 0, At, B0); PG8_BAR; PG8_SCHED;
            PG8_STAGE(PG8_SB(0, 1), b2 + hstep, voffB);
            PG8_WAIT_V(6); PG8_BAR; PG8_MMA(1, 1, At, B1); PG8_BAR;
            PG8_LDB(B0, 1, 0); PG8_SCHED; PG8_LDA(At, 1, 0); PG8_STAGE(PG8_SA(0, 1), a2 + hstep, voffA);
            PG8_WAIT_L(8); PG8_BAR; PG8_WAIT_L(0); PG8_MMA(0, 0, At, B0); PG8_BAR; PG8_SCHED;
            PG8_LDB(B1, 1, 1); PG8_STAGE(PG8_SB(1, 0), b3, voffB);
            PG8_BAR; PG8_WAIT_L(0); PG8_MMA(0, 1, At, B1); PG8_BAR;
            PG8_LDA(At, 1, 1); PG8_STAGE(PG8_SA(1, 0), a3, voffA);
            PG8_BAR; PG8_WAIT_L(0); PG8_MMA(1, 0, At, B0); PG8_BAR; PG8_SCHED;
            PG8_STAGE(PG8_SB(1, 1), b3 + hstep, voffB);
            PG8_WAIT_V(6); PG8_BAR; PG8_MMA(1, 1, At, B1); PG8_BAR;
            }
        }
        if constexpr (ALIGN_EPI) { if (wr == 0) PG8_BAR; }
        if constexpr (!Epi::AFTER_DRAIN) { E(acc, cur, wr, wc, fr, fq); S.done(cur); }
        if (!has_next) break;
#pragma unroll
        for (int a = 0; a < 2; ++a)
#pragma unroll
            for (int b = 0; b < 2; ++b)
#pragma unroll
                for (int m = 0; m < 4; ++m)
#pragma unroll
                    for (int n = 0; n < 2; ++n) acc[a][b][m][n] = (f32x4){0.f, 0.f, 0.f, 0.f};
        cur = nxt; cA = nA; cB = nB; ++ui;
        if constexpr (ALIGN_EPI) { if (wr == 1) PG8_BAR; }
    }
    PG8_WAIT_V(0);
    if constexpr (!ALIGN_EPI) { if (wr == 0) PG8_BAR; }
    PG8_BAR;
    if constexpr (Epi::AFTER_DRAIN) { E.fused(acc, cur, wr, wc, fr, fq, lds, wid, lane); S.done(cur); }
#undef PG8_SA
#undef PG8_SB
#undef PG8_STAGE
#undef PG8_LDA
#undef PG8_LDB
#undef PG8_MMA
#undef PG8_WAIT_V
#undef PG8_WAIT_L
#undef PG8_BAR
#undef PG8_SCHED
}
}
constexpr int NWAVES = 8;
constexpr int D = 1024, MP = 16384, MS = 256, M = MP + MS, NIN = 2048, FF = 4096;
constexpr float EPS = 1e-6f;
constexpr size_t OUT_Y = 0, OUT_POOL_P = 17039360, OUT_CONV_P = 17070080, OUT_MK = 17074176, OUT_MV = 18122752, OUT_POOL_S = 19171328, OUT_CONV_S = 19294208, OUT_TOTAL = 19310592;
constexpr size_t MiB = 1u << 20;
constexpr size_t WS_CTL = 0, CTL_ZERO_BYTES = 128 * 1024;
constexpr size_t WS_WDOWN = 1 * MiB, WS_WUP = 9 * MiB, WS_WIN = 17 * MiB, WS_WKV = 21 * MiB, WS_WOUT = 25 * MiB, WS_WQ = 27 * MiB, WS_WCO = 29 * MiB, WS_WP = 31 * MiB;
constexpr size_t WS_HISTU = 31 * MiB + 512 * 1024, WS_HISTV = WS_HISTU + 16 * 15 * 512 * 2, WS_ZERO = 32 * 1024;
constexpr size_t WS_MN = 32 * MiB, WS_KB = 34 * MiB, WS_VT = 36 * MiB, WS_KBS = 38 * MiB, WS_VTS = 46 * MiB;
constexpr size_t WS_XN = 54 * MiB;
constexpr size_t WS_MRG = 87 * MiB;
constexpr size_t WS_AO = 87 * MiB;
constexpr size_t WS_P1 = 120 * MiB;
constexpr size_t WS_QO = 120 * MiB;
constexpr size_t WS_HID = 120 * MiB;
constexpr size_t WS_XB1 = 248 * MiB, WS_XB2 = WS_XB1 + 256 * 1024, WS_XB3 = WS_XB2 + 256 * 1024, WS_RSP1 = WS_XB3 + 256 * 1024, WS_RSP2 = WS_RSP1 + 256 * 1024;
constexpr size_t WS_SXB = 249 * MiB + 512 * 1024, WS_SRSP = WS_SXB + 3 * 32768;
constexpr size_t WS_RNORM = 249 * MiB + 768 * 1024;
constexpr size_t WS_SQO = 250 * MiB, WS_SAO = WS_SQO + 512 * 1024, WS_SRAW = 251 * MiB, WS_SHID = 252 * MiB;
constexpr size_t WS_END = 256 * MiB;
constexpr int CW_TMO = 0, CW_SEAM = 16384, CW_SSEAM = 16384 + 3 * 4096;
static_assert(WS_MRG + (size_t)M * D * 2 <= WS_P1 && WS_HID + (size_t)MP * FF * 2 <= WS_XB1 && WS_SHID + (size_t)MS * FF * 2 <= WS_END, "ws map");
constexpr int CW_BAR = 4096;

constexpr int RING_BYTES = 131072, LDSCTL_OFF = RING_BYTES, MISC_OFF = LDSCTL_OFF + 320, RSTAB_OFF = RING_BYTES + 1024, GGTAB_OFF = RING_BYTES + 2048, STASH_OFF = RING_BYTES + 4096, LDS_BYTES = 147456;

#define GAS __attribute__((address_space(1)))
#define LAS __attribute__((address_space(3)))
typedef unsigned short bf16;
typedef unsigned v4u __attribute__((ext_vector_type(4)));
typedef unsigned v2u __attribute__((ext_vector_type(2)));
typedef float f32x4 __attribute__((ext_vector_type(4)));
typedef float f32x16 __attribute__((ext_vector_type(16)));
typedef float f32x2 __attribute__((ext_vector_type(2)));
typedef short bf16x8 __attribute__((ext_vector_type(8)));
#define LDS_WAIT() asm volatile("s_waitcnt lgkmcnt(0)" ::: "memory")
#define VM_WAIT() asm volatile("s_waitcnt vmcnt(0)" ::: "memory")
__device__ __forceinline__ unsigned f2bf(float f) { unsigned u = __builtin_bit_cast(unsigned, f); return (u + 0x7fffu + ((u >> 16) & 1u)) >> 16; }
__device__ __forceinline__ unsigned pk2(float lo, float hi) { return pg8::cvt_pk_bf16(lo, hi); }
typedef __bf16 bf16n2 __attribute__((ext_vector_type(2)));
__device__ __forceinline__ unsigned pk2c(float lo, float hi) { const bf16n2 v = __builtin_convertvector((f32x2){lo, hi}, bf16n2); return __builtin_bit_cast(unsigned, v); }
__device__ __forceinline__ float bflo(unsigned w) { return __builtin_bit_cast(float, w << 16); }
__device__ __forceinline__ float bfhi(unsigned w) { return __builtin_bit_cast(float, w & 0xffff0000u); }

#define XB_TMO      128
#define XB_XCNT(j)  (256  + 64 * (j))
#define XB_XSUB(j)  (1280 + 64 * (j))
#define XB_XGEN(j)  (2304 + 64 * (j))
#define XB_TOP      3328
#define XB_TOPGEN   3392
#define XCD_BAR_WORDS 3456
#define XB_SPIN_CAP (1u << 22)
__device__ __forceinline__ unsigned xb_ld(unsigned* p)              { return __hip_atomic_load(p, __ATOMIC_RELAXED, __HIP_MEMORY_SCOPE_AGENT); }
__device__ __forceinline__ unsigned xb_add(unsigned* p, unsigned v) { return __hip_atomic_fetch_add(p, v, __ATOMIC_RELAXED, __HIP_MEMORY_SCOPE_AGENT); }
__device__ __forceinline__ unsigned xb_xcc_id() { return (unsigned)__builtin_amdgcn_s_getreg((3 << 11) | 20) & 0xFu; }
#define XB_SPIN(cond, bar) do { unsigned _sp = 0; while (cond) { __builtin_amdgcn_s_sleep(1); \
    if ((++_sp & 255u) == 0u) { if (xb_ld(&(bar)[XB_TMO])) break; if (_sp > XB_SPIN_CAP) { atomicAdd(&(bar)[XB_TMO], 1u); break; } } } } while (0)
struct XcdBarrier { unsigned* bar; unsigned x; volatile LAS unsigned* st; };
__device__ __forceinline__ XcdBarrier xcd_barrier_post(unsigned* bar, volatile LAS unsigned* st) {
    XcdBarrier b; b.bar = bar; b.x = xb_xcc_id(); b.st = st;
    if (threadIdx.x == 0) (void)xb_add(&bar[XB_XCNT(b.x)], 1u);
    return b;
}
__device__ __forceinline__ void xcd_barrier_complete(unsigned* bar, unsigned x, unsigned& nloc, unsigned& nx) {
    const unsigned G = gridDim.x * gridDim.y * gridDim.z;
    unsigned sum, cnt, mine, sp = 0u;
    for (;;) {
        sum = 0u; cnt = 0u; mine = 0u;
#pragma unroll
        for (unsigned j = 0; j < 16; ++j) { const unsigned c = xb_ld(&bar[XB_XCNT(j)]); sum += c; cnt += (c > 0u) ? 1u : 0u; mine = (j == x) ? c : mine; }
        if (sum == G) break;
        __builtin_amdgcn_s_sleep(1);
        if ((++sp & 255u) == 0u) { if (xb_ld(&bar[XB_TMO])) break; if (sp > XB_SPIN_CAP) { atomicAdd(&bar[XB_TMO], 1u); break; } }
    }
    nloc = mine > 0u ? mine : 1u; nx = cnt > 0u ? cnt : 1u;
}
__device__ __forceinline__ void xcd_barrier(const XcdBarrier& b) {
    asm volatile("s_waitcnt vmcnt(0)" ::: "memory");
    __syncthreads();
    if (threadIdx.x == 0) {
        unsigned* bar = b.bar;
        __builtin_amdgcn_s_waitcnt(0);
        unsigned nloc = b.st[0], nx = b.st[1];
        if (nloc == 0u) { xcd_barrier_complete(bar, b.x, nloc, nx); b.st[0] = nloc; b.st[1] = nx; }
        const unsigned old = xb_add(&bar[XB_XSUB(b.x)], 1u);
        const unsigned gen = old / nloc;
        if (old + 1u == (gen + 1u) * nloc) {
            __builtin_amdgcn_fence(__ATOMIC_RELEASE, "agent");
            asm volatile("s_waitcnt vmcnt(0)" ::: "memory");
            const unsigned og = xb_add(&bar[XB_TOP], 1u);
            const unsigned tg = og / nx;
            if (og + 1u == (tg + 1u) * nx) xb_add(&bar[XB_TOPGEN], 1u);
            else XB_SPIN(xb_ld(&bar[XB_TOPGEN]) == tg, bar);
            __builtin_amdgcn_fence(__ATOMIC_ACQUIRE, "agent");
            xb_add(&bar[XB_XGEN(b.x)], 1u);
            asm volatile("s_waitcnt vmcnt(0)" ::: "memory");
        } else {
            XB_SPIN(xb_ld(&bar[XB_XGEN(b.x)]) == gen, bar);
            __builtin_amdgcn_fence(__ATOMIC_ACQUIRE, "agent");
            asm volatile("s_waitcnt vmcnt(0)" ::: "memory");
        }
    }
    __syncthreads();
}

__device__ __forceinline__ void xcd_arrive(const XcdBarrier& b) {
    asm volatile("s_waitcnt vmcnt(0)" ::: "memory");
    __syncthreads();
    if (threadIdx.x == 0) {
        unsigned* bar = b.bar;
        __builtin_amdgcn_s_waitcnt(0);
        unsigned nloc = b.st[0], nx = b.st[1];
        if (nloc == 0u) { xcd_barrier_complete(bar, b.x, nloc, nx); b.st[0] = nloc; b.st[1] = nx; }
        const unsigned old = xb_add(&bar[XB_XSUB(b.x)], 1u);
        const unsigned gen = old / nloc;
        b.st[2] = gen;
        if (old + 1u == (gen + 1u) * nloc) {
            __builtin_amdgcn_fence(__ATOMIC_RELEASE, "agent");
            asm volatile("s_waitcnt vmcnt(0)" ::: "memory");
            (void)xb_add(&bar[XB_TOP], 1u);
        }
        __builtin_amdgcn_fence(__ATOMIC_ACQUIRE, "agent");
    }
}
__device__ __forceinline__ void xcd_wait(const XcdBarrier& b) {
    if (threadIdx.x == 0) {
        unsigned* bar = b.bar; const unsigned need = (b.st[2] + 1u) * b.st[1];
        XB_SPIN((int)(xb_ld(&bar[XB_TOP]) - need) < 0, bar);
        asm volatile("s_waitcnt vmcnt(0)" ::: "memory");
    }
    __syncthreads();
}

#define XB_LSUB(j)  (5120 + 64 * (j))
#define XB_GRP(j)   (6400 + 64 * (j))
#define XB_MIS      7040
__device__ __forceinline__ void xcd_local_barrier(const XcdBarrier& b) {
    asm volatile("s_waitcnt vmcnt(0)" ::: "memory");
    __syncthreads();
    if (threadIdx.x == 0) {
        unsigned* bar = b.bar;
        const unsigned nloc = b.st[0];
        const unsigned old = xb_add(&bar[XB_LSUB(b.x)], 1u);
        const unsigned need = (old / nloc + 1u) * nloc;
        __builtin_amdgcn_fence(__ATOMIC_ACQUIRE, "agent");
        XB_SPIN((int)(xb_ld(&bar[XB_LSUB(b.x)]) - need) < 0, bar);
        asm volatile("s_waitcnt vmcnt(0)" ::: "memory");
    }
    __syncthreads();
}

struct Args { const float* in[27]; float* out; unsigned char* ws; };

__device__ __forceinline__ float wave_sum(float v) {
#pragma unroll
    for (int o = 1; o < 64; o <<= 1) v += __shfl_xor(v, o);
    return v;
}

struct TItem { const float* W; const float* g; const float* gn; bf16* WT; int ldw, K, srccol, dstrow, k0; float sc; int kperm; };
struct TRegs { f32x4 v[8]; float gk[8]; };
__device__ __forceinline__ void t_load(const TItem& t, TRegs& r, int lane) {
    const int rl = lane >> 3, cq = lane & 7;
#pragma unroll
    for (int i = 0; i < 8; ++i) { const int kk = 8 * i + rl; r.v[i] = __builtin_nontemporal_load((const GAS f32x4*)(t.W + (size_t)(t.k0 + kk) * t.ldw + t.srccol + 4 * cq)); r.gk[i] = t.g ? t.g[t.k0 + kk] : 1.f; }
}
__device__ __forceinline__ void t_process(const TItem& t, const TRegs& r, LAS float* scr, int lane) {
    const int rl = lane >> 3, cq = lane & 7;
    f32x4 gn4 = (f32x4){1.f, 1.f, 1.f, 1.f}; if (t.gn) gn4 = *(const GAS f32x4*)(t.gn + t.srccol + 4 * cq);
#pragma unroll
    for (int i = 0; i < 8; ++i) { const int kk = 8 * i + rl; const float m = r.gk[i] * t.sc; LAS float* d = scr + kk * 33 + 4 * cq;
        d[0] = r.v[i].x * m * gn4.x; d[1] = r.v[i].y * m * gn4.y; d[2] = r.v[i].z * m * gn4.z; d[3] = r.v[i].w * m * gn4.w; }
    LDS_WAIT(); asm volatile("" ::: "memory");
    const int c = lane & 7;
    const int lp = t.kperm == 0 ? 8 * c : t.kperm == 1 ? (((c & 6) << 3) | ((c & 1) << 2)) : (((c & 4) << 3) | ((c & 3) << 2));
    const LAS float* s0 = scr + lp * 33; const LAS float* s1 = s0 + (4 << t.kperm) * 33;
#pragma unroll
    for (int j = 0; j < 4; ++j) { const int n = (lane >> 3) + 8 * j;
        float e[8];
#pragma unroll
        for (int q = 0; q < 8; ++q) e[q] = (q < 4 ? s0 : s1)[(q & 3) * 33 + n];
        v4u o; o.x = pk2(e[0], e[1]); o.y = pk2(e[2], e[3]); o.z = pk2(e[4], e[5]); o.w = pk2(e[6], e[7]);
        *(GAS v4u*)(t.WT + (size_t)(t.dstrow + n) * t.K + t.k0 + 8 * c) = o; }
    LDS_WAIT(); asm volatile("" ::: "memory");
}
__device__ __forceinline__ void rms_row_to_bf16(const float* xrow, bf16* orow, float* n0, int lane) {
    const GAS f32x4* xr = (const GAS f32x4*)xrow + lane;
    f32x4 v[4]; float s = 0.f;
#pragma unroll
    for (int j = 0; j < 4; ++j) { v[j] = __builtin_nontemporal_load(xr + 64 * j); s += (v[j].x * v[j].x + v[j].y * v[j].y) + (v[j].z * v[j].z + v[j].w * v[j].w); }
    const float rs = 1.f / sqrtf(wave_sum(s) * (1.f / D) + EPS);
    if (lane == 0 && n0) *n0 = 1.f / rs;
    GAS v2u* o8 = (GAS v2u*)orow + lane;
#pragma unroll
    for (int j = 0; j < 4; ++j) { v2u w; w.x = pk2(v[j].x * rs, v[j].y * rs); w.y = pk2(v[j].z * rs, v[j].w * rs); o8[64 * j] = w; }
}
__device__ __forceinline__ void rms_rows2_to_bf16(const float* x0, bf16* o0, const float* x1, bf16* o1, float* n0, float* n1, int lane) {
    const GAS f32x4* a0 = (const GAS f32x4*)x0 + lane; const GAS f32x4* a1 = (const GAS f32x4*)x1 + lane;
    f32x4 v[4], w[4]; float s = 0.f, t = 0.f;
#pragma unroll
    for (int j = 0; j < 4; ++j) { v[j] = __builtin_nontemporal_load(a0 + 64 * j); w[j] = __builtin_nontemporal_load(a1 + 64 * j); }
#pragma unroll
    for (int j = 0; j < 4; ++j) { s += (v[j].x * v[j].x + v[j].y * v[j].y) + (v[j].z * v[j].z + v[j].w * v[j].w); t += (w[j].x * w[j].x + w[j].y * w[j].y) + (w[j].z * w[j].z + w[j].w * w[j].w); }
    const float rs = 1.f / sqrtf(wave_sum(s) * (1.f / D) + EPS), rt_ = 1.f / sqrtf(wave_sum(t) * (1.f / D) + EPS);
    GAS v2u* p0 = (GAS v2u*)o0 + lane; GAS v2u* p1 = (GAS v2u*)o1 + lane;
    if (lane == 0) { if (n0) *n0 = 1.f / rs; if (n1) *n1 = 1.f / rt_; }
#pragma unroll
    for (int j = 0; j < 4; ++j) { v2u u; u.x = pk2(v[j].x * rs, v[j].y * rs); u.y = pk2(v[j].z * rs, v[j].w * rs); p0[64 * j] = u;
        v2u z; z.x = pk2(w[j].x * rt_, w[j].y * rt_); z.y = pk2(w[j].z * rt_, w[j].w * rt_); p1[64 * j] = z; }
}
__device__ __forceinline__ const float* xrow_ptr(const Args& a, int row) { return row < MP ? a.in[0] + (size_t)row * D : a.in[1] + (size_t)(row - MP) * D; }

constexpr int I_IN = 16 * 64, I_KV = 16 * 64, I_WP = 4 * 2 * 4, N_EARLY = I_IN + I_KV + I_WP;
constexpr int I_OUT = 16 * 32, I_Q = 16 * 32, I_CO = 16 * 32, I_UP = 16 * 128, I_DN = 64 * 32, I_VS = 64 * 4 * 8, N_ITEMS = N_EARLY + I_OUT + I_Q + I_CO + I_UP + I_DN + I_VS;
constexpr int DN_LO = N_EARLY + I_OUT + I_Q + I_CO + I_UP, DN_HI = DN_LO + I_DN;
__device__ __forceinline__ TItem p0_item(const Args& a, int it) {
    unsigned char* ws = a.ws; TItem t; t.g = nullptr; t.gn = nullptr; t.sc = 1.f; t.kperm = 0;
    int r = it;
    if (r < I_IN) { const int kb = r / 64, nb = r % 64, n0 = 32 * nb; int src;
        if (n0 < 1024) src = n0; else { const int j = (n0 - 1024) >> 8, o = (n0 - 1024) & 255; src = o < 128 ? 1024 + 128 * j + o : 1536 + 128 * j + (o - 128); }
        t.W = a.in[8]; t.ldw = NIN; t.K = D; t.srccol = src; t.WT = (bf16*)(ws + WS_WIN); t.dstrow = n0; t.k0 = 64 * kb; t.g = a.in[7]; return t; } r -= I_IN;
    if (r < I_KV) { const int kb = r / 64, nb = r % 64, n0 = 32 * nb;
        t.W = n0 < 1024 ? a.in[17] : a.in[18]; t.ldw = D; t.K = D; t.srccol = n0 & 1023; t.WT = (bf16*)(ws + WS_WKV); t.dstrow = n0; t.k0 = 64 * kb; t.g = a.in[16]; return t; } r -= I_KV;
    if (r < I_WP) { const int gi = r / 8, kb = (r % 8) / 4, nb = r % 4;
        t.W = a.in[9] + gi * 16384; t.ldw = 128; t.K = 128; t.srccol = 32 * nb; t.WT = (bf16*)(ws + WS_WP) + gi * 16384; t.dstrow = 32 * nb; t.k0 = 64 * kb; t.gn = a.in[10] + gi * 128; t.kperm = 2; return t; } r -= I_WP;
    if (r < I_OUT) { t.W = a.in[14]; t.ldw = D; t.K = D; t.srccol = 32 * (r % 32); t.WT = (bf16*)(ws + WS_WOUT); t.dstrow = t.srccol; t.k0 = 64 * (r / 32);
        t.g = t.k0 < 512 ? a.in[12] : a.in[13] - 512; return t; } r -= I_OUT;
    if (r < I_Q) { t.W = a.in[20]; t.ldw = D; t.K = D; t.srccol = 32 * (r % 32); t.WT = (bf16*)(ws + WS_WQ); t.dstrow = t.srccol; t.k0 = 64 * (r / 32); t.g = a.in[19]; t.sc = 0.0625f; return t; } r -= I_Q;
    if (r < I_CO) { t.W = a.in[21]; t.ldw = D; t.K = D; t.srccol = 32 * (r % 32); t.WT = (bf16*)(ws + WS_WCO); t.dstrow = t.srccol; t.k0 = 64 * (r / 32); return t; } r -= I_CO;
    if (r < I_UP) { t.W = a.in[24]; t.ldw = FF; t.K = D; t.srccol = 32 * (r % 128); t.WT = (bf16*)(ws + WS_WUP); t.dstrow = t.srccol; t.k0 = 64 * (r / 128); t.g = a.in[23]; return t; } r -= I_UP;
    if (r < I_DN) { t.W = a.in[25]; t.ldw = D; t.K = FF; t.srccol = 32 * (r % 32); t.WT = (bf16*)(ws + WS_WDOWN); t.dstrow = t.srccol; t.k0 = 64 * (r / 32); return t; } r -= I_DN;
    { const int sbh = r / 32, kb = (r % 32) / 8, nb = r % 8, sb = sbh >> 2, h = sbh & 3;
        t.W = a.in[5] + (size_t)sb * 262144 + h * 256; t.ldw = 1024; t.K = 256; t.srccol = 32 * nb; t.WT = (bf16*)(ws + WS_VTS) + (size_t)sbh * 65536; t.dstrow = 32 * nb; t.k0 = 64 * kb; t.kperm = 1; return t; }
}
__device__ __forceinline__ void p0_items(const Args& a, LAS float* scr, int lo, int hi, int gw, int NGW, int lane) {
    int it = lo + gw; TItem cur; TRegs rc;
    if (it < hi) { cur = p0_item(a, it); t_load(cur, rc, lane); }
    while (it < hi) {
        const int nx = it + NGW; TItem nxt = cur; TRegs rn = rc;
        if (nx < hi) { nxt = p0_item(a, nx); t_load(nxt, rn, lane); }
        t_process(cur, rc, scr, lane);
        cur = nxt; rc = rn; it = nx;
    }
}
__device__ __forceinline__ void p0_prologue(const Args& a, LAS unsigned char* lds, int gw, int NGW, int wave, int lane_) {
    int lane = lane_; asm volatile("" : "+v"(lane));
    unsigned char* ws = a.ws;
    p0_items(a, (LAS float*)(lds + wave * 16384), 0, N_EARLY, gw, NGW, lane);
    float* rn = (float*)(ws + WS_RNORM);
    for (int m = gw; m < M + 1024; m += 2 * NGW) {
        const int m2 = m + NGW;
        const float* r0 = m < M ? xrow_ptr(a, m) : a.in[6] + (size_t)(m - M) * D; bf16* o0 = m < M ? (bf16*)(ws + WS_XN) + (size_t)m * D : (bf16*)(ws + WS_MN) + (size_t)(m - M) * D;
        if (m2 < M + 1024) {
            const float* r1 = m2 < M ? xrow_ptr(a, m2) : a.in[6] + (size_t)(m2 - M) * D; bf16* o1 = m2 < M ? (bf16*)(ws + WS_XN) + (size_t)m2 * D : (bf16*)(ws + WS_MN) + (size_t)(m2 - M) * D;
            rms_rows2_to_bf16(r0, o0, r1, o1, m < MP ? rn + m : nullptr, m2 < MP ? rn + m2 : nullptr, lane);
        } else rms_row_to_bf16(r0, o0, m < MP ? rn + m : nullptr, lane);
    }
    { GAS v4u* dst = (GAS v4u*)(ws + WS_HISTU); constexpr int NU = 16 * 15 * 512 / 8, NV = 16 * 2 * 512 / 8;
      for (int i = gw * 64 + lane; i < NU + NV; i += NGW * 64) { const GAS f32x4* src = i < NU ? (const GAS f32x4*)a.in[2] + 2 * i : (const GAS f32x4*)a.in[3] + 2 * (i - NU); const f32x4 p = src[0], q = src[1];
          v4u o; o.x = pk2(p.x, p.y); o.y = pk2(p.z, p.w); o.z = pk2(q.x, q.y); o.w = pk2(q.z, q.w); dst[i] = o; } }
}
__device__ __forceinline__ void p2_late(const Args& a, LAS unsigned char* lds, int gw, int NGW, int wave, int lane_) {
    int lane = lane_; asm volatile("" : "+v"(lane));
    unsigned char* ws = a.ws;
    p0_items(a, (LAS float*)(lds + wave * 16384), N_EARLY, DN_LO, gw, NGW, lane);
    p0_items(a, (LAS float*)(lds + wave * 16384), DN_HI, N_ITEMS, gw, NGW, lane);
    { const GAS f32x4* src = (const GAS f32x4*)a.in[4]; GAS v4u* dst = (GAS v4u*)(ws + WS_KBS); const size_t n = (size_t)16 * 256 * 1024 / 8, st = (size_t)NGW * 64;
      for (size_t i = (size_t)gw * 64 + lane; i < n; i += 4 * st) { f32x4 p[4], q[4];
#pragma unroll
          for (int k = 0; k < 4; ++k) if (i + k * st < n) { p[k] = __builtin_nontemporal_load(src + 2 * (i + k * st)); q[k] = __builtin_nontemporal_load(src + 2 * (i + k * st) + 1); }
#pragma unroll
          for (int k = 0; k < 4; ++k) if (i + k * st < n) { v4u o; o.x = pk2(p[k].x, p[k].y); o.y = pk2(p[k].z, p[k].w); o.z = pk2(q[k].x, q[k].y); o.w = pk2(q[k].z, q[k].w); dst[i + k * st] = o; } } }
}

__device__ __forceinline__ void load8(const bf16* p, float (&f)[8]) { const v4u w = *(const GAS v4u*)p; f[0] = bflo(w.x); f[1] = bfhi(w.x); f[2] = bflo(w.y); f[3] = bfhi(w.y); f[4] = bflo(w.z); f[5] = bfhi(w.z); f[6] = bflo(w.w); f[7] = bfhi(w.w); }
__device__ __forceinline__ void load8f(const float* p, float (&f)[8]) { const f32x4 a = *(const GAS f32x4*)p, b = *(const GAS f32x4*)(p + 4); f[0] = a.x; f[1] = a.y; f[2] = a.z; f[3] = a.w; f[4] = b.x; f[5] = b.y; f[6] = b.z; f[7] = b.w; }
__device__ __forceinline__ void acc8(const v4u w, float (&s)[8]) { s[0] += bflo(w.x); s[1] += bfhi(w.x); s[2] += bflo(w.y); s[3] += bfhi(w.y); s[4] += bflo(w.z); s[5] += bfhi(w.z); s[6] += bflo(w.w); s[7] += bfhi(w.w); }
__device__ __forceinline__ void mixer_stage_wp(LAS unsigned char* lds, const bf16* WPt, int wave, int lane) {
    const GAS char* gb = (const GAS char*)WPt + (size_t)wave * 16384;
    const unsigned rl4 = (unsigned)lane >> 4, l15 = (unsigned)lane & 15u;
#pragma unroll
    for (int n = 0; n < 16; ++n) { const unsigned rl = 4u * n + rl4;
        __builtin_amdgcn_global_load_lds((const GAS unsigned*)(gb + rl * 256u + ((l15 ^ (rl & 15u)) << 4)), (LAS unsigned*)(lds + (wave * 16 + n) * 1024), 16, 0, 0); }
}
__device__ __forceinline__ unsigned off_b(unsigned row, unsigned ch) { return 256u * row + 16u * (ch ^ (((row & 3u) << 2) | ((row >> 2) & 3u))); }
template <int GI> __device__ __forceinline__ void pool_issue(const Args& a, LAS unsigned char* tile, int row0, int nblk, bool sample, int lane) {
    constexpr int W = 2 << GI;
    const unsigned fr = lane & 15, fq = lane >> 4;
    const int nrows = 16 * nblk + W - 1, t0 = sample ? 0 : (row0 & 4095), sb = (row0 >> 4) & 15;
    const GAS char* wsb = (const GAS char*)a.ws;
#pragma unroll
    for (int n = 0; n < 16; ++n) if (n < 4 * nblk + 4) {
        const int r = 4 * n + (int)fq, tt = t0 - (W - 1) + r;
        unsigned o;
        if (r >= nrows) o = (unsigned)WS_ZERO;
        else if (tt >= 0) o = (unsigned)WS_P1 + (unsigned)(row0 - (W - 1) + r) * 3072u + (unsigned)(GI * 256);
        else o = sample ? (unsigned)WS_HISTU + (unsigned)(sb * 15 + 15 + tt) * 1024u + (unsigned)(GI * 256) : (unsigned)WS_ZERO;
        const unsigned lc = fr ^ ((fq << 2) | (unsigned)(n & 3));
        __builtin_amdgcn_global_load_lds((const GAS unsigned*)(wsb + o + (lc << 4)), (LAS unsigned*)(tile + n * 1024), 16, 0, 0); }
}
template <int GI> __device__ __forceinline__ void pool_compute(const Args& a, LAS unsigned char* lds, LAS unsigned char* tile, int row0, int nblk, bool sample, int lane) {
    constexpr int W = 2 << GI;
    const int fr = lane & 15, fq = lane >> 4;
    bf16x8 wf[4][8];
    { const bf16* wp = (const bf16*)(a.ws + WS_WP) + GI * 16384 + (size_t)fr * 128 + fq * 8;
#pragma unroll
      for (int ks = 0; ks < 4; ++ks)
#pragma unroll
          for (int db = 0; db < 8; ++db) wf[ks][db] = *(const GAS bf16x8*)(wp + db * 2048 + ks * 32); }
    const unsigned tb = (unsigned)(size_t)tile, qq = (unsigned)(lane & 15) >> 2, pp = (unsigned)lane & 3u;
    bf16x8 cfg;
    { float cw[8]; int fr_ = fr, r8 = 8 * fq; asm volatile("" : "+v"(fr_), "+v"(r8));
#pragma unroll
      for (int jj = 0; jj < 8; ++jj) { const int r = r8 + jj; cw[jj] = ((r >= fr_ && r <= fr_ + W - 1) ? (1.f / W) : 0.f) - (r == fr_ + W - 1 ? 1.f : 0.f); }
      v4u pc; pc.x = pk2(cw[0], cw[1]); pc.y = pk2(cw[2], cw[3]); pc.z = pk2(cw[4], cw[5]); pc.w = pk2(cw[6], cw[7]); cfg = __builtin_bit_cast(bf16x8, pc); }
    asm volatile("s_waitcnt vmcnt(0)" ::: "memory");
#pragma unroll 1
    for (int i = 0; i < nblk; ++i) {
        const int row = row0 + 16 * i + fr, t = sample ? fr : (row & 4095);
        const float inv = sample ? (1.f / W) : 1.f / (float)(t + 1 < W ? t + 1 : W);
        bf16x8 cf = cfg;
        if (!sample && ((row0 + 16 * i) & 4095) == 0) {
          float cw[8];
          int fr_ = fr, r8 = 8 * fq; asm volatile("" : "+v"(fr_), "+v"(r8));
#pragma unroll
          for (int jj = 0; jj < 8; ++jj) { const int r = r8 + jj; cw[jj] = ((r >= fr_ && r <= fr_ + W - 1) ? inv : 0.f) - (r == fr_ + W - 1 ? 1.f : 0.f); }
          v4u pc; pc.x = pk2(cw[0], cw[1]); pc.y = pk2(cw[2], cw[3]); pc.z = pk2(cw[4], cw[5]); pc.w = pk2(cw[6], cw[7]); cf = __builtin_bit_cast(bf16x8, pc); }
        v4u pa[4];
#pragma unroll
        for (int cb = 0; cb < 8; cb += 2) {
            unsigned ad[4];
#pragma unroll
            for (int k = 0; k < 4; ++k) { const unsigned c_ = cb + (k >> 1), tt = k & 1; ad[k] = tb + 4096u * i + off_b(8u * fq + 4u * tt + qq, 2u * c_ + (pp >> 1)) + 8u * (pp & 1u); }
            v2u r0, r1, r2, r3;
            asm volatile("ds_read_b64_tr_b16 %0, %4\n\tds_read_b64_tr_b16 %1, %5\n\tds_read_b64_tr_b16 %2, %6\n\tds_read_b64_tr_b16 %3, %7\n\ts_waitcnt lgkmcnt(0)"
                         : "=&v"(r0), "=&v"(r1), "=&v"(r2), "=&v"(r3) : "v"(ad[0]), "v"(ad[1]), "v"(ad[2]), "v"(ad[3]) : "memory");
            v4u f0; f0.x = r0.x; f0.y = r0.y; f0.z = r1.x; f0.w = r1.y;
            v4u f1; f1.x = r2.x; f1.y = r2.y; f1.z = r3.x; f1.w = r3.y;
            const pg8::f32x4 p0 = __builtin_amdgcn_mfma_f32_16x16x32_bf16(__builtin_bit_cast(bf16x8, f0), cf, (pg8::f32x4){0.f, 0.f, 0.f, 0.f}, 0, 0, 0);
            const pg8::f32x4 p1 = __builtin_amdgcn_mfma_f32_16x16x32_bf16(__builtin_bit_cast(bf16x8, f1), cf, (pg8::f32x4){0.f, 0.f, 0.f, 0.f}, 0, 0, 0);
            pa[cb >> 1].x = pk2c(p0[0], p0[1]); pa[cb >> 1].y = pk2c(p0[2], p0[3]); pa[cb >> 1].z = pk2c(p1[0], p1[1]); pa[cb >> 1].w = pk2c(p1[2], p1[3]);
        }
        pg8::f32x4 acc[8];
#pragma unroll
        for (int db = 0; db < 8; ++db) acc[db] = (pg8::f32x4){0.f, 0.f, 0.f, 0.f};
#pragma unroll
        for (int ks = 0; ks < 4; ++ks) { const bf16x8 pf = __builtin_bit_cast(bf16x8, pa[ks]);
#pragma unroll
            for (int db = 0; db < 8; ++db) acc[db] = __builtin_amdgcn_mfma_f32_16x16x32_bf16(wf[ks][db], pf, acc[db], 0, 0, 0); }
        float ss = 0.f;
#pragma unroll
        for (int db = 0; db < 8; ++db) ss += (acc[db][0] * acc[db][0] + acc[db][1] * acc[db][1]) + (acc[db][2] * acc[db][2] + acc[db][3] * acc[db][3]);
        ss += __shfl_xor(ss, 16); ss += __shfl_xor(ss, 32);
        const float rs = 1.f / sqrtf(ss * (1.f / 128.f) + EPS);
        bf16* MRG = (bf16*)(a.ws + WS_MRG);
#pragma unroll
        for (int db = 0; db < 8; ++db) { const f32x4 o = acc[db] * rs;
            v2u w; w.x = pk2(o[0], o[1]); w.y = pk2(o[2], o[3]); *(GAS v2u*)(MRG + (size_t)row * D + GI * 128 + 16 * db + 4 * fq) = w; }
    }
}
__device__ __forceinline__ f32x2 up2(unsigned w) { f32x2 r; r.x = bflo(w); r.y = bfhi(w); return r; }
__device__ __forceinline__ unsigned pk2v(f32x2 v) { const bf16n2 b = __builtin_convertvector(v, bf16n2); return __builtin_bit_cast(unsigned, b); }
template <int CTRL> __device__ __forceinline__ float dpp_f(float v) { return __builtin_bit_cast(float, __builtin_amdgcn_update_dpp(0, __builtin_bit_cast(int, v), CTRL, 0xf, 0xf, true)); }
__device__ __forceinline__ void conv_half(const Args& a, int row0, int half, bool sample, int lane) {
    const bf16* P1 = (const bf16*)(a.ws + WS_P1); bf16* MRG = (bf16*)(a.ws + WS_MRG);
    const int ch = 8 * lane, i0 = 8 * half;
    const bf16* histv = sample ? (const bf16*)(a.ws + WS_HISTV) + (size_t)(((row0 >> 4) & 15) * 2 + 2) * 512 : (const bf16*)(a.ws + WS_ZERO);
    const int hstep = sample ? 512 : 0, t0 = sample ? 0 : (row0 & 4095);
    v4u xv[10], xb[8];
#pragma unroll
    for (int k = 0; k < 10; ++k) { const int i = i0 + k - 2; const bf16* p = (t0 + i >= 0) ? P1 + (size_t)(row0 + i) * 1536 + 1024 : histv + (ptrdiff_t)i * hstep; xv[k] = *(const GAS v4u*)(p + ch); }
#pragma unroll
    for (int k = 0; k < 8; ++k) xb[k] = *(const GAS v4u*)(P1 + (size_t)(row0 + i0 + k) * 1536 + 512 + ch);
    f32x2 w0[4], w1[4], w2[4];
#pragma unroll
    for (int q = 0; q < 4; ++q) { w0[q] = *(const GAS f32x2*)(a.in[11] + ch + 2 * q); w1[q] = *(const GAS f32x2*)(a.in[11] + 512 + ch + 2 * q); w2[q] = *(const GAS f32x2*)(a.in[11] + 1024 + ch + 2 * q); }
    f32x2 va[4], vb[4], vc[4];
#pragma unroll
    for (int q = 0; q < 4; ++q) { va[q] = up2(xv[0][q]); vb[q] = up2(xv[1][q]); }
#pragma unroll
    for (int k = 0; k < 8; ++k) {
        f32x2 y[4]; f32x2 s2 = {0.f, 0.f};
#pragma unroll
        for (int q = 0; q < 4; ++q) { vc[q] = up2(xv[k + 2][q]); const f32x2 bg = up2(xb[k][q]);
            f32x2 cv = w0[q] * va[q]; cv = __builtin_elementwise_fma(w1[q], vb[q], cv); cv = __builtin_elementwise_fma(w2[q], vc[q], cv);
            y[q] = bg * cv; s2 = __builtin_elementwise_fma(y[q], y[q], s2); }
        float ss = s2.x + s2.y;
        ss += dpp_f<0xB1>(ss); ss += dpp_f<0x4E>(ss); ss += dpp_f<0x141>(ss);
        const float rs = 1.f / sqrtf(ss * (1.f / 64.f) + EPS);
        v4u o;
#pragma unroll
        for (int q = 0; q < 4; ++q) { const f32x2 r2 = {rs, rs}; o[q] = pk2v(y[q] * r2); }
        *(GAS v4u*)(MRG + (size_t)(row0 + i0 + k) * D + 512 + ch) = o;
#pragma unroll
        for (int q = 0; q < 4; ++q) { va[q] = vb[q]; vb[q] = vc[q]; }
    }
}
__device__ __forceinline__ void unpack8(const v4u w, float (&f)[8]) { f[0] = bflo(w.x); f[1] = bfhi(w.x); f[2] = bflo(w.y); f[3] = bfhi(w.y); f[4] = bflo(w.z); f[5] = bfhi(w.z); f[6] = bflo(w.w); f[7] = bfhi(w.w); }
__device__ __forceinline__ int mixer_blk(int xg, int bl) { return xg < 0 ? bl : (bl < 128 ? xg * 128 + bl : 1024 + xg * 2 + (bl - 128)); }
template <int GI> __device__ __forceinline__ void mixer_wave(const Args& a, LAS unsigned char* lds, int xg, int j, int nj, int wave, int lane) {
    LAS unsigned char* tile = lds + wave * 16384;
    if (xg >= 0 && nj == 56) {
        int bl0 = -1, nblk = 0;
        if (j < 42) { bl0 = 3 * j; nblk = 3; } else if (j == 42) { bl0 = 126; nblk = 2; } else if (j < 45) { bl0 = 128 + (j - 43); nblk = 1; }
        const int row0 = bl0 >= 0 ? mixer_blk(xg, bl0) * 16 : 0; const bool sample = row0 >= MP;
        if (nblk) pool_issue<GI>(a, tile, row0, nblk, sample, lane);
        int c0 = -1, c1 = -1;
        if (j >= 45) { c0 = 2 * (j - 45); c1 = c0 + 1; } else if (j <= 42) c0 = 22 + j;
        if (c0 >= 0) { const int h = 4 * c0 + GI, r0 = mixer_blk(xg, h >> 1) * 16; conv_half(a, r0, h & 1, r0 >= MP, lane); }
        if (c1 >= 0) { const int h = 4 * c1 + GI, r0 = mixer_blk(xg, h >> 1) * 16; conv_half(a, r0, h & 1, r0 >= MP, lane); }
        asm volatile("" ::: "memory");
        if (nblk) pool_compute<GI>(a, lds, tile, row0, nblk, sample, lane);
    } else {
        const int nb = xg >= 0 ? 130 : M / 16;
        for (int bl = j; bl < nb; bl += nj) { const int row0 = mixer_blk(xg, bl) * 16;
            pool_issue<GI>(a, tile, row0, 1, row0 >= MP, lane); pool_compute<GI>(a, lds, tile, row0, 1, row0 >= MP, lane); }
        for (int h = j * 4 + GI; h < 2 * nb; h += nj * 4) { const int r0 = mixer_blk(xg, h >> 1) * 16; conv_half(a, r0, h & 1, r0 >= MP, lane); }
    }
}
__device__ __forceinline__ void mixer_all(const Args& a, LAS unsigned char* lds, int xg, int cu, int ncu, int wave, int lane_) {
    int lane = lane_; asm volatile("" : "+v"(lane));
    const int gi = wave & 3, j = cu * 2 + (wave >> 2), nj = ncu * 2;
    if (gi == 0) mixer_wave<0>(a, lds, xg, j, nj, wave, lane);
    else if (gi == 1) mixer_wave<1>(a, lds, xg, j, nj, wave, lane);
    else if (gi == 2) mixer_wave<2>(a, lds, xg, j, nj, wave, lane);
    else mixer_wave<3>(a, lds, xg, j, nj, wave, lane);
}

__device__ __forceinline__ void resid_row(const float* base, const float* raw, const float* g, float* xo, bf16* xn, int lane_) {
    int lane = lane_; asm volatile("" : "+v"(lane));
    const GAS f32x4* rr = (const GAS f32x4*)raw + lane; const GAS f32x4* bb = (const GAS f32x4*)base + lane; const GAS f32x4* gg = (const GAS f32x4*)g + lane;
    f32x4 v[4]; float s = 0.f;
#pragma unroll
    for (int j = 0; j < 4; ++j) { v[j] = rr[64 * j]; s += (v[j].x * v[j].x + v[j].y * v[j].y) + (v[j].z * v[j].z + v[j].w * v[j].w); }
    const float rs = 1.f / sqrtf(wave_sum(s) * (1.f / D) + EPS);
    float s2 = 0.f;
#pragma unroll
    for (int j = 0; j < 4; ++j) { v[j] = bb[64 * j] + v[j] * rs * gg[64 * j]; s2 += (v[j].x * v[j].x + v[j].y * v[j].y) + (v[j].z * v[j].z + v[j].w * v[j].w); }
    GAS f32x4* oo = (GAS f32x4*)xo + lane;
#pragma unroll
    for (int j = 0; j < 4; ++j) oo[64 * j] = v[j];
    if (xn) { const float r2 = 1.f / sqrtf(wave_sum(s2) * (1.f / D) + EPS); GAS v2u* o8 = (GAS v2u*)xn + lane;
#pragma unroll
        for (int j = 0; j < 4; ++j) { v2u w; w.x = pk2(v[j].x * r2, v[j].y * r2); w.y = pk2(v[j].z * r2, v[j].w * r2); o8[64 * j] = w; } }
}

#define MFMA32(a, b, c) __builtin_amdgcn_mfma_f32_32x32x16_bf16((a), (b), (c), 0, 0, 0)
__device__ __forceinline__ bf16x8 pack8(const f32x16& x, int s) {
    v4u p; p.x = pk2(x[8 * s], x[8 * s + 1]); p.y = pk2(x[8 * s + 2], x[8 * s + 3]); p.z = pk2(x[8 * s + 4], x[8 * s + 5]); p.w = pk2(x[8 * s + 6], x[8 * s + 7]);
    return __builtin_bit_cast(bf16x8, p);
}
__device__ __forceinline__ void attn_stage(LAS unsigned char* lds, const bf16* G, unsigned pitch  , int wave, int lane) {
    const GAS char* gb = (const GAS char*)G + (size_t)wave * 32 * pitch;
    const unsigned hi = (unsigned)lane >> 5, l31 = (unsigned)lane & 31u;
#pragma unroll
    for (int n = 0; n < 16; ++n) { const unsigned rl = 2u * n + hi;
        const unsigned off = rl * pitch + ((l31 ^ (rl & 15u)) << 4);
        __builtin_amdgcn_global_load_lds((const GAS unsigned*)(gb + off), (LAS unsigned*)(lds + (wave * 16 + n) * 1024), 16, 0, 0); }
}
__device__ __forceinline__ void attn_unit(LAS unsigned char* lds, const bf16* Qb, bf16* Ob, unsigned qoff, const bf16* Kg, const bf16* VTg, bool store, int wave, int lane_) {
    int lane = lane_; asm volatile("" : "+v"(lane));
    const int r = lane & 31, h = lane >> 5;
    attn_stage(lds, Kg, 2048u, wave, lane);
    const GAS char* qp = (const GAS char*)Qb;
    const unsigned qo = qoff + 16u * h;
    const unsigned x = (unsigned)(h ^ (r & 15));
    const LAS unsigned char* fo[8]; const LAS unsigned char* fo2[8];
#pragma unroll
    for (int k = 0; k < 8; ++k) { fo[k] = lds + ((unsigned)r * 512u + (((unsigned)(2 * k) ^ x) * 16u)); fo2[k] = fo[k] + 65536; asm volatile("" : "+v"(fo2[k])); }
    bf16x8 qf[8];
#pragma unroll
    for (int k = 0; k < 8; ++k) qf[k] = *(const GAS bf16x8*)(qp + qo + 32 * k);
    asm volatile("s_waitcnt vmcnt(0)" ::: "memory"); __syncthreads();
    f32x16 s[8];
#pragma unroll
    for (int mb = 0; mb < 8; ++mb)
#pragma unroll
        for (int i = 0; i < 16; ++i) s[mb][i] = 0.f;
#pragma unroll
    for (int hf = 0; hf < 2; ++hf) {
        if (hf == 1) {
#pragma unroll
            for (int k = 0; k < 8; ++k) qf[k] = *(const GAS bf16x8*)(qp + qo + 256 + 32 * k);
        }
        bf16x8 kc[8], kn[8];
#pragma unroll
        for (int k = 0; k < 8; ++k) kc[k] = *(const LAS bf16x8*)(fo[k] + hf * 256);
#pragma unroll
        for (int mb = 0; mb < 8; ++mb) {
            if (mb < 7) {
#pragma unroll
                for (int k = 0; k < 8; ++k) kn[k] = *(const LAS bf16x8*)((mb + 1 < 4 ? fo[k] : fo2[k]) + (((mb + 1) & 3) * 16384 + hf * 256)); }
            __builtin_amdgcn_s_setprio(1);
#pragma unroll
            for (int k = 0; k < 8; ++k) s[mb] = MFMA32(kc[k], qf[k], s[mb]);
            __builtin_amdgcn_s_setprio(0);
#pragma unroll
            for (int k = 0; k < 8; ++k) kc[k] = kn[k];
            asm volatile("" ::: "memory");
        }
    }
    asm volatile("s_waitcnt lgkmcnt(0)" ::: "memory"); __syncthreads();
    { int lane2 = lane; asm volatile("" : "+v"(lane2)); attn_stage(lds, VTg, 512u, wave, lane2); }
    float mx = -3.0e38f;
#pragma unroll
    for (int mb = 0; mb < 8; ++mb)
#pragma unroll
        for (int i = 0; i < 16; ++i) mx = fmaxf(mx, s[mb][i]);
    mx = fmaxf(mx, __shfl_xor(mx, 32));
    float sum; { const float nmc = -mx * 1.44269504089f; const f32x2 c2 = {1.44269504089f, 1.44269504089f}, m2 = {nmc, nmc}; f32x2 sum2 = {0.f, 0.f};
#pragma unroll
    for (int mb = 0; mb < 8; ++mb)
#pragma unroll
        for (int i = 0; i < 16; i += 2) { const f32x2 t = __builtin_elementwise_fma((f32x2){s[mb][i], s[mb][i + 1]}, c2, m2);
            const f32x2 p = {__builtin_amdgcn_exp2f(t.x), __builtin_amdgcn_exp2f(t.y)}; s[mb][i] = p.x; s[mb][i + 1] = p.y; sum2 += p; }
    sum = sum2.x + sum2.y; }
    sum += __shfl_xor(sum, 32);
    const float inv = 1.f / sum;
    bf16x8 pf[8][2];
#pragma unroll
    for (int mb = 0; mb < 8; ++mb) { pf[mb][0] = pack8(s[mb], 0); pf[mb][1] = pack8(s[mb], 1); }
    asm volatile("s_waitcnt vmcnt(0)" ::: "memory"); __syncthreads();
    GAS char* op = (GAS char*)Ob;
    bf16x8 vc[8], vn[8];
#pragma unroll
    for (int k = 0; k < 8; ++k) vc[k] = *(const LAS bf16x8*)(fo[k]);
#pragma unroll
    for (int eb = 0; eb < 8; ++eb) {
        f32x16 o;
#pragma unroll
        for (int i = 0; i < 16; ++i) o[i] = 0.f;
#pragma unroll
        for (int hv = 0; hv < 2; ++hv) {
            const int nstep = 2 * eb + hv + 1;
            if (nstep < 16) { const int neb = nstep >> 1, nhv = nstep & 1;
#pragma unroll
                for (int k = 0; k < 8; ++k) vn[k] = *(const LAS bf16x8*)((neb < 4 ? fo[k] : fo2[k]) + ((neb & 3) * 16384 + nhv * 256)); }
            __builtin_amdgcn_s_setprio(1);
#pragma unroll
            for (int k = 0; k < 8; ++k) o = MFMA32(vc[k], pf[4 * hv + (k >> 1)][k & 1], o);
            __builtin_amdgcn_s_setprio(0);
#pragma unroll
            for (int k = 0; k < 8; ++k) vc[k] = vn[k];
            asm volatile("" ::: "memory");
        }
        if (store) {
#pragma unroll
            for (int g = 0; g < 4; ++g) { v2u w; w.x = pk2(o[4 * g] * inv, o[4 * g + 1] * inv); w.y = pk2(o[4 * g + 2] * inv, o[4 * g + 3] * inv);
                *(GAS v2u*)(op + qoff + 8u * h + (64 * eb + 16 * g)) = w; }
        }
    }
    asm volatile("s_waitcnt lgkmcnt(0)" ::: "memory"); __syncthreads();
}

__device__ __forceinline__ void attn_unit_small(LAS unsigned char* lds, const bf16* Qb, bf16* Ob, const bf16* Kg, const bf16* VTg, int wave, int lane_) {
    int lane = lane_; asm volatile("" : "+v"(lane));
    const int r = lane & 31, h = lane >> 5;
    const GAS char* qp = (const GAS char*)Qb; const GAS char* kp = (const GAS char*)Kg + (size_t)wave * 65536; const GAS char* vp = (const GAS char*)VTg + (size_t)wave * 16384;
    const unsigned qo = (unsigned)(r & 15) * 2048u + 16u * h, ko = (unsigned)r * 2048u + 16u * h, vo = (unsigned)r * 512u + 16u * h;
    bf16x8 qf[16], kf[16], vf[16];
#pragma unroll
    for (int ks = 0; ks < 16; ++ks) { qf[ks] = *(const GAS bf16x8*)(qp + qo + 32 * ks); kf[ks] = *(const GAS bf16x8*)(kp + ko + 32 * ks); }
#pragma unroll
    for (int c = 0; c < 16; ++c) vf[c] = *(const GAS bf16x8*)(vp + vo + 32 * c);
    f32x16 s;
#pragma unroll
    for (int i = 0; i < 16; ++i) s[i] = 0.f;
#pragma unroll
    for (int ks = 0; ks < 16; ++ks) s = MFMA32(kf[ks], qf[ks], s);
    LAS float* red = (LAS float*)lds;
    LAS unsigned char* pbuf = lds + 4096;
    float mx = s[0];
#pragma unroll
    for (int i = 1; i < 16; ++i) mx = fmaxf(mx, s[i]);
    mx = fmaxf(mx, __shfl_xor(mx, 32));
    if (h == 0) red[wave * 32 + r] = mx;
    asm volatile("s_waitcnt lgkmcnt(0)" ::: "memory"); __syncthreads();
#pragma unroll
    for (int w = 0; w < 8; ++w) mx = fmaxf(mx, red[w * 32 + r]);
    float sum = 0.f;
#pragma unroll
    for (int i = 0; i < 16; ++i) { const float p = __builtin_amdgcn_exp2f((s[i] - mx) * 1.44269504089f); s[i] = p; sum += p; }
    sum += __shfl_xor(sum, 32);
    if (h == 0) red[256 + wave * 32 + r] = sum;
    *(LAS bf16x8*)(pbuf + (wave * 2 + 0) * 1024 + lane * 16) = pack8(s, 0);
    *(LAS bf16x8*)(pbuf + (wave * 2 + 1) * 1024 + lane * 16) = pack8(s, 1);
    asm volatile("s_waitcnt lgkmcnt(0)" ::: "memory"); __syncthreads();
    float tot = 0.f;
#pragma unroll
    for (int w = 0; w < 8; ++w) tot += red[256 + w * 32 + r];
    const float inv = 1.f / tot;
    f32x16 o;
#pragma unroll
    for (int i = 0; i < 16; ++i) o[i] = 0.f;
#pragma unroll
    for (int c = 0; c < 16; ++c) { const bf16x8 pf = *(const LAS bf16x8*)(pbuf + c * 1024 + lane * 16); o = MFMA32(vf[c], pf, o); }
    if (r < 16) { GAS char* op = (GAS char*)Ob + (unsigned)r * 2048u + 8u * h + 64u * wave;
#pragma unroll
        for (int g = 0; g < 4; ++g) { v2u w2; w2.x = pk2(o[4 * g] * inv, o[4 * g + 1] * inv); w2.y = pk2(o[4 * g + 2] * inv, o[4 * g + 3] * inv); *(GAS v2u*)(op + 16 * g) = w2; } }
    asm volatile("s_waitcnt lgkmcnt(0)" ::: "memory"); __syncthreads();
}

template <int NT, int KCH>
__device__ __forceinline__ void micro_gemm(LAS unsigned char* lds, const bf16* A, int lda, const bf16* Bt, int ldb, const int (&cb)[NT], int wave, int lane_, int tid_, float (&val)[NT][2]) {
    int lane = lane_, tid = tid_; asm volatile("" : "+v"(lane), "+v"(tid));
    constexpr int KB = (KCH > 8 && NT == 1) ? 16 : 8;
    const int r = lane & 31, h = lane >> 5;
    const GAS char* ap = (const GAS char*)A; const GAS char* bp = (const GAS char*)Bt;
    const unsigned ao = ((unsigned)r * lda + wave * (KCH * 16) + 8 * h) * 2u, bo = ((unsigned)r * ldb + wave * (KCH * 16) + 8 * h) * 2u;
    f32x16 acc[NT];
#pragma unroll
    for (int nt = 0; nt < NT; ++nt)
#pragma unroll
        for (int i = 0; i < 16; ++i) acc[nt][i] = 0.f;
#pragma unroll 1
    for (int kc = 0; kc < KCH; kc += KB) {
        bf16x8 af[KB], bfr[NT][KB];
#pragma unroll
        for (int i = 0; i < KB; ++i) af[i] = *(const GAS bf16x8*)(ap + ao + (kc + i) * 32);
#pragma unroll
        for (int nt = 0; nt < NT; ++nt)
#pragma unroll
            for (int i = 0; i < KB; ++i) bfr[nt][i] = *(const GAS bf16x8*)(bp + (size_t)cb[nt] * ldb * 2 + bo + (kc + i) * 32);
#pragma unroll
        for (int nt = 0; nt < NT; ++nt)
#pragma unroll
            for (int i = 0; i < KB; ++i) acc[nt] = MFMA32(af[i], bfr[nt][i], acc[nt]);
    }
    LAS float* part = (LAS float*)lds;
#pragma unroll
    for (int nt = 0; nt < NT; ++nt)
#pragma unroll
        for (int i = 0; i < 16; ++i) part[(wave * NT + nt) * 1024 + ((i & 3) + 8 * (i >> 2) + 4 * h) * 32 + r] = acc[nt][i];
    __syncthreads();
#pragma unroll
    for (int nt = 0; nt < NT; ++nt) { float s0 = 0.f, s1 = 0.f;
#pragma unroll
        for (int w = 0; w < 8; ++w) { const f32x2 p = *(const LAS f32x2*)(part + (w * NT + nt) * 1024 + 2 * tid); s0 += p.x; s1 += p.y; }
        val[nt][0] = s0; val[nt][1] = s1; }
}
__device__ __forceinline__ void micro_gemm_lds(LAS unsigned char* lds, const bf16* A, int lda, const bf16* Bt, int ldb, int cb0, int wave, int lane_, int tid_, float (&val)[1][2]) {
    int lane = lane_, tid = tid_; asm volatile("" : "+v"(lane), "+v"(tid));
    const int r = lane & 31, h = lane >> 5;
    LAS unsigned char* reg = lds + wave * 16384;
    __syncthreads();
    { const unsigned rq = (unsigned)lane >> 4, pc = (unsigned)lane & 15u;
      const GAS char* ap = (const GAS char*)A + wave * 256; const GAS char* bp = (const GAS char*)(Bt + (size_t)cb0 * ldb) + wave * 256;
#pragma unroll
      for (int n = 0; n < 8; ++n) { const unsigned row = 4u * n + rq, lc = pc ^ (row & 15u);
          __builtin_amdgcn_global_load_lds((const GAS unsigned*)(ap + row * (unsigned)(lda * 2) + lc * 16u), (LAS unsigned*)(reg + n * 1024), 16, 0, 0); }
#pragma unroll
      for (int n = 0; n < 8; ++n) { const unsigned row = 4u * n + rq, lc = pc ^ (row & 15u);
          __builtin_amdgcn_global_load_lds((const GAS unsigned*)(bp + row * (unsigned)(ldb * 2) + lc * 16u), (LAS unsigned*)(reg + 8192 + n * 1024), 16, 0, 0); } }
    f32x16 acc;
#pragma unroll
    for (int i = 0; i < 16; ++i) acc[i] = 0.f;
    const LAS unsigned char* fa = reg + r * 256; const unsigned x = (unsigned)(r & 15);
    asm volatile("s_waitcnt vmcnt(0)" ::: "memory");
    bf16x8 af[8], bfr[8];
#pragma unroll
    for (int i = 0; i < 8; ++i) { const unsigned pcx = ((unsigned)(2 * i + h) ^ x) * 16u; af[i] = *(const LAS bf16x8*)(fa + pcx); bfr[i] = *(const LAS bf16x8*)(fa + 8192 + pcx); }
#pragma unroll
    for (int i = 0; i < 8; ++i) acc = MFMA32(af[i], bfr[i], acc);
    asm volatile("s_waitcnt lgkmcnt(0)" ::: "memory");
    LAS float* part = (LAS float*)reg;
#pragma unroll
    for (int i = 0; i < 16; ++i) part[((i & 3) + 8 * (i >> 2) + 4 * h) * 32 + r] = acc[i];
    __syncthreads();
    float s0 = 0.f, s1 = 0.f;
#pragma unroll
    for (int w = 0; w < 8; ++w) { const f32x2 p = *(const LAS f32x2*)((const LAS float*)(lds + w * 16384) + 2 * tid); s0 += p.x; s1 += p.y; }
    val[0][0] = s0; val[0][1] = s1;
}
__device__ __forceinline__ void micro_gemm_lds_k4096(LAS unsigned char* lds, const bf16* A, int lda, const bf16* Bt, int ldb, int cb0, int wave, int lane_, int tid_, float (&val)[1][2]) {
    int lane = lane_, tid = tid_; asm volatile("" : "+v"(lane), "+v"(tid));
    const int r = lane & 31, h = lane >> 5;
    LAS unsigned char* reg = lds + wave * 16384;
    __syncthreads();
    const unsigned rq = (unsigned)lane >> 3, pc = (unsigned)lane & 7u;
    const GAS char* ap = (const GAS char*)A + wave * 128; const GAS char* bp = (const GAS char*)(Bt + (size_t)cb0 * ldb) + wave * 128;
    unsigned ao[4], bo[4];
#pragma unroll
    for (int n = 0; n < 4; ++n) { const unsigned row = 8u * n + rq, lc = pc ^ ((row >> 1) & 7u); ao[n] = row * (unsigned)(lda * 2) + lc * 16u; bo[n] = row * (unsigned)(ldb * 2) + lc * 16u; }
#define MG4K_ISSUE(rd) do { LAS unsigned char* dst_ = reg + ((rd) & 1) * 8192; \
        _Pragma("unroll") for (int n = 0; n < 4; ++n) __builtin_amdgcn_global_load_lds((const GAS unsigned*)(ap + (rd) * 1024 + ao[n]), (LAS unsigned*)(dst_ + n * 1024), 16, 0, 0); \
        _Pragma("unroll") for (int n = 0; n < 4; ++n) __builtin_amdgcn_global_load_lds((const GAS unsigned*)(bp + (rd) * 1024 + bo[n]), (LAS unsigned*)(dst_ + 4096 + n * 1024), 16, 0, 0); } while (0)
    f32x16 acc;
#pragma unroll
    for (int i = 0; i < 16; ++i) acc[i] = 0.f;
    const unsigned x = (unsigned)(r >> 1) & 7u;
    MG4K_ISSUE(0);
#pragma unroll
    for (int rd = 0; rd < 8; ++rd) {
        if (rd < 7) { MG4K_ISSUE(rd + 1); asm volatile("s_waitcnt vmcnt(8)" ::: "memory"); } else asm volatile("s_waitcnt vmcnt(0)" ::: "memory");
        const LAS unsigned char* fa = reg + (rd & 1) * 8192 + r * 128;
        bf16x8 af[4], bfr[4];
#pragma unroll
        for (int i = 0; i < 4; ++i) { const unsigned pcx = ((unsigned)(2 * i + h) ^ x) * 16u; af[i] = *(const LAS bf16x8*)(fa + pcx); bfr[i] = *(const LAS bf16x8*)(fa + 4096 + pcx); }
#pragma unroll
        for (int i = 0; i < 4; ++i) acc = MFMA32(af[i], bfr[i], acc);
        asm volatile("s_waitcnt lgkmcnt(0)" ::: "memory");
    }
#undef MG4K_ISSUE
    LAS float* part = (LAS float*)reg;
#pragma unroll
    for (int i = 0; i < 16; ++i) part[((i & 3) + 8 * (i >> 2) + 4 * h) * 32 + r] = acc[i];
    __syncthreads();
    float s0 = 0.f, s1 = 0.f;
#pragma unroll
    for (int w = 0; w < 8; ++w) { const f32x2 p = *(const LAS f32x2*)((const LAS float*)(lds + w * 16384) + 2 * tid); s0 += p.x; s1 += p.y; }
    val[0][0] = s0; val[0][1] = s1;
}
template <int NT>
__device__ __forceinline__ void micro_gemm_lds_nt(LAS unsigned char* lds, const bf16* A, int lda, const bf16* Bt, int ldb, const int (&cb)[NT], int wave, int lane_, int tid_, float (&val)[NT][2]) {
    int lane = lane_, tid = tid_; asm volatile("" : "+v"(lane), "+v"(tid));
    const int r = lane & 31, h = lane >> 5;
    LAS unsigned char* reg = lds + wave * 16384;
    __syncthreads();
    { const unsigned rq = (unsigned)lane >> 4, pc = (unsigned)lane & 15u; const GAS char* ap = (const GAS char*)A + wave * 256;
#pragma unroll
      for (int n = 0; n < 8; ++n) { const unsigned row = 4u * n + rq, lc = pc ^ (row & 15u);
          __builtin_amdgcn_global_load_lds((const GAS unsigned*)(ap + row * (unsigned)(lda * 2) + lc * 16u), (LAS unsigned*)(reg + n * 1024), 16, 0, 0); } }
    const unsigned rq8 = (unsigned)lane >> 3, pc8 = (unsigned)lane & 7u;
    unsigned bo[4];
#pragma unroll
    for (int n = 0; n < 4; ++n) { const unsigned row = 8u * n + rq8, lc = pc8 ^ ((row >> 1) & 7u); bo[n] = row * (unsigned)(ldb * 2) + lc * 16u; }
    const GAS char* bbase = (const GAS char*)Bt + wave * 256;
#define MGNT_ISSUE(rd) do { LAS unsigned char* dst_ = reg + 8192 + ((rd) & 1) * 4096; const GAS char* bp_ = bbase + (size_t)cb[(rd) >> 1] * ldb * 2 + ((rd) & 1) * 128; \
        _Pragma("unroll") for (int n = 0; n < 4; ++n) __builtin_amdgcn_global_load_lds((const GAS unsigned*)(bp_ + bo[n]), (LAS unsigned*)(dst_ + n * 1024), 16, 0, 0); } while (0)
    MGNT_ISSUE(0);
    f32x16 acc[NT];
#pragma unroll
    for (int nt = 0; nt < NT; ++nt)
#pragma unroll
        for (int i = 0; i < 16; ++i) acc[nt][i] = 0.f;
    asm volatile("s_waitcnt vmcnt(4)" ::: "memory");
    bf16x8 af[8];
    { const LAS unsigned char* fa = reg + r * 256; const unsigned x = (unsigned)(r & 15);
#pragma unroll
      for (int i = 0; i < 8; ++i) af[i] = *(const LAS bf16x8*)(fa + (((unsigned)(2 * i + h) ^ x) * 16u)); }
    const unsigned x8 = (unsigned)(r >> 1) & 7u;
#pragma unroll
    for (int rd = 0; rd < 2 * NT; ++rd) {
        if (rd + 1 < 2 * NT) { MGNT_ISSUE(rd + 1); asm volatile("s_waitcnt vmcnt(4)" ::: "memory"); } else asm volatile("s_waitcnt vmcnt(0)" ::: "memory");
        const LAS unsigned char* fb = reg + 8192 + (rd & 1) * 4096 + r * 128;
        bf16x8 bfr[4];
#pragma unroll
        for (int i = 0; i < 4; ++i) bfr[i] = *(const LAS bf16x8*)(fb + (((unsigned)(2 * i + h) ^ x8) * 16u));
#pragma unroll
        for (int i = 0; i < 4; ++i) acc[rd >> 1] = MFMA32(af[4 * (rd & 1) + i], bfr[i], acc[rd >> 1]);
        asm volatile("s_waitcnt lgkmcnt(0)" ::: "memory");
    }
#undef MGNT_ISSUE
    LAS float* part = (LAS float*)reg;
#pragma unroll
    for (int nt = 0; nt < NT; ++nt)
#pragma unroll
        for (int i = 0; i < 16; ++i) part[nt * 1024 + ((i & 3) + 8 * (i >> 2) + 4 * h) * 32 + r] = acc[nt][i];
    __syncthreads();
#pragma unroll
    for (int nt = 0; nt < NT; ++nt) { float s0 = 0.f, s1 = 0.f;
#pragma unroll
        for (int w = 0; w < 8; ++w) { const f32x2 p = *(const LAS f32x2*)((const LAS float*)(lds + w * 16384) + nt * 1024 + 2 * tid); s0 += p.x; s1 += p.y; }
        val[nt][0] = s0; val[nt][1] = s1; }
}
__device__ __forceinline__ void sample_gemm1_piece(const Args& a, LAS unsigned char* lds, int p, int wave, int lane, int tid_) {
    int tid = tid_; asm volatile("" : "+v"(tid));
    const int rg = p & 7, cp = p >> 3; int cb[2];
    if (cp < 16) { cb[0] = 64 * cp; cb[1] = 64 * cp + 32; } else { const int q = cp - 16; cb[0] = 1024 + 256 * (q >> 2) + 32 * (q & 3); cb[1] = cb[0] + 128; }
    float val[2][2];
    micro_gemm_lds_nt<2>(lds, (const bf16*)(a.ws + WS_XN) + (size_t)(MP + 32 * rg) * D, D, (const bf16*)(a.ws + WS_WIN), D, cb, wave, lane, tid, val);
    const int rs_ = 32 * rg + (tid >> 4), row = MP + rs_, t = rs_ & 15, sb = rs_ >> 4, c2 = 2 * (tid & 15);
    bf16* P1 = (bf16*)(a.ws + WS_P1) + (size_t)row * 1536;
    if (cp < 16) {
#pragma unroll
        for (int nt = 0; nt < 2; ++nt) { const int col = cb[nt] + c2; *(GAS unsigned*)(P1 + col) = pk2(val[nt][0], val[nt][1]);
            if (cp < 8 && t >= 1) *(GAS f32x2*)(a.out + OUT_POOL_S + (size_t)(sb * 15 + t - 1) * 512 + col) = (f32x2){val[nt][0], val[nt][1]}; }
    } else {
        const int ch = 32 * (cp - 16) + c2; const float v0 = val[0][0] * val[1][0], v1 = val[0][1] * val[1][1];
        *(GAS unsigned*)(P1 + 1024 + ch) = pk2(v0, v1);
        if (t >= 14) *(GAS f32x2*)(a.out + OUT_CONV_S + (size_t)(sb * 2 + t - 14) * 512 + ch) = (f32x2){v0, v1};
    }
    __syncthreads();
}
struct SampleX { unsigned* xbuf; unsigned* cnt; float* rsp; unsigned* tmo; };
template <int NT, int KCH, int MODE>
__device__ __forceinline__ void sample_gemm_piece(LAS unsigned char* lds, const bf16* A, int K, const bf16* Bt, bf16* C, int ldc, const float* rsp, int p, int wave, int lane, int tid_) {
    int tid = tid_; asm volatile("" : "+v"(tid));
    const int rg = p & 7, cp = p >> 3; int cb[NT];
#pragma unroll
    for (int nt = 0; nt < NT; ++nt) cb[nt] = 32 * NT * cp + 32 * nt;
    const int rl = 32 * rg + (tid >> 4); const size_t row = MP + rl; const int c2 = 2 * (tid & 15);
    f32x4 pr[8];
    if (rsp) { const GAS f32x4* pp = (const GAS f32x4*)(rsp + (size_t)rl * 32);
#pragma unroll
        for (int k = 0; k < 8; ++k) pr[k] = pp[k]; }
    float val[NT][2];
    if constexpr (NT == 1 && KCH == 8) micro_gemm_lds(lds, A + (size_t)(MP + 32 * rg) * K, K, Bt, K, cb[0], wave, lane, tid, val);
    else if constexpr (KCH == 8) micro_gemm_lds_nt<NT>(lds, A + (size_t)(MP + 32 * rg) * K, K, Bt, K, cb, wave, lane, tid, val);
    else micro_gemm<NT, KCH>(lds, A + (size_t)(MP + 32 * rg) * K, K, Bt, K, cb, wave, lane, tid, val);
    float rs = 1.f;
    if (rsp) { f32x4 t = pr[0];
#pragma unroll
        for (int k = 1; k < 8; ++k) t = t + pr[k];
        rs = 1.f / sqrtf(((t[0] + t[1]) + (t[2] + t[3])) * (1.f / D) + EPS); }
#pragma unroll
    for (int nt = 0; nt < NT; ++nt) {
        float v0 = val[nt][0] * rs, v1 = val[nt][1] * rs;
        if (MODE == 2) { v0 = fmaxf(v0, 0.f); v0 *= v0; v1 = fmaxf(v1, 0.f); v1 *= v1; }
        *(GAS unsigned*)(C + row * ldc + cb[nt] + c2) = pk2(v0, v1);
    }
    __syncthreads();
}
template <int KCH>
__device__ __forceinline__ void sample_fused_A(LAS unsigned char* lds, const bf16* A, int K, const bf16* Bt, const SampleX& sx, int p, int wave, int lane, int tid_) {
    int tid = tid_; asm volatile("" : "+v"(tid));
    const int rg = p & 7, cp = p >> 3; int cb[1] = {32 * cp};
    float val[1][2];
    if constexpr (KCH == 8) micro_gemm_lds(lds, A + (size_t)(MP + 32 * rg) * K, K, Bt, K, cb[0], wave, lane, tid, val);
    else if constexpr (KCH == 32) micro_gemm_lds_k4096(lds, A + (size_t)(MP + 32 * rg) * K, K, Bt, K, cb[0], wave, lane, tid, val);
    else micro_gemm<1, KCH>(lds, A + (size_t)(MP + 32 * rg) * K, K, Bt, K, cb, wave, lane, tid, val);
    const int rl = 32 * rg + (tid >> 4);
    float s = val[0][0] * val[0][0] + val[0][1] * val[0][1];
    s += __shfl_xor(s, 1); s += __shfl_xor(s, 2); s += __shfl_xor(s, 4); s += __shfl_xor(s, 8);
    if ((tid & 15) == 0) __hip_atomic_store(sx.xbuf + (size_t)rl * 32 + cp, __float_as_uint(s), __ATOMIC_RELAXED, __HIP_MEMORY_SCOPE_AGENT);
    *(LAS f32x2*)(lds + STASH_OFF + tid * 8) = (f32x2){val[0][0], val[0][1]};
    asm volatile("s_waitcnt vmcnt(0) lgkmcnt(0)" ::: "memory"); __syncthreads();
    if (tid == 0) __hip_atomic_fetch_add(sx.cnt + 64 * rg, 1u, __ATOMIC_RELAXED, __HIP_MEMORY_SCOPE_AGENT);
}
template <bool FINAL>
__device__ __forceinline__ void sample_fused_B(LAS unsigned char* lds, const float* base, const float* g, float* Y, bf16* X, const SampleX& sx, int p, int wave, int lane, int tid_) {
    int tid = tid_; asm volatile("" : "+v"(tid));
    const int rg = p & 7, cp = p >> 3;
    const int rl = 32 * rg + (tid >> 4); const int col = 32 * cp + 2 * (tid & 15);
    const f32x2 bs = *(const GAS f32x2*)(base + (size_t)rl * D + col), gv = *(const GAS f32x2*)(g + col);
    if (wave == 0) { unsigned sp = 0;
        while ((unsigned)__builtin_amdgcn_readfirstlane(__hip_atomic_load(sx.cnt + 64 * rg, __ATOMIC_RELAXED, __HIP_MEMORY_SCOPE_AGENT)) < 32u) {
            __builtin_amdgcn_s_sleep(2);
            if ((++sp & 1023u) == 0u) { if (__hip_atomic_load(sx.tmo, __ATOMIC_RELAXED, __HIP_MEMORY_SCOPE_AGENT) != 0u) break; if (sp > (1u << 22)) { if (lane == 0) __hip_atomic_store(sx.tmo, 1u, __ATOMIC_RELAXED, __HIP_MEMORY_SCOPE_AGENT); break; } } }
        }
    __syncthreads();
    float tot = 0.f;
    { const unsigned* slot = sx.xbuf + (size_t)rl * 32;
#pragma unroll
      for (int k = 0; k < 32; ++k) tot += __uint_as_float(__hip_atomic_load(slot + k, __ATOMIC_RELAXED, __HIP_MEMORY_SCOPE_AGENT)); }
    const f32x2 val = *(const LAS f32x2*)(lds + STASH_OFF + tid * 8);
    const float rs = 1.f / sqrtf(tot * (1.f / D) + EPS);
    const float x0 = bs[0] + val[0] * rs * gv[0], x1 = bs[1] + val[1] * rs * gv[1];
    *(GAS f32x2*)(Y + (size_t)rl * D + col) = (f32x2){x0, x1};
    if (!FINAL) {
        *(GAS unsigned*)(X + (size_t)rl * D + col) = pk2(x0, x1);
        float q = x0 * x0 + x1 * x1;
        q += __shfl_xor(q, 1); q += __shfl_xor(q, 2); q += __shfl_xor(q, 4); q += __shfl_xor(q, 8);
        if ((tid & 15) == 0) sx.rsp[(size_t)rl * 32 + cp] = q;
    }
    __syncthreads();
}
template <int KCH, bool FINAL>
__device__ __forceinline__ void sample_fused_piece(LAS unsigned char* lds, const bf16* A, int K, const bf16* Bt, const float* base, const float* g, float* Y, bf16* X, const SampleX& sx, int p, int wave, int lane, int tid) {
    sample_fused_A<KCH>(lds, A, K, Bt, sx, p, wave, lane, tid);
    sample_fused_B<FINAL>(lds, base, g, Y, X, sx, p, wave, lane, tid);
}

__global__ void __launch_bounds__(NWAVES * 64, 2) enc_fwd(Args args) {
    extern __shared__ __attribute__((aligned(16))) unsigned char lds_raw[];
    LAS unsigned char* lds = (LAS unsigned char*)lds_raw;
    volatile LAS unsigned* MISC = (volatile LAS unsigned*)(lds + MISC_OFF);
    const int tid = threadIdx.x, lane = tid & 63, wave = __builtin_amdgcn_readfirstlane(tid >> 6);
    const int G = gridDim.x; const int bx = blockIdx.x; const int vcu = (G % 8 == 0) ? (bx % 8) * (G / 8) + bx / 8 : bx;
    const int gw = vcu * NWAVES + wave, NGW = G * NWAVES;
    unsigned char* ws = args.ws;
    unsigned* ctl = (unsigned*)(ws + WS_CTL);
    for (int u = tid; u < (LDS_BYTES - LDSCTL_OFF) / 4; u += NWAVES * 64) ((LAS unsigned*)(lds + LDSCTL_OFF))[u] = 0u;
    __syncthreads();
    XcdBarrier bar = xcd_barrier_post(ctl + CW_BAR, MISC + 8);
#define GRID_BAR() do { xcd_arrive(bar); xcd_wait(bar); } while (0)
    if (tid == 0) { unsigned* gp = ctl + CW_BAR + XB_GRP(bx & 7); const unsigned me = bar.x + 1u;
        const unsigned prev = atomicCAS(gp, 0u, me);
        if (prev != 0u && prev != me) __hip_atomic_store(ctl + CW_BAR + XB_MIS, 1u, __ATOMIC_RELAXED, __HIP_MEMORY_SCOPE_AGENT); }
    bf16* XN = (bf16*)(ws + WS_XN);
    float* Y = args.out + OUT_Y;

    p0_prologue(args, lds, gw, NGW, wave, lane);
    GRID_BAR();

    const bool localok = G == 256 && __hip_atomic_load(ctl + CW_BAR + XB_MIS, __ATOMIC_RELAXED, __HIP_MEMORY_SCOPE_AGENT) == 0u;
#define LOCAL_BAR() do { if (localok) xcd_local_barrier(bar); else GRID_BAR(); } while (0)
    if (bx & 1) for (int p = bx; p < 256; p += G) sample_gemm1_piece(args, lds, p, wave, lane, tid);
    { pg8::Gemm g{XN, (const bf16*)(ws + WS_WIN), MP, NIN, D}; pg8::StaticOrder S; S.init(MP, NIN, G, bx);
      pg8::Epi1 E{(bf16*)(ws + WS_P1), args.out + OUT_POOL_P, args.out + OUT_CONV_P, args.out + OUT_POOL_S, args.out + OUT_CONV_S};
      pg8::gemm_phase<pg8::Epi1, pg8::StaticOrder, true, true>(lds, g, S, E); }
    if (!(bx & 1)) for (int p = bx; p < 256; p += G) sample_gemm1_piece(args, lds, p, wave, lane, tid);
    GRID_BAR();

    if (bx < 32 && G > 32) {
      pg8::Gemm g{(const bf16*)(ws + WS_MN), (const bf16*)(ws + WS_WKV), 1024, 2048, D}; pg8::StaticOrder S; S.init(1024, 2048, 32, bx);
      pg8::EpiKV E{args.out + OUT_MK, args.out + OUT_MV, (bf16*)(ws + WS_KB), (bf16*)(ws + WS_VT)};
      pg8::gemm_phase<pg8::EpiKV, pg8::StaticOrder, true, true>(lds, g, S, E);
    } else {
      const int gw2 = (bx - 32) * NWAVES + wave, NGW2 = (G - 32) * NWAVES;
      if (G == 256) mixer_all(args, lds, bx & 7, (bx - 32) >> 3, 28, wave, lane);
      else mixer_all(args, lds, -1, bx - 32, G - 32, wave, lane);
      if (G == 256) { const int lw = ((bx - 32) >> 3) * NWAVES + wave, xg = bx & 7, NV = (180 + 2 * 44) * 8;
          if (lw < 180) p2_late(args, lds, lw * 8 + xg, NV, wave, lane);
          else { p2_late(args, lds, (180 + 2 * (lw - 180)) * 8 + xg, NV, wave, lane); p2_late(args, lds, (181 + 2 * (lw - 180)) * 8 + xg, NV, wave, lane); } }
      else { __syncthreads(); p2_late(args, lds, gw2, NGW2, wave, lane); }
    }
    GRID_BAR();

    bf16* SQO = (bf16*)(ws + WS_SQO) - (size_t)MP * D; bf16* SAO = (bf16*)(ws + WS_SAO) - (size_t)MP * D; bf16* SHID = (bf16*)(ws + WS_SHID) - (size_t)MP * FF;
    unsigned* tmo = ctl + CW_TMO;
    float* Ys = Y + (size_t)MP * D; bf16* XNs = XN + (size_t)MP * D;
    const SampleX sx0{(unsigned*)(ws + WS_SXB), ctl + CW_SSEAM, (float*)(ws + WS_SRSP), tmo};
    const SampleX sx1{(unsigned*)(ws + WS_SXB + 32768), ctl + CW_SSEAM + 512, (float*)(ws + WS_SRSP + 32768), tmo};
    const SampleX sx2{(unsigned*)(ws + WS_SXB + 65536), ctl + CW_SSEAM + 1024, nullptr, tmo};

    { pg8::Gemm g{(const bf16*)(ws + WS_MRG), (const bf16*)(ws + WS_WOUT), MP, D, D}; pg8::StaticOrder S; S.init(MP, D, G, bx);
      pg8::EpiRes<1> E{(const float*)(ws + WS_RNORM), XN, nullptr, args.in[15], (unsigned*)(ws + WS_XB1), ctl + CW_SEAM, (float*)(ws + WS_RSP1), tmo};
      if (G == 256) sample_fused_A<8>(lds, (const bf16*)(ws + WS_MRG), D, (const bf16*)(ws + WS_WOUT), sx0, bx, wave, lane, tid);
      pg8::gemm_phase<pg8::EpiRes<1>, pg8::StaticOrder, false, true>(lds, g, S, E); }
    if (G == 256) sample_fused_B<false>(lds, args.in[1], args.in[15], Ys, XNs, sx0, bx, wave, lane, tid);
    else for (int p = bx; p < 256; p += G) sample_fused_piece<8, false>(lds, (const bf16*)(ws + WS_MRG), D, (const bf16*)(ws + WS_WOUT), args.in[1], args.in[15], Ys, XNs, sx0, p, wave, lane, tid);
    LOCAL_BAR();
    if (bx & 1) for (int p = bx; p < 256; p += G) sample_gemm_piece<1, 8, 1>(lds, XN, D, (const bf16*)(ws + WS_WQ), SQO, D, sx0.rsp, p, wave, lane, tid);
    { pg8::Gemm g{XN, (const bf16*)(ws + WS_WQ), MP, D, D}; pg8::StaticOrder S; S.init(MP, D, G, bx);
      pg8::EpiBf16S<0, false> E{(bf16*)(ws + WS_QO), D, (const float*)(ws + WS_RSP1), nullptr};
      pg8::gemm_phase<pg8::EpiBf16S<0, false>, pg8::StaticOrder, true, true>(lds, g, S, E); }
    if (!(bx & 1)) for (int p = bx; p < 256; p += G) sample_gemm_piece<1, 8, 1>(lds, XN, D, (const bf16*)(ws + WS_WQ), SQO, D, sx0.rsp, p, wave, lane, tid);
    LOCAL_BAR();
    { const bf16* QO = (const bf16*)(ws + WS_QO); bf16* AO = (bf16*)(ws + WS_AO);
      pg8::StaticOrder SA; SA.init(MP, D, G, bx); pg8::Unit au;
      for (int i = 0; SA.next(i, au); ++i) {
          const int hd = au.pn, b = au.pm >> 4; const size_t qb = (size_t)(au.pm * 256 + wave * 32) * D + hd * 256;
          int ln = lane; asm volatile("" : "+v"(ln));
          attn_unit(lds, QO + qb, AO + qb, (unsigned)(ln & 31) * 2048u, (const bf16*)(ws + WS_KB) + (size_t)b * 256 * 1024 + hd * 256, (const bf16*)(ws + WS_VT) + (size_t)(b * 4 + hd) * 65536, true, wave, ln);
      } }
    if (G == 256 && bx >= 64) { int ln = lane; asm volatile("" : "+v"(ln));
        p0_items(args, (LAS float*)(lds + wave * 16384), DN_LO, DN_HI, (bx - 64) * NWAVES + wave, 192 * NWAVES, ln); }
    else if (G != 256) { int ln = lane; asm volatile("" : "+v"(ln)); p0_items(args, (LAS float*)(lds + wave * 16384), DN_LO, DN_HI, gw, NGW, ln); }
    for (int u = bx; u < 64; u += G) {
        const int sb = 2 * (u & 7) + (u >> 5), hd = (u >> 3) & 3; const size_t qb = (size_t)(MP + sb * 16) * D + hd * 256;
        attn_unit_small(lds, SQO + qb, SAO + qb, (const bf16*)(ws + WS_KBS) + (size_t)sb * 256 * 1024 + hd * 256, (const bf16*)(ws + WS_VTS) + (size_t)(sb * 4 + hd) * 65536, wave, lane);
    }
    GRID_BAR();
    { pg8::Gemm g{(const bf16*)(ws + WS_AO), (const bf16*)(ws + WS_WCO), MP, D, D}; pg8::StaticOrder S; S.init(MP, D, G, bx);
      pg8::EpiRes<2> E{nullptr, XN, nullptr, args.in[22], (unsigned*)(ws + WS_XB2), ctl + CW_SEAM + 4096, (float*)(ws + WS_RSP2), tmo};
      if (G == 256) sample_fused_A<8>(lds, SAO, D, (const bf16*)(ws + WS_WCO), sx1, bx, wave, lane, tid);
      pg8::gemm_phase<pg8::EpiRes<2>, pg8::StaticOrder, false, true>(lds, g, S, E); }
    if (G == 256) sample_fused_B<false>(lds, Ys, args.in[22], Ys, XNs, sx1, bx, wave, lane, tid);
    else for (int p = bx; p < 256; p += G) sample_fused_piece<8, false>(lds, SAO, D, (const bf16*)(ws + WS_WCO), Ys, args.in[22], Ys, XNs, sx1, p, wave, lane, tid);
    LOCAL_BAR();
    if (bx & 1) for (int p = bx; p < 256; p += G) sample_gemm_piece<4, 8, 2>(lds, XN, D, (const bf16*)(ws + WS_WUP), SHID, FF, sx1.rsp, p, wave, lane, tid);
    { pg8::Gemm g{XN, (const bf16*)(ws + WS_WUP), MP, FF, D}; pg8::StaticOrder S; S.init(MP, FF, G, bx);
      LAS float* rstab = (LAS float*)(lds + RSTAB_OFF);
      { pg8::Unit u0; if (S.next(0, u0) && tid < 256) { const f32x4 p = *(const GAS f32x4*)((const float*)(ws + WS_RSP2) + (size_t)(u0.pm * 256 + tid) * 4);
            rstab[tid] = 1.0f / sqrtf(((p[0] + p[1]) + (p[2] + p[3])) * (1.0f / 1024.0f) + EPS); } }
      __syncthreads();
      pg8::EpiBf16S<1, true> E{(bf16*)(ws + WS_HID), FF, (const float*)(ws + WS_RSP2), rstab};
      pg8::gemm_phase<pg8::EpiBf16S<1, true>, pg8::StaticOrder, true, true>(lds, g, S, E); }
    if (!(bx & 1)) for (int p = bx; p < 256; p += G) sample_gemm_piece<4, 8, 2>(lds, XN, D, (const bf16*)(ws + WS_WUP), SHID, FF, sx1.rsp, p, wave, lane, tid);
    LOCAL_BAR();
    { pg8::Gemm g{(const bf16*)(ws + WS_HID), (const bf16*)(ws + WS_WDOWN), MP, D, FF}; pg8::StaticOrder S; S.init(MP, D, G, bx);
      pg8::EpiRes<3> E{nullptr, XN, Y, args.in[26], (unsigned*)(ws + WS_XB3), ctl + CW_SEAM + 8192, nullptr, tmo};
      if (G == 256 && (bx & 1)) sample_fused_A<32>(lds, SHID, FF, (const bf16*)(ws + WS_WDOWN), sx2, bx, wave, lane, tid);
      pg8::gemm_phase<pg8::EpiRes<3>, pg8::StaticOrder, false, true>(lds, g, S, E); }
    if (G == 256 && !(bx & 1)) { __syncthreads(); sample_fused_A<32>(lds, SHID, FF, (const bf16*)(ws + WS_WDOWN), sx2, bx, wave, lane, tid); }
    if (G == 256) sample_fused_B<true>(lds, Ys, args.in[26], Ys, nullptr, sx2, bx, wave, lane, tid);
    else for (int p = bx; p < 256; p += G) sample_fused_piece<32, true>(lds, SHID, FF, (const bf16*)(ws + WS_WDOWN), Ys, args.in[26], Ys, nullptr, sx2, p, wave, lane, tid);
}

extern "C" void kernel_launch(void* const* d_in, const int* in_sizes, int n_in, void* d_out, int out_size, void* d_ws, size_t ws_size, hipStream_t stream) {
    static int grid = 0;
    if (grid == 0) {
        if (n_in != 27 || (size_t)out_size != OUT_TOTAL || ws_size < WS_END) { fprintf(stderr, "kernel_launch: unexpected sizes n_in %d out %d ws %zu\n", n_in, out_size, ws_size); grid = -1; return; }
        int dev = 0, cus = 0, per_cu = 0;
        if (hipGetDevice(&dev) != hipSuccess || hipDeviceGetAttribute(&cus, hipDeviceAttributeMultiprocessorCount, dev) != hipSuccess) { grid = -1; return; }
        if (hipFuncSetAttribute((const void*)enc_fwd, hipFuncAttributeMaxDynamicSharedMemorySize, LDS_BYTES) != hipSuccess) { fprintf(stderr, "kernel_launch: hipFuncSetAttribute failed\n"); grid = -1; return; }
        if (hipOccupancyMaxActiveBlocksPerMultiprocessor(&per_cu, (const void*)enc_fwd, NWAVES * 64, LDS_BYTES) != hipSuccess || per_cu < 1) { fprintf(stderr, "kernel_launch: occupancy query says %d blocks/CU\n", per_cu); per_cu = 1; }
        (void)hipGetLastError();
        grid = cus;
    }
    if (grid < 0) return;
    (void)hipMemsetAsync((char*)d_ws + WS_CTL, 0, CTL_ZERO_BYTES, stream);
    Args a{};
    for (int i = 0; i < 27; ++i) a.in[i] = (const float*)d_in[i];
    a.out = (float*)d_out; a.ws = (unsigned char*)d_ws;
    hipLaunchKernelGGL(enc_fwd, dim3(grid), dim3(NWAVES * 64), LDS_BYTES, stream, a);
}
```

```cpp
#include <hip/hip_runtime.h>
#include <cstdio>
#include <cstdint>

namespace pg8 {
#define PG8_LAS __attribute__((address_space(3)))
typedef unsigned short bf16_t;
typedef short bf16x8 __attribute__((ext_vector_type(8)));
typedef float f32x4 __attribute__((ext_vector_type(4)));
typedef unsigned u32x4 __attribute__((ext_vector_type(4)));
typedef unsigned u32x2 __attribute__((ext_vector_type(2)));
constexpr int BM = 256, BK = 64, HALF = 128, HTB = HALF * BK * 2  , STAGE_BYTES = 8 * HTB, NXCD = 8, WGM = 8;

__host__ __device__ __forceinline__ int lds_byte(int r, int c) { const int st = (r >> 4) * 2 + (c >> 5), rr = r & 15, cc = c & 31, ob = rr * 64 + cc * 2; return st * 1024 + (ob ^ (((ob >> 9) & 1) << 5)); }
__host__ __device__ __forceinline__ void stage_rc(int b, int& R, int& C) { const int st = b / 1024, sb = b % 1024, swz = sb ^ (((sb >> 9) & 1) << 5); R = (st >> 1) * 16 + swz / 64; C = (st & 1) * 32 + (swz % 64) / 2; }
__host__ __device__ __forceinline__ int perm32(int rho) { const int n = rho >> 4, i = rho & 15; return 8 * (i >> 2) + 4 * n + (i & 3); }

struct Unit { int pm, pn; };
struct Gemm { const bf16_t* A; const bf16_t* Bt; int M, N, K; };

struct StaticOrder {
    int nM, nN, nwg, G, c;
    __host__ __device__ void init(int M, int N, int G_, int c_) { nM = M / BM; nN = N / BM; nwg = nM * nN; G = G_; c = c_; }
    __host__ __device__ __forceinline__ bool next(int i, Unit& u) const {
        const long L = (long)i * G + c; if (L >= nwg) return false;
        int wgid = (int)L; { const int q = nwg / NXCD, r = nwg % NXCD, xcd = wgid % NXCD, off = wgid / NXCD; wgid = (xcd < r ? xcd * (q + 1) : r * (q + 1) + (xcd - r) * q) + off; }
        const int nig = WGM * nN, gid = wgid / nig, fm = gid * WGM, gsz = (nM - fm) < WGM ? (nM - fm) : WGM;
        u.pm = fm + ((wgid % nig) % gsz); u.pn = (wgid % nig) / gsz; return true;
    }
    __device__ __forceinline__ void a_ready(const Unit&) const {}
    __device__ __forceinline__ void done(const Unit&) const {}
};

__device__ __forceinline__ unsigned cvt_pk_bf16(float lo, float hi) { unsigned r; asm volatile("v_cvt_pk_bf16_f32 %0, %1, %2" : "=v"(r) : "v"(lo), "v"(hi)); return r; }

struct EpiF32 {
    static constexpr bool PERM = false, AFTER_DRAIN = false;
    float* C; int ldc;
    __device__ __forceinline__ void operator()(const f32x4 (&acc)[2][2][4][2], const Unit& u, int wr, int wc, int fr, int fq) const {
        const int row0 = u.pm * BM + wr * 64 + fr, col0 = u.pn * BM + wc * 32 + 4 * fq;
#pragma unroll
        for (int ai = 0; ai < 2; ++ai)
#pragma unroll
            for (int m = 0; m < 4; ++m) { float* rowp = C + (size_t)(row0 + ai * HALF + m * 16) * ldc + col0;
#pragma unroll
                for (int bj = 0; bj < 2; ++bj)
#pragma unroll
                    for (int n = 0; n < 2; ++n) *(f32x4*)(rowp + bj * HALF + n * 16) = acc[ai][bj][m][n]; }
    }
};
template <int ACT> struct EpiBf16 {
    static constexpr bool PERM = true, AFTER_DRAIN = false;
    bf16_t* O; int ldc;
    __device__ __forceinline__ void operator()(const f32x4 (&acc)[2][2][4][2], const Unit& u, int wr, int wc, int fr, int fq) const {
        const int row0 = u.pm * BM + wr * 64 + fr, col0 = u.pn * BM + wc * 32 + 8 * fq;
#pragma unroll
        for (int ai = 0; ai < 2; ++ai)
#pragma unroll
            for (int m = 0; m < 4; ++m) { bf16_t* rowp = O + (size_t)(row0 + ai * HALF + m * 16) * ldc + col0;
#pragma unroll
                for (int bj = 0; bj < 2; ++bj) { f32x4 v0 = acc[ai][bj][m][0], v1 = acc[ai][bj][m][1];
                    if (ACT == 1) {
#pragma unroll
                        for (int j = 0; j < 4; ++j) { const float a = fmaxf(v0[j], 0.f), b = fmaxf(v1[j], 0.f); v0[j] = a * a; v1[j] = b * b; } }
                    u32x4 w; w.x = cvt_pk_bf16(v0[0], v0[1]); w.y = cvt_pk_bf16(v0[2], v0[3]); w.z = cvt_pk_bf16(v1[0], v1[1]); w.w = cvt_pk_bf16(v1[2], v1[3]);
                    *(u32x4*)(rowp + bj * HALF) = w; } }
    }
};
struct Epi1 {
    static constexpr bool PERM = true, AFTER_DRAIN = false;
    bf16_t* P1; float* pool_p; float* conv_p; float* pool_s; float* conv_s;
    __device__ __forceinline__ void operator()(const f32x4 (&acc)[2][2][4][2], const Unit& u, int wr, int wc, int fr, int fq) const {
        const int row0 = u.pm * BM + wr * 64 + fr;
        const bool sample = (u.pm == 64), tailp = ((u.pm & 15) == 15) && !sample;
        if (u.pn < 4) {
            const int col0 = u.pn * BM + wc * 32 + 8 * fq;
#pragma unroll
            for (int ai = 0; ai < 2; ++ai)
#pragma unroll
                for (int m = 0; m < 4; ++m) { const int row = row0 + ai * HALF + m * 16; bf16_t* rowp = P1 + (size_t)row * 1536 + col0;
#pragma unroll
                    for (int bj = 0; bj < 2; ++bj) { const f32x4 v0 = acc[ai][bj][m][0], v1 = acc[ai][bj][m][1];
                        u32x4 w; w.x = cvt_pk_bf16(v0[0], v0[1]); w.y = cvt_pk_bf16(v0[2], v0[3]); w.z = cvt_pk_bf16(v1[0], v1[1]); w.w = cvt_pk_bf16(v1[2], v1[3]);
                        *(u32x4*)(rowp + bj * HALF) = w;
                        if (u.pn < 2) {
                            float* dst = nullptr;
                            if (sample) { const int t = row & 15, sb = (row >> 4) & 15; if (t >= 1) dst = pool_s + ((size_t)(sb * 15 + t - 1) * 512 + col0 + bj * HALF); }
                            else if (tailp) { const int t = row & 4095, b = row >> 12; if (t >= 4081) dst = pool_p + ((size_t)(b * 15 + t - 4081) * 512 + col0 + bj * HALF); }
                            if (dst) { *(f32x4*)dst = v0; *(f32x4*)(dst + 4) = v1; }
                        } } }
        } else {
            const int ch0 = (u.pn - 4) * 128 + wc * 32 + 8 * fq;
#pragma unroll
            for (int ai = 0; ai < 2; ++ai)
#pragma unroll
                for (int m = 0; m < 4; ++m) { const int row = row0 + ai * HALF + m * 16;
                    const f32x4 v0 = acc[ai][0][m][0] * acc[ai][1][m][0], v1 = acc[ai][0][m][1] * acc[ai][1][m][1];
                    u32x4 w; w.x = cvt_pk_bf16(v0[0], v0[1]); w.y = cvt_pk_bf16(v0[2], v0[3]); w.z = cvt_pk_bf16(v1[0], v1[1]); w.w = cvt_pk_bf16(v1[2], v1[3]);
                    *(u32x4*)(P1 + (size_t)row * 1536 + 1024 + ch0) = w;
                    float* dst = nullptr;
                    if (sample) { const int t = row & 15, sb = (row >> 4) & 15; if (t >= 14) dst = conv_s + ((size_t)(sb * 2 + t - 14) * 512 + ch0); }
                    else if (tailp) { const int t = row & 4095, b = row >> 12; if (t >= 4094) dst = conv_p + ((size_t)(b * 2 + t - 4094) * 512 + ch0); }
                    if (dst) { *(f32x4*)dst = v0; *(f32x4*)(dst + 4) = v1; } }
        }
    }
};
struct EpiKV {
    static constexpr bool PERM = false, AFTER_DRAIN = false;
    float* outK; float* outV; bf16_t* KB; bf16_t* VT;
    __device__ __forceinline__ void operator()(const f32x4 (&acc)[2][2][4][2], const Unit& u, int wr, int wc, int fr, int fq) const {
        const int row0 = u.pm * BM + wr * 64 + fr;
        if (u.pn < 4) {
            const int col0 = u.pn * BM + wc * 32 + 4 * fq;
#pragma unroll
            for (int ai = 0; ai < 2; ++ai)
#pragma unroll
                for (int m = 0; m < 4; ++m) { const size_t off = (size_t)(row0 + ai * HALF + m * 16) * 1024 + col0;
#pragma unroll
                    for (int bj = 0; bj < 2; ++bj)
#pragma unroll
                        for (int n = 0; n < 2; ++n) { const f32x4 v = acc[ai][bj][m][n]; __builtin_nontemporal_store(v, (f32x4*)(outK + off + bj * HALF + n * 16));
                            u32x2 w; w.x = cvt_pk_bf16(v[0], v[1]); w.y = cvt_pk_bf16(v[2], v[3]); *(u32x2*)(KB + off + bj * HALF + n * 16) = w; } }
        } else {
            const int h = u.pn - 4, e0 = wc * 32 + 4 * fq;
            bf16_t* vt = VT + (size_t)(u.pm * 4 + h) * 65536;
#pragma unroll
            for (int ai = 0; ai < 2; ++ai)
#pragma unroll
                for (int m = 0; m < 4; ++m) { const int mrow = wr * 64 + fr + ai * HALF + m * 16;
                    const int pos = (mrow & ~12) | ((mrow & 4) << 1) | ((mrow & 8) >> 1);
                    const size_t off = (size_t)(u.pm * BM + mrow) * 1024 + h * 256 + e0;
#pragma unroll
                    for (int bj = 0; bj < 2; ++bj)
#pragma unroll
                        for (int n = 0; n < 2; ++n) { const f32x4 v = acc[ai][bj][m][n]; __builtin_nontemporal_store(v, (f32x4*)(outV + off + bj * HALF + n * 16));
                            const unsigned w0 = cvt_pk_bf16(v[0], v[1]), w1 = cvt_pk_bf16(v[2], v[3]); const int e = e0 + bj * HALF + n * 16;
                            vt[(size_t)(e + 0) * 256 + pos] = (bf16_t)(w0 & 0xffffu); vt[(size_t)(e + 1) * 256 + pos] = (bf16_t)(w0 >> 16);
                            vt[(size_t)(e + 2) * 256 + pos] = (bf16_t)(w1 & 0xffffu); vt[(size_t)(e + 3) * 256 + pos] = (bf16_t)(w1 >> 16); } }
        }
    }
};


template <int ACT, bool TAB> struct EpiBf16S {
    static constexpr bool PERM = true, AFTER_DRAIN = false;
    bf16_t* O; int ldc; const float* rsp; const PG8_LAS float* rstab;
    __device__ __forceinline__ void operator()(const f32x4 (&acc)[2][2][4][2], const Unit& u, int wr, int wc, int fr, int fq) const {
        const int row0 = u.pm * BM + wr * 64 + fr, col0 = u.pn * BM + wc * 32 + 8 * fq;
#pragma unroll
        for (int ai = 0; ai < 2; ++ai)
#pragma unroll
            for (int m = 0; m < 4; ++m) { const int row = row0 + ai * HALF + m * 16; bf16_t* rowp = O + (size_t)row * ldc + col0;
                float rs;
                if (TAB) rs = rstab[wr * 64 + fr + ai * HALF + m * 16];
                else { const f32x4 p = *(const f32x4*)(rsp + (size_t)row * 4); rs = 1.0f / sqrtf(((p[0] + p[1]) + (p[2] + p[3])) * (1.0f / 1024.0f) + 1e-6f); }
#pragma unroll
                for (int bj = 0; bj < 2; ++bj) { f32x4 v0 = acc[ai][bj][m][0] * rs, v1 = acc[ai][bj][m][1] * rs;
                    if (ACT == 1) {
#pragma unroll
                        for (int j = 0; j < 4; ++j) { const float a = fmaxf(v0[j], 0.f), b = fmaxf(v1[j], 0.f); v0[j] = a * a; v1[j] = b * b; } }
                    u32x4 w; w.x = cvt_pk_bf16(v0[0], v0[1]); w.y = cvt_pk_bf16(v0[2], v0[3]); w.z = cvt_pk_bf16(v1[0], v1[1]); w.w = cvt_pk_bf16(v1[2], v1[3]);
                    *(u32x4*)(rowp + bj * HALF) = w; } }
    }
};

template <int MODE> struct EpiRes {
    static constexpr bool PERM = true, AFTER_DRAIN = true;
    const float* basef; bf16_t* X; float* outf; const float* g; unsigned* xbuf; unsigned* cnt; float* rsp; unsigned* tmo;
    __device__ __forceinline__ void fused(f32x4 (&acc)[2][2][4][2], const Unit& u, int wr, int wc, int fr, int fq, PG8_LAS unsigned char* lds, int wid, int lane) const {
        PG8_LAS float* P = (PG8_LAS float*)lds;
        PG8_LAS float* S = (PG8_LAS float*)(lds + 4096);
        PG8_LAS float* R = (PG8_LAS float*)(lds + 5120);
        const int col0 = u.pn * BM + wc * 32 + 8 * fq;
        u32x4 pre[4][2][1];
#pragma unroll
        for (int m = 0; m < 4; ++m) { const size_t off = (size_t)(u.pm * BM + wr * 64 + m * 16 + fr) * 1024 + col0;
#pragma unroll
            for (int bj = 0; bj < 2; ++bj) {
                pre[m][bj][0] = *(const u32x4*)(X + off + bj * HALF); } }
#pragma unroll
        for (int ai = 0; ai < 2; ++ai)
#pragma unroll
            for (int m = 0; m < 4; ++m) { float s = 0.f;
#pragma unroll
                for (int bj = 0; bj < 2; ++bj)
#pragma unroll
                    for (int n = 0; n < 2; ++n) { const f32x4 x = acc[ai][bj][m][n]; s += (x[0] * x[0] + x[1] * x[1]) + (x[2] * x[2] + x[3] * x[3]); }
                s += __shfl_xor(s, 16); s += __shfl_xor(s, 32);
                if (fq == 0) P[(ai * HALF + wr * 64 + m * 16 + fr) * 4 + wc] = s; }
        asm volatile("s_waitcnt lgkmcnt(0)" ::: "memory"); __builtin_amdgcn_s_barrier(); asm volatile("" ::: "memory");
        const int row = wid * 32 + (lane & 31);
        if (lane < 32) { const f32x4 p = *(const PG8_LAS f32x4*)(P + row * 4); const float t = (p[0] + p[1]) + (p[2] + p[3]);
            __hip_atomic_store(xbuf + (size_t)(u.pm * BM + row) * 4 + u.pn, __float_as_uint(t), __ATOMIC_RELAXED, __HIP_MEMORY_SCOPE_AGENT); }
        asm volatile("s_waitcnt vmcnt(0)" ::: "memory");
        if (lane == 0) __hip_atomic_fetch_add(cnt + 64 * u.pm, 1u, __ATOMIC_RELAXED, __HIP_MEMORY_SCOPE_AGENT);
        if (wid == 0) { unsigned sp = 0;
            while ((unsigned)__builtin_amdgcn_readfirstlane(__hip_atomic_load(cnt + 64 * u.pm, __ATOMIC_RELAXED, __HIP_MEMORY_SCOPE_AGENT)) < 32u) {
                __builtin_amdgcn_s_sleep(2);
                if ((++sp & 1023u) == 0u) { if (__hip_atomic_load(tmo, __ATOMIC_RELAXED, __HIP_MEMORY_SCOPE_AGENT) != 0u) break; if (sp > (1u << 22)) { if (lane == 0) __hip_atomic_store(tmo, 1u, __ATOMIC_RELAXED, __HIP_MEMORY_SCOPE_AGENT); break; } } }
            }
        asm volatile("s_waitcnt vmcnt(0) lgkmcnt(0)" ::: "memory"); __builtin_amdgcn_s_barrier(); asm volatile("" ::: "memory");
        if (lane < 32) { const unsigned* slot = xbuf + (size_t)(u.pm * BM + row) * 4; float t = 0.f;
#pragma unroll
            for (int k = 0; k < 4; ++k) t += __uint_as_float(__hip_atomic_load(slot + k, __ATOMIC_RELAXED, __HIP_MEMORY_SCOPE_AGENT));
            S[row] = 1.0f / sqrtf(t * (1.0f / 1024.0f) + 1e-6f);
            if (MODE == 1) R[row] = basef[u.pm * BM + row]; }
        asm volatile("s_waitcnt lgkmcnt(0)" ::: "memory"); __builtin_amdgcn_s_barrier(); asm volatile("" ::: "memory");
        f32x4 gv[2][2];
#pragma unroll
        for (int bj = 0; bj < 2; ++bj)
#pragma unroll
            for (int n = 0; n < 2; ++n) gv[bj][n] = *(const f32x4*)(g + col0 + bj * HALF + 4 * n);
#pragma unroll
        for (int ai = 0; ai < 2; ++ai)
#pragma unroll
            for (int m = 0; m < 4; ++m) { const int r = ai * HALF + wr * 64 + m * 16 + fr; const float sr = S[r], rn = MODE == 1 ? R[r] : 1.f; const size_t off = (size_t)(u.pm * BM + r) * 1024 + col0; float q = 0.f;
#pragma unroll
                for (int bj = 0; bj < 2; ++bj) { f32x4 b0, b1;
                    { const u32x4 w = ai == 0 ? pre[m][bj][0] : *(const u32x4*)(X + off + bj * HALF);
                        b0 = (f32x4){__uint_as_float(w.x << 16), __uint_as_float(w.x & 0xffff0000u), __uint_as_float(w.y << 16), __uint_as_float(w.y & 0xffff0000u)};
                        b1 = (f32x4){__uint_as_float(w.z << 16), __uint_as_float(w.z & 0xffff0000u), __uint_as_float(w.w << 16), __uint_as_float(w.w & 0xffff0000u)};
                        if (MODE == 1) { b0 = b0 * rn; b1 = b1 * rn; } }
                    const f32x4 v0 = b0 + acc[ai][bj][m][0] * sr * gv[bj][0], v1 = b1 + acc[ai][bj][m][1] * sr * gv[bj][1];
                    if (MODE == 3) { __builtin_nontemporal_store(v0, (f32x4*)(outf + off + bj * HALF)); __builtin_nontemporal_store(v1, (f32x4*)(outf + off + bj * HALF + 4)); }
                    else { q += ((v0[0] * v0[0] + v0[1] * v0[1]) + (v0[2] * v0[2] + v0[3] * v0[3])) + ((v1[0] * v1[0] + v1[1] * v1[1]) + (v1[2] * v1[2] + v1[3] * v1[3]));
                        u32x4 w; w.x = cvt_pk_bf16(v0[0], v0[1]); w.y = cvt_pk_bf16(v0[2], v0[3]); w.z = cvt_pk_bf16(v1[0], v1[1]); w.w = cvt_pk_bf16(v1[2], v1[3]);
                        *(u32x4*)(X + off + bj * HALF) = w; } }
                if (MODE != 3) { q += __shfl_xor(q, 16); q += __shfl_xor(q, 32); if (fq == 0) P[r * 4 + wc] = q; }
                if (m & 1) asm volatile("" ::: "memory"); }
        if (MODE != 3) {
            asm volatile("s_waitcnt lgkmcnt(0)" ::: "memory"); __builtin_amdgcn_s_barrier(); asm volatile("" ::: "memory");
            if (lane < 32) { const f32x4 p = *(const PG8_LAS f32x4*)(P + row * 4); rsp[(size_t)(u.pm * BM + row) * 4 + u.pn] = (p[0] + p[1]) + (p[2] + p[3]); }
        }
    }
};

template <class Epi, class Sched, bool ALIGN_EPI = false, bool SP2 = false>
__device__ __forceinline__ void gemm_phase(PG8_LAS unsigned char* lds, const Gemm g, const Sched& S, const Epi& E) {
    int tid_ = threadIdx.x; asm volatile("" : "+v"(tid_));
    const int tid = tid_, wid = __builtin_amdgcn_readfirstlane(tid >> 6), lane = tid & 63, wr = wid >> 2, wc = wid & 3, fr = lane & 15, fq = lane >> 4;
    const int K = g.K, nt = K / BK;
    unsigned voffA[2], voffB[2];
#pragma unroll
    for (int i = 0; i < 2; ++i) { int R, C; stage_rc(tid * 16 + i * 8192, R, C); const int Rb = Epi::PERM ? ((R & ~31) + perm32(R & 31)) : R;
        voffA[i] = (unsigned)(R * K + C) * 2u; voffB[i] = (unsigned)(Rb * K + C) * 2u; }
    const size_t kstep = (size_t)(BK * 2);
    const size_t hstep = (size_t)HALF * K * 2;
    const size_t tstep = 2 * hstep;
    const unsigned ldsw = (unsigned)wid * 1024u;
    const int aoff = lds_byte(wr * 64 + fr, fq * 8), boff = lds_byte(wc * 32 + fr, fq * 8);
#define PG8_SA(b, h) (((b) * 2 + (h)) * HTB)
#define PG8_SB(b, h) ((4 + (b) * 2 + (h)) * HTB)
#define PG8_STAGE(bufoff, gbase, voff) do { _Pragma("unroll") for (int _i = 0; _i < 2; ++_i) \
        __builtin_amdgcn_global_load_lds((const unsigned*)((const char*)(gbase) + (voff)[_i]), (PG8_LAS unsigned*)(lds + (bufoff) + ldsw + _i * 8192), 16, 0, 0); } while (0)
#define PG8_LDA(dst, b, h) do { _Pragma("unroll") for (int m = 0; m < 4; ++m) _Pragma("unroll") for (int k = 0; k < 2; ++k) dst[m][k] = *(const PG8_LAS bf16x8*)(lds + PG8_SA(b, h) + aoff + m * 2048 + k * 1024); } while (0)
#define PG8_LDB(dst, b, h) do { _Pragma("unroll") for (int n = 0; n < 2; ++n) _Pragma("unroll") for (int k = 0; k < 2; ++k) dst[n][k] = *(const PG8_LAS bf16x8*)(lds + PG8_SB(b, h) + boff + n * 2048 + k * 1024); } while (0)
#define PG8_MMA(ai, bj, At, Bt) do { __builtin_amdgcn_s_setprio(1); _Pragma("unroll") for (int m = 0; m < 4; ++m) _Pragma("unroll") for (int n = 0; n < 2; ++n) _Pragma("unroll") for (int k = 0; k < 2; ++k) \
        acc[ai][bj][m][n] = __builtin_amdgcn_mfma_f32_16x16x32_bf16(Bt[n][k], At[m][k], acc[ai][bj][m][n], 0, 0, 0); __builtin_amdgcn_s_setprio(0); } while (0)
#define PG8_WAIT_V(n) asm volatile("s_waitcnt vmcnt(" #n ")" ::: "memory")
#define PG8_WAIT_L(n) asm volatile("s_waitcnt lgkmcnt(" #n ")" ::: "memory")
#define PG8_BAR __builtin_amdgcn_s_barrier()
#define PG8_SCHED __builtin_amdgcn_sched_barrier(0)
    Unit cur, nxt; int ui = 0;
    if (!S.next(0, cur)) return;
    f32x4 acc[2][2][4][2];
#pragma unroll
    for (int a = 0; a < 2; ++a)
#pragma unroll
        for (int b = 0; b < 2; ++b)
#pragma unroll
            for (int m = 0; m < 4; ++m)
#pragma unroll
                for (int n = 0; n < 2; ++n) acc[a][b][m][n] = (f32x4){0.f, 0.f, 0.f, 0.f};
    bf16x8 At[4][2], B0[2][2], B1[2][2];
    const char* cA = (const char*)g.A + (size_t)cur.pm * tstep; const char* cB = (const char*)g.Bt + (size_t)cur.pn * tstep;
    S.a_ready(cur);
    if constexpr (SP2) {
        PG8_STAGE(PG8_SB(0, 0), cB, voffB); PG8_STAGE(PG8_SB(0, 1), cB + hstep, voffB); PG8_STAGE(PG8_SA(0, 0), cA, voffA); PG8_STAGE(PG8_SA(0, 1), cA + hstep, voffA);
        if (wr == 1) PG8_BAR;
        PG8_WAIT_V(2); PG8_BAR;
        PG8_STAGE(PG8_SB(1, 0), cB + kstep, voffB); PG8_STAGE(PG8_SA(1, 0), cA + kstep, voffA); PG8_STAGE(PG8_SB(1, 1), cB + hstep + kstep, voffB);
        PG8_WAIT_V(6); PG8_BAR;
    } else {
        PG8_STAGE(PG8_SB(0, 0), cB, voffB); PG8_STAGE(PG8_SA(0, 0), cA, voffA); PG8_STAGE(PG8_SB(0, 1), cB + hstep, voffB); PG8_STAGE(PG8_SA(0, 1), cA + hstep, voffA);
        if (wr == 1) PG8_BAR;
        PG8_WAIT_V(4); PG8_BAR;
        PG8_STAGE(PG8_SB(1, 0), cB + kstep, voffB); PG8_STAGE(PG8_SA(1, 0), cA + kstep, voffA); PG8_STAGE(PG8_SB(1, 1), cB + hstep + kstep, voffB);
        PG8_WAIT_V(6); PG8_BAR;
    }
    for (;;) {
        const bool has_next = S.next(ui + 1, nxt);
        const char* nA = has_next ? (const char*)g.A + (size_t)nxt.pm * tstep : cA; const char* nB = has_next ? (const char*)g.Bt + (size_t)nxt.pn * tstep : cB;
        for (int t = 0; t < nt; t += 2) {
            const bool last = (t == nt - 2);
            const char* a1 = cA + (size_t)(t + 1) * kstep;
            const char* a2 = last ? nA : cA + (size_t)(t + 2) * kstep; const char* b2 = last ? nB : cB + (size_t)(t + 2) * kstep;
            const char* a3 = a2 + kstep; const char* b3 = b2 + kstep;
            if (last && has_next) S.a_ready(nxt);
            if constexpr (SP2) {
            PG8_LDB(B0, 0, 0); PG8_LDB(B1, 0, 1); PG8_SCHED; PG8_LDA(At, 0, 0); PG8_STAGE(PG8_SA(1, 1), a1 + hstep, voffA);
            PG8_WAIT_V(8); PG8_WAIT_L(0); PG8_BAR; PG8_MMA(0, 0, At, B0); PG8_MMA(0, 1, At, B1); PG8_BAR; PG8_SCHED;
            PG8_LDA(At, 0, 1); PG8_STAGE(PG8_SB(0, 0), b2, voffB); PG8_STAGE(PG8_SB(0, 1), b2 + hstep, voffB); PG8_STAGE(PG8_SA(0, 0), a2, voffA);
            PG8_WAIT_V(8); PG8_WAIT_L(0); PG8_BAR; PG8_MMA(1, 0, At, B0); PG8_MMA(1, 1, At, B1); PG8_BAR; PG8_SCHED;
            PG8_LDB(B0, 1, 0); PG8_LDB(B1, 1, 1); PG8_SCHED; PG8_LDA(At, 1, 0); PG8_STAGE(PG8_SA(0, 1), a2 + hstep, voffA);
            PG8_WAIT_V(8); PG8_WAIT_L(0); PG8_BAR; PG8_MMA(0, 0, At, B0); PG8_MMA(0, 1, At, B1); PG8_BAR; PG8_SCHED;
            PG8_LDA(At, 1, 1); PG8_STAGE(PG8_SB(1, 0), b3, voffB); PG8_STAGE(PG8_SB(1, 1), b3 + hstep, voffB); PG8_STAGE(PG8_SA(1, 0), a3, voffA);
            PG8_WAIT_V(8); PG8_WAIT_L(0); PG8_BAR; PG8_MMA(1, 0, At, B0); PG8_MMA(1, 1, At, B1); PG8_BAR; PG8_SCHED;
            } else {
            PG8_LDB(B0, 0, 0); PG8_SCHED; PG8_LDA(At, 0, 0); PG8_STAGE(PG8_SA(1, 1), a1 + hstep, voffA);
            PG8_WAIT_L(8); PG8_BAR; PG8_WAIT_L(0); PG8_MMA(0, 0, At, B0); PG8_BAR; PG8_SCHED;
            PG8_LDB(B1, 0, 1); PG8_STAGE(PG8_SB(0, 0), b2, voffB);
            PG8_BAR; PG8_WAIT_L(0); PG8_MMA(0, 1, At, B1); PG8_BAR;
            PG8_LDA(At, 0, 1); PG8_STAGE(PG8_SA(0, 0), a2, voffA);
            PG8_BAR; PG8_WAIT_L(0); PG8_MMA(1, 0, At, B0); PG8_BAR; PG8_SCHED;
            PG8_STAGE(PG8_SB(0, 1), b2 + hstep, voffB);
            PG8_WAIT_V(6); PG8_BAR; PG8_MMA(1, 1, At, B1); PG8_BAR;
            PG8_LDB(B0, 1, 0); PG8_SCHED; PG8_LDA(At, 1, 0); PG8_STAGE(PG8_SA(0, 1), a2 + hstep, voffA);
            PG8_WAIT_L(8); PG8_BAR; PG8_WAIT_L(0); PG8_MMA(0, 0, At, B0); PG8_BAR; PG8_SCHED;
            PG8_LDB(B1, 1, 1); PG8_STAGE(PG8_SB(1, 0), b3, voffB);
            PG8_BAR; PG8_WAIT_L(0); PG8_MMA(0, 1, At, B1); PG8_BAR;
            PG8_LDA(At, 1, 1); PG8_STAGE(PG8_SA(1, 0), a3, voffA);
            PG8_BAR; PG8_WAIT_L(0); PG8_MMA(1, 0, At, B0); PG8_BAR; PG8_SCHED;
            PG8_STAGE(PG8_SB(1, 1), b3 + hstep, voffB);
            PG8_WAIT_V(6); PG8_BAR; PG8_MMA(1, 1, At, B1); PG8_BAR;
            }
        }
        if constexpr (ALIGN_EPI) { if (wr == 0) PG8_BAR; }
        if constexpr (!Epi::AFTER_DRAIN) { E(acc, cur, wr, wc, fr, fq); S.done(cur); }
        if (!has_next) break;
#pragma unroll
        for (int a = 0; a < 2; ++a)
#pragma unroll
            for (int b = 0; b < 2; ++b)
#pragma unroll
                for (int m = 0; m < 4; ++m)
#pragma unroll
                    for (int n = 0; n < 2; ++n) acc[a][b][m][n] = (f32x4){0.f, 0.f, 0.f, 0.f};
        cur = nxt; cA = nA; cB = nB; ++ui;
        if constexpr (ALIGN_EPI) { if (wr == 1) PG8_BAR; }
    }
    PG8_WAIT_V(0);
    if constexpr (!ALIGN_EPI) { if (wr == 0) PG8_BAR; }
    PG8_BAR;
    if constexpr (Epi::AFTER_DRAIN) { E.fused(acc, cur, wr, wc, fr, fq, lds, wid, lane); S.done(cur); }
#undef PG8_SA
#undef PG8_SB
#undef PG8_STAGE
#undef PG8_LDA
#undef PG8_LDB
#undef PG8_MMA
#undef PG8_WAIT_V
#undef PG8_WAIT_L
#undef PG8_BAR
#undef PG8_SCHED
}
}
constexpr int NWAVES = 8;
constexpr int D = 1024, MP = 16384, MS = 256, M = MP + MS, NIN = 2048, FF = 4096;
constexpr float EPS = 1e-6f;
constexpr size_t OUT_Y = 0, OUT_POOL_P = 17039360, OUT_CONV_P = 17070080, OUT_MK = 17074176, OUT_MV = 18122752, OUT_POOL_S = 19171328, OUT_CONV_S = 19294208, OUT_TOTAL = 19310592;
constexpr size_t MiB = 1u << 20;
constexpr size_t WS_CTL = 0, CTL_ZERO_BYTES = 128 * 1024;
constexpr size_t WS_WDOWN = 1 * MiB, WS_WUP = 9 * MiB, WS_WIN = 17 * MiB, WS_WKV = 21 * MiB, WS_WOUT = 25 * MiB, WS_WQ = 27 * MiB, WS_WCO = 29 * MiB, WS_WP = 31 * MiB;
constexpr size_t WS_HISTU = 31 * MiB + 512 * 1024, WS_HISTV = WS_HISTU + 16 * 15 * 512 * 2, WS_ZERO = 32 * 1024;
constexpr size_t WS_MN = 32 * MiB, WS_KB = 34 * MiB, WS_VT = 36 * MiB, WS_KBS = 38 * MiB, WS_VTS = 46 * MiB;
constexpr size_t WS_XN = 54 * MiB;
constexpr size_t WS_MRG = 87 * MiB;
constexpr size_t WS_AO = 87 * MiB;
constexpr size_t WS_P1 = 120 * MiB;
constexpr size_t WS_QO = 120 * MiB;
constexpr size_t WS_HID = 120 * MiB;
constexpr size_t WS_XB1 = 248 * MiB, WS_XB2 = WS_XB1 + 256 * 1024, WS_XB3 = WS_XB2 + 256 * 1024, WS_RSP1 = WS_XB3 + 256 * 1024, WS_RSP2 = WS_RSP1 + 256 * 1024;
constexpr size_t WS_SXB = 249 * MiB + 512 * 1024, WS_SRSP = WS_SXB + 3 * 32768;
constexpr size_t WS_RNORM = 249 * MiB + 768 * 1024;
constexpr size_t WS_SQO = 250 * MiB, WS_SAO = WS_SQO + 512 * 1024, WS_SRAW = 251 * MiB, WS_SHID = 252 * MiB;
constexpr size_t WS_END = 256 * MiB;
constexpr int CW_TMO = 0, CW_SEAM = 16384, CW_SSEAM = 16384 + 3 * 4096;
static_assert(WS_MRG + (size_t)M * D * 2 <= WS_P1 && WS_HID + (size_t)MP * FF * 2 <= WS_XB1 && WS_SHID + (size_t)MS * FF * 2 <= WS_END, "ws map");
constexpr int CW_BAR = 4096;

constexpr int RING_BYTES = 131072, LDSCTL_OFF = RING_BYTES, MISC_OFF = LDSCTL_OFF + 320, RSTAB_OFF = RING_BYTES + 1024, GGTAB_OFF = RING_BYTES + 2048, STASH_OFF = RING_BYTES + 4096, LDS_BYTES = 147456;

#define GAS __attribute__((address_space(1)))
#define LAS __attribute__((address_space(3)))
typedef unsigned short bf16;
typedef unsigned v4u __attribute__((ext_vector_type(4)));
typedef unsigned v2u __attribute__((ext_vector_type(2)));
typedef float f32x4 __attribute__((ext_vector_type(4)));
typedef float f32x16 __attribute__((ext_vector_type(16)));
typedef float f32x2 __attribute__((ext_vector_type(2)));
typedef short bf16x8 __attribute__((ext_vector_type(8)));
#define LDS_WAIT() asm volatile("s_waitcnt lgkmcnt(0)" ::: "memory")
#define VM_WAIT() asm volatile("s_waitcnt vmcnt(0)" ::: "memory")
__device__ __forceinline__ unsigned f2bf(float f) { unsigned u = __builtin_bit_cast(unsigned, f); return (u + 0x7fffu + ((u >> 16) & 1u)) >> 16; }
__device__ __forceinline__ unsigned pk2(float lo, float hi) { return pg8::cvt_pk_bf16(lo, hi); }
typedef __bf16 bf16n2 __attribute__((ext_vector_type(2)));
__device__ __forceinline__ unsigned pk2c(float lo, float hi) { const bf16n2 v = __builtin_convertvector((f32x2){lo, hi}, bf16n2); return __builtin_bit_cast(unsigned, v); }
__device__ __forceinline__ float bflo(unsigned w) { return __builtin_bit_cast(float, w << 16); }
__device__ __forceinline__ float bfhi(unsigned w) { return __builtin_bit_cast(float, w & 0xffff0000u); }

__device__ __forceinline__ void st_wt16(void* p, v4u v) { asm volatile("global_store_dwordx4 %0, %1, off sc0 sc1\n\ts_nop 1" :: "v"(p), "v"(v) : "memory"); }
#define XB_TMO      128
#define XB_XCNT(j)  (256  + 64 * (j))
#define XB_XSUB(j)  (1280 + 64 * (j))
#define XB_XGEN(j)  (2304 + 64 * (j))
#define XB_TOP      3328
#define XB_TOPGEN   3392
#define XCD_BAR_WORDS 3456
#define XB_SPIN_CAP (1u << 22)
__device__ __forceinline__ unsigned xb_ld(unsigned* p)              { return __hip_atomic_load(p, __ATOMIC_RELAXED, __HIP_MEMORY_SCOPE_AGENT); }
__device__ __forceinline__ unsigned xb_add(unsigned* p, unsigned v) { return __hip_atomic_fetch_add(p, v, __ATOMIC_RELAXED, __HIP_MEMORY_SCOPE_AGENT); }
__device__ __forceinline__ unsigned xb_xcc_id() { return (unsigned)__builtin_amdgcn_s_getreg((3 << 11) | 20) & 0xFu; }
#define XB_SPIN(cond, bar) do { unsigned _sp = 0; while (cond) { __builtin_amdgcn_s_sleep(1); \
    if ((++_sp & 255u) == 0u) { if (xb_ld(&(bar)[XB_TMO])) break; if (_sp > XB_SPIN_CAP) { atomicAdd(&(bar)[XB_TMO], 1u); break; } } } } while (0)
struct XcdBarrier { unsigned* bar; unsigned x; volatile LAS unsigned* st; };
__device__ __forceinline__ XcdBarrier xcd_barrier_post(unsigned* bar, volatile LAS unsigned* st) {
    XcdBarrier b; b.bar = bar; b.x = xb_xcc_id(); b.st = st;
    if (threadIdx.x == 0) (void)xb_add(&bar[XB_XCNT(b.x)], 1u);
    return b;
}
__device__ __forceinline__ void xcd_barrier_complete(unsigned* bar, unsigned x, unsigned& nloc, unsigned& nx) {
    const unsigned G = gridDim.x * gridDim.y * gridDim.z;
    unsigned sum, cnt, mine, sp = 0u;
    for (;;) {
        sum = 0u; cnt = 0u; mine = 0u;
#pragma unroll
        for (unsigned j = 0; j < 16; ++j) { const unsigned c = xb_ld(&bar[XB_XCNT(j)]); sum += c; cnt += (c > 0u) ? 1u : 0u; mine = (j == x) ? c : mine; }
        if (sum == G) break;
        __builtin_amdgcn_s_sleep(1);
        if ((++sp & 255u) == 0u) { if (xb_ld(&bar[XB_TMO])) break; if (sp > XB_SPIN_CAP) { atomicAdd(&bar[XB_TMO], 1u); break; } }
    }
    nloc = mine > 0u ? mine : 1u; nx = cnt > 0u ? cnt : 1u;
}
__device__ __forceinline__ void xcd_barrier(const XcdBarrier& b) {
    asm volatile("s_waitcnt vmcnt(0)" ::: "memory");
    __syncthreads();
    if (threadIdx.x == 0) {
        unsigned* bar = b.bar;
        __builtin_amdgcn_s_waitcnt(0);
        unsigned nloc = b.st[0], nx = b.st[1];
        if (nloc == 0u) { xcd_barrier_complete(bar, b.x, nloc, nx); b.st[0] = nloc; b.st[1] = nx; }
        const unsigned old = xb_add(&bar[XB_XSUB(b.x)], 1u);
        const unsigned gen = old / nloc;
        if (old + 1u == (gen + 1u) * nloc) {
            __builtin_amdgcn_fence(__ATOMIC_RELEASE, "agent");
            asm volatile("s_waitcnt vmcnt(0)" ::: "memory");
            const unsigned og = xb_add(&bar[XB_TOP], 1u);
            const unsigned tg = og / nx;
            if (og + 1u == (tg + 1u) * nx) xb_add(&bar[XB_TOPGEN], 1u);
            else XB_SPIN(xb_ld(&bar[XB_TOPGEN]) == tg, bar);
            __builtin_amdgcn_fence(__ATOMIC_ACQUIRE, "agent");
            xb_add(&bar[XB_XGEN(b.x)], 1u);
            asm volatile("s_waitcnt vmcnt(0)" ::: "memory");
        } else {
            XB_SPIN(xb_ld(&bar[XB_XGEN(b.x)]) == gen, bar);
            __builtin_amdgcn_fence(__ATOMIC_ACQUIRE, "agent");
            asm volatile("s_waitcnt vmcnt(0)" ::: "memory");
        }
    }
    __syncthreads();
}

template <bool WB = true>
__device__ __forceinline__ void xcd_arrive(const XcdBarrier& b) {
    asm volatile("s_waitcnt vmcnt(0)" ::: "memory");
    __syncthreads();
    if (threadIdx.x == 0) {
        unsigned* bar = b.bar;
        __builtin_amdgcn_s_waitcnt(0);
        unsigned nloc = b.st[0], nx = b.st[1];
        if (nloc == 0u) { xcd_barrier_complete(bar, b.x, nloc, nx); b.st[0] = nloc; b.st[1] = nx; }
        const unsigned old = xb_add(&bar[XB_XSUB(b.x)], 1u);
        const unsigned gen = old / nloc;
        b.st[2] = gen;
        if (old + 1u == (gen + 1u) * nloc) {
            if (WB) { __builtin_amdgcn_fence(__ATOMIC_RELEASE, "agent");
                asm volatile("s_waitcnt vmcnt(0)" ::: "memory"); }
            (void)xb_add(&bar[XB_TOP], 1u);
        }
        __builtin_amdgcn_fence(__ATOMIC_ACQUIRE, "agent");
    }
}
__device__ __forceinline__ void xcd_wait(const XcdBarrier& b) {
    if (threadIdx.x == 0) {
        unsigned* bar = b.bar; const unsigned need = (b.st[2] + 1u) * b.st[1];
        XB_SPIN((int)(xb_ld(&bar[XB_TOP]) - need) < 0, bar);
        asm volatile("s_waitcnt vmcnt(0)" ::: "memory");
    }
    __syncthreads();
}

#define XB_LSUB(j)  (5120 + 64 * (j))
#define XB_GRP(j)   (6400 + 64 * (j))
#define XB_MIS      7040
__device__ __forceinline__ void xcd_local_barrier(const XcdBarrier& b) {
    asm volatile("s_waitcnt vmcnt(0)" ::: "memory");
    __syncthreads();
    if (threadIdx.x == 0) {
        unsigned* bar = b.bar;
        const unsigned nloc = b.st[0];
        const unsigned old = xb_add(&bar[XB_LSUB(b.x)], 1u);
        const unsigned need = (old / nloc + 1u) * nloc;
        __builtin_amdgcn_fence(__ATOMIC_ACQUIRE, "agent");
        XB_SPIN((int)(xb_ld(&bar[XB_LSUB(b.x)]) - need) < 0, bar);
        asm volatile("s_waitcnt vmcnt(0)" ::: "memory");
    }
    __syncthreads();
}

struct Args { const float* in[27]; float* out; unsigned char* ws; };

__device__ __forceinline__ float wave_sum(float v) {
#pragma unroll
    for (int o = 1; o < 64; o <<= 1) v += __shfl_xor(v, o);
    return v;
}

struct TItem { const float* W; const float* g; const float* gn; bf16* WT; int ldw, K, srccol, dstrow, k0; float sc; int kperm; };
struct TRegs { f32x4 v[8]; float gk[8]; };
__device__ __forceinline__ void t_load(const TItem& t, TRegs& r, int lane) {
    const int rl = lane >> 3, cq = lane & 7;
#pragma unroll
    for (int i = 0; i < 8; ++i) { const int kk = 8 * i + rl; r.v[i] = __builtin_nontemporal_load((const GAS f32x4*)(t.W + (size_t)(t.k0 + kk) * t.ldw + t.srccol + 4 * cq)); r.gk[i] = t.g ? t.g[t.k0 + kk] : 1.f; }
}
__device__ __forceinline__ void t_process(const TItem& t, const TRegs& r, LAS float* scr, int lane) {
    const int rl = lane >> 3, cq = lane & 7;
    f32x4 gn4 = (f32x4){1.f, 1.f, 1.f, 1.f}; if (t.gn) gn4 = *(const GAS f32x4*)(t.gn + t.srccol + 4 * cq);
#pragma unroll
    for (int i = 0; i < 8; ++i) { const int kk = 8 * i + rl; const float m = r.gk[i] * t.sc; LAS float* d = scr + kk * 33 + 4 * cq;
        d[0] = r.v[i].x * m * gn4.x; d[1] = r.v[i].y * m * gn4.y; d[2] = r.v[i].z * m * gn4.z; d[3] = r.v[i].w * m * gn4.w; }
    LDS_WAIT(); asm volatile("" ::: "memory");
    const int c = lane & 7;
    const int lp = t.kperm == 0 ? 8 * c : t.kperm == 1 ? (((c & 6) << 3) | ((c & 1) << 2)) : (((c & 4) << 3) | ((c & 3) << 2));
    const LAS float* s0 = scr + lp * 33; const LAS float* s1 = s0 + (4 << t.kperm) * 33;
#pragma unroll
    for (int j = 0; j < 4; ++j) { const int n = (lane >> 3) + 8 * j;
        float e[8];
#pragma unroll
        for (int q = 0; q < 8; ++q) e[q] = (q < 4 ? s0 : s1)[(q & 3) * 33 + n];
        v4u o; o.x = pk2(e[0], e[1]); o.y = pk2(e[2], e[3]); o.z = pk2(e[4], e[5]); o.w = pk2(e[6], e[7]);
        st_wt16(t.WT + (size_t)(t.dstrow + n) * t.K + t.k0 + 8 * c, o); }
    LDS_WAIT(); asm volatile("" ::: "memory");
}
__device__ __forceinline__ void rms_row_to_bf16(const float* xrow, bf16* orow, float* n0, int lane) {
    const GAS f32x4* xr = (const GAS f32x4*)xrow + lane;
    f32x4 v[4]; float s = 0.f;
#pragma unroll
    for (int j = 0; j < 4; ++j) { v[j] = __builtin_nontemporal_load(xr + 64 * j); s += (v[j].x * v[j].x + v[j].y * v[j].y) + (v[j].z * v[j].z + v[j].w * v[j].w); }
    const float rs = 1.f / sqrtf(wave_sum(s) * (1.f / D) + EPS);
    if (lane == 0 && n0) *n0 = 1.f / rs;
    GAS v2u* o8 = (GAS v2u*)orow + lane;
#pragma unroll
    for (int j = 0; j < 4; ++j) { v2u w; w.x = pk2(v[j].x * rs, v[j].y * rs); w.y = pk2(v[j].z * rs, v[j].w * rs); o8[64 * j] = w; }
}
__device__ __forceinline__ void rms_rows2_to_bf16(const float* x0, bf16* o0, const float* x1, bf16* o1, float* n0, float* n1, int lane) {
    const GAS f32x4* a0 = (const GAS f32x4*)x0 + lane; const GAS f32x4* a1 = (const GAS f32x4*)x1 + lane;
    f32x4 v[4], w[4]; float s = 0.f, t = 0.f;
#pragma unroll
    for (int j = 0; j < 4; ++j) { v[j] = __builtin_nontemporal_load(a0 + 64 * j); w[j] = __builtin_nontemporal_load(a1 + 64 * j); }
#pragma unroll
    for (int j = 0; j < 4; ++j) { s += (v[j].x * v[j].x + v[j].y * v[j].y) + (v[j].z * v[j].z + v[j].w * v[j].w); t += (w[j].x * w[j].x + w[j].y * w[j].y) + (w[j].z * w[j].z + w[j].w * w[j].w); }
    const float rs = 1.f / sqrtf(wave_sum(s) * (1.f / D) + EPS), rt_ = 1.f / sqrtf(wave_sum(t) * (1.f / D) + EPS);
    GAS v2u* p0 = (GAS v2u*)o0 + lane; GAS v2u* p1 = (GAS v2u*)o1 + lane;
    if (lane == 0) { if (n0) *n0 = 1.f / rs; if (n1) *n1 = 1.f / rt_; }
#pragma unroll
    for (int j = 0; j < 4; ++j) { v2u u; u.x = pk2(v[j].x * rs, v[j].y * rs); u.y = pk2(v[j].z * rs, v[j].w * rs); p0[64 * j] = u;
        v2u z; z.x = pk2(w[j].x * rt_, w[j].y * rt_); z.y = pk2(w[j].z * rt_, w[j].w * rt_); p1[64 * j] = z; }
}
__device__ __forceinline__ const float* xrow_ptr(const Args& a, int row) { return row < MP ? a.in[0] + (size_t)row * D : a.in[1] + (size_t)(row - MP) * D; }

constexpr int I_IN = 16 * 64, I_KV = 16 * 64, I_WP = 4 * 2 * 4, N_EARLY = I_IN + I_KV + I_WP;
constexpr int I_OUT = 16 * 32, I_Q = 16 * 32, I_CO = 16 * 32, I_UP = 16 * 128, I_DN = 64 * 32, I_VS = 64 * 4 * 8, N_ITEMS = N_EARLY + I_OUT + I_Q + I_CO + I_UP + I_DN + I_VS;
constexpr int DN_LO = N_EARLY + I_OUT + I_Q + I_CO + I_UP, DN_HI = DN_LO + I_DN;
__device__ __forceinline__ TItem p0_item(const Args& a, int it) {
    unsigned char* ws = a.ws; TItem t; t.g = nullptr; t.gn = nullptr; t.sc = 1.f; t.kperm = 0;
    int r = it;
    if (r < I_IN) { const int kb = r / 64, nb = r % 64, n0 = 32 * nb; int src;
        if (n0 < 1024) src = n0; else { const int j = (n0 - 1024) >> 8, o = (n0 - 1024) & 255; src = o < 128 ? 1024 + 128 * j + o : 1536 + 128 * j + (o - 128); }
        t.W = a.in[8]; t.ldw = NIN; t.K = D; t.srccol = src; t.WT = (bf16*)(ws + WS_WIN); t.dstrow = n0; t.k0 = 64 * kb; t.g = a.in[7]; return t; } r -= I_IN;
    if (r < I_KV) { const int kb = r / 64, nb = r % 64, n0 = 32 * nb;
        t.W = n0 < 1024 ? a.in[17] : a.in[18]; t.ldw = D; t.K = D; t.srccol = n0 & 1023; t.WT = (bf16*)(ws + WS_WKV); t.dstrow = n0; t.k0 = 64 * kb; t.g = a.in[16]; return t; } r -= I_KV;
    if (r < I_WP) { const int gi = r / 8, kb = (r % 8) / 4, nb = r % 4;
        t.W = a.in[9] + gi * 16384; t.ldw = 128; t.K = 128; t.srccol = 32 * nb; t.WT = (bf16*)(ws + WS_WP) + gi * 16384; t.dstrow = 32 * nb; t.k0 = 64 * kb; t.gn = a.in[10] + gi * 128; t.kperm = 2; return t; } r -= I_WP;
    if (r < I_OUT) { t.W = a.in[14]; t.ldw = D; t.K = D; t.srccol = 32 * (r % 32); t.WT = (bf16*)(ws + WS_WOUT); t.dstrow = t.srccol; t.k0 = 64 * (r / 32);
        t.g = t.k0 < 512 ? a.in[12] : a.in[13] - 512; return t; } r -= I_OUT;
    if (r < I_Q) { t.W = a.in[20]; t.ldw = D; t.K = D; t.srccol = 32 * (r % 32); t.WT = (bf16*)(ws + WS_WQ); t.dstrow = t.srccol; t.k0 = 64 * (r / 32); t.g = a.in[19]; t.sc = 0.0625f; return t; } r -= I_Q;
    if (r < I_CO) { t.W = a.in[21]; t.ldw = D; t.K = D; t.srccol = 32 * (r % 32); t.WT = (bf16*)(ws + WS_WCO); t.dstrow = t.srccol; t.k0 = 64 * (r / 32); return t; } r -= I_CO;
    if (r < I_UP) { t.W = a.in[24]; t.ldw = FF; t.K = D; t.srccol = 32 * (r % 128); t.WT = (bf16*)(ws + WS_WUP); t.dstrow = t.srccol; t.k0 = 64 * (r / 128); t.g = a.in[23]; return t; } r -= I_UP;
    if (r < I_DN) { t.W = a.in[25]; t.ldw = D; t.K = FF; t.srccol = 32 * (r % 32); t.WT = (bf16*)(ws + WS_WDOWN); t.dstrow = t.srccol; t.k0 = 64 * (r / 32); return t; } r -= I_DN;
    { const int sbh = r / 32, kb = (r % 32) / 8, nb = r % 8, sb = sbh >> 2, h = sbh & 3;
        t.W = a.in[5] + (size_t)sb * 262144 + h * 256; t.ldw = 1024; t.K = 256; t.srccol = 32 * nb; t.WT = (bf16*)(ws + WS_VTS) + (size_t)sbh * 65536; t.dstrow = 32 * nb; t.k0 = 64 * kb; t.kperm = 1; return t; }
}
__device__ __forceinline__ void p0_items(const Args& a, LAS float* scr, int lo, int hi, int gw, int NGW, int lane) {
    int it = lo + gw; TItem cur; TRegs rc;
    if (it < hi) { cur = p0_item(a, it); t_load(cur, rc, lane); }
    while (it < hi) {
        const int nx = it + NGW; TItem nxt = cur; TRegs rn = rc;
        if (nx < hi) { nxt = p0_item(a, nx); t_load(nxt, rn, lane); }
        t_process(cur, rc, scr, lane);
        cur = nxt; rc = rn; it = nx;
    }
}
__device__ __forceinline__ void p0_prologue(const Args& a, LAS unsigned char* lds, int gw, int NGW, int wave, int lane_) {
    int lane = lane_; asm volatile("" : "+v"(lane));
    unsigned char* ws = a.ws;
    p0_items(a, (LAS float*)(lds + wave * 16384), 0, N_EARLY, gw, NGW, lane);
    float* rn = (float*)(ws + WS_RNORM);
    for (int m = gw; m < M + 1024; m += 2 * NGW) {
        const int m2 = m + NGW;
        const float* r0 = m < M ? xrow_ptr(a, m) : a.in[6] + (size_t)(m - M) * D; bf16* o0 = m < M ? (bf16*)(ws + WS_XN) + (size_t)m * D : (bf16*)(ws + WS_MN) + (size_t)(m - M) * D;
        if (m2 < M + 1024) {
            const float* r1 = m2 < M ? xrow_ptr(a, m2) : a.in[6] + (size_t)(m2 - M) * D; bf16* o1 = m2 < M ? (bf16*)(ws + WS_XN) + (size_t)m2 * D : (bf16*)(ws + WS_MN) + (size_t)(m2 - M) * D;
            rms_rows2_to_bf16(r0, o0, r1, o1, m < MP ? rn + m : nullptr, m2 < MP ? rn + m2 : nullptr, lane);
        } else rms_row_to_bf16(r0, o0, m < MP ? rn + m : nullptr, lane);
    }
    { GAS v4u* dst = (GAS v4u*)(ws + WS_HISTU); constexpr int NU = 16 * 15 * 512 / 8, NV = 16 * 2 * 512 / 8;
      for (int i = gw * 64 + lane; i < NU + NV; i += NGW * 64) { const GAS f32x4* src = i < NU ? (const GAS f32x4*)a.in[2] + 2 * i : (const GAS f32x4*)a.in[3] + 2 * (i - NU); const f32x4 p = src[0], q = src[1];
          v4u o; o.x = pk2(p.x, p.y); o.y = pk2(p.z, p.w); o.z = pk2(q.x, q.y); o.w = pk2(q.z, q.w); dst[i] = o; } }
}
__device__ __forceinline__ void p2_late(const Args& a, LAS unsigned char* lds, int gw, int NGW, int wave, int lane_) {
    int lane = lane_; asm volatile("" : "+v"(lane));
    unsigned char* ws = a.ws;
    p0_items(a, (LAS float*)(lds + wave * 16384), N_EARLY, DN_LO, gw, NGW, lane);
    p0_items(a, (LAS float*)(lds + wave * 16384), DN_HI, N_ITEMS, gw, NGW, lane);
    { const GAS f32x4* src = (const GAS f32x4*)a.in[4]; GAS v4u* dst = (GAS v4u*)(ws + WS_KBS); const size_t n = (size_t)16 * 256 * 1024 / 8, st = (size_t)NGW * 64;
      for (size_t i = (size_t)gw * 64 + lane; i < n; i += 4 * st) { f32x4 p[4], q[4];
#pragma unroll
          for (int k = 0; k < 4; ++k) if (i + k * st < n) { p[k] = __builtin_nontemporal_load(src + 2 * (i + k * st)); q[k] = __builtin_nontemporal_load(src + 2 * (i + k * st) + 1); }
#pragma unroll
          for (int k = 0; k < 4; ++k) if (i + k * st < n) { v4u o; o.x = pk2(p[k].x, p[k].y); o.y = pk2(p[k].z, p[k].w); o.z = pk2(q[k].x, q[k].y); o.w = pk2(q[k].z, q[k].w); dst[i + k * st] = o; } } }
}

__device__ __forceinline__ void load8(const bf16* p, float (&f)[8]) { const v4u w = *(const GAS v4u*)p; f[0] = bflo(w.x); f[1] = bfhi(w.x); f[2] = bflo(w.y); f[3] = bfhi(w.y); f[4] = bflo(w.z); f[5] = bfhi(w.z); f[6] = bflo(w.w); f[7] = bfhi(w.w); }
__device__ __forceinline__ void load8f(const float* p, float (&f)[8]) { const f32x4 a = *(const GAS f32x4*)p, b = *(const GAS f32x4*)(p + 4); f[0] = a.x; f[1] = a.y; f[2] = a.z; f[3] = a.w; f[4] = b.x; f[5] = b.y; f[6] = b.z; f[7] = b.w; }
__device__ __forceinline__ void acc8(const v4u w, float (&s)[8]) { s[0] += bflo(w.x); s[1] += bfhi(w.x); s[2] += bflo(w.y); s[3] += bfhi(w.y); s[4] += bflo(w.z); s[5] += bfhi(w.z); s[6] += bflo(w.w); s[7] += bfhi(w.w); }
__device__ __forceinline__ void mixer_stage_wp(LAS unsigned char* lds, const bf16* WPt, int wave, int lane) {
    const GAS char* gb = (const GAS char*)WPt + (size_t)wave * 16384;
    const unsigned rl4 = (unsigned)lane >> 4, l15 = (unsigned)lane & 15u;
#pragma unroll
    for (int n = 0; n < 16; ++n) { const unsigned rl = 4u * n + rl4;
        __builtin_amdgcn_global_load_lds((const GAS unsigned*)(gb + rl * 256u + ((l15 ^ (rl & 15u)) << 4)), (LAS unsigned*)(lds + (wave * 16 + n) * 1024), 16, 0, 0); }
}
__device__ __forceinline__ unsigned off_b(unsigned row, unsigned ch) { return 256u * row + 16u * (ch ^ (((row & 3u) << 2) | ((row >> 2) & 3u))); }
template <int GI> __device__ __forceinline__ void pool_issue(const Args& a, LAS unsigned char* tile, int row0, int nblk, bool sample, int lane) {
    constexpr int W = 2 << GI;
    const unsigned fr = lane & 15, fq = lane >> 4;
    const int nrows = 16 * nblk + W - 1, t0 = sample ? 0 : (row0 & 4095), sb = (row0 >> 4) & 15;
    const GAS char* wsb = (const GAS char*)a.ws;
#pragma unroll
    for (int n = 0; n < 16; ++n) if (n < 4 * nblk + 4) {
        const int r = 4 * n + (int)fq, tt = t0 - (W - 1) + r;
        unsigned o;
        if (r >= nrows) o = (unsigned)WS_ZERO;
        else if (tt >= 0) o = (unsigned)WS_P1 + (unsigned)(row0 - (W - 1) + r) * 3072u + (unsigned)(GI * 256);
        else o = sample ? (unsigned)WS_HISTU + (unsigned)(sb * 15 + 15 + tt) * 1024u + (unsigned)(GI * 256) : (unsigned)WS_ZERO;
        const unsigned lc = fr ^ ((fq << 2) | (unsigned)(n & 3));
        __builtin_amdgcn_global_load_lds((const GAS unsigned*)(wsb + o + (lc << 4)), (LAS unsigned*)(tile + n * 1024), 16, 0, 0); }
}
template <int GI> __device__ __forceinline__ void pool_compute(const Args& a, LAS unsigned char* lds, LAS unsigned char* tile, int row0, int nblk, bool sample, int lane) {
    constexpr int W = 2 << GI;
    const int fr = lane & 15, fq = lane >> 4;
    bf16x8 wf[4][8];
    { const bf16* wp = (const bf16*)(a.ws + WS_WP) + GI * 16384 + (size_t)fr * 128 + fq * 8;
#pragma unroll
      for (int ks = 0; ks < 4; ++ks)
#pragma unroll
          for (int db = 0; db < 8; ++db) wf[ks][db] = *(const GAS bf16x8*)(wp + db * 2048 + ks * 32); }
    const unsigned tb = (unsigned)(size_t)tile, qq = (unsigned)(lane & 15) >> 2, pp = (unsigned)lane & 3u;
    bf16x8 cfg;
    { float cw[8]; int fr_ = fr, r8 = 8 * fq; asm volatile("" : "+v"(fr_), "+v"(r8));
#pragma unroll
      for (int jj = 0; jj < 8; ++jj) { const int r = r8 + jj; cw[jj] = ((r >= fr_ && r <= fr_ + W - 1) ? (1.f / W) : 0.f) - (r == fr_ + W - 1 ? 1.f : 0.f); }
      v4u pc; pc.x = pk2(cw[0], cw[1]); pc.y = pk2(cw[2], cw[3]); pc.z = pk2(cw[4], cw[5]); pc.w = pk2(cw[6], cw[7]); cfg = __builtin_bit_cast(bf16x8, pc); }
    asm volatile("s_waitcnt vmcnt(0)" ::: "memory");
#pragma unroll 1
    for (int i = 0; i < nblk; ++i) {
        const int row = row0 + 16 * i + fr, t = sample ? fr : (row & 4095);
        const float inv = sample ? (1.f / W) : 1.f / (float)(t + 1 < W ? t + 1 : W);
        bf16x8 cf = cfg;
        if (!sample && ((row0 + 16 * i) & 4095) == 0) {
          float cw[8];
          int fr_ = fr, r8 = 8 * fq; asm volatile("" : "+v"(fr_), "+v"(r8));
#pragma unroll
          for (int jj = 0; jj < 8; ++jj) { const int r = r8 + jj; cw[jj] = ((r >= fr_ && r <= fr_ + W - 1) ? inv : 0.f) - (r == fr_ + W - 1 ? 1.f : 0.f); }
          v4u pc; pc.x = pk2(cw[0], cw[1]); pc.y = pk2(cw[2], cw[3]); pc.z = pk2(cw[4], cw[5]); pc.w = pk2(cw[6], cw[7]); cf = __builtin_bit_cast(bf16x8, pc); }
        v4u pa[4];
#pragma unroll
        for (int cb = 0; cb < 8; cb += 2) {
            unsigned ad[4];
#pragma unroll
            for (int k = 0; k < 4; ++k) { const unsigned c_ = cb + (k >> 1), tt = k & 1; ad[k] = tb + 4096u * i + off_b(8u * fq + 4u * tt + qq, 2u * c_ + (pp >> 1)) + 8u * (pp & 1u); }
            v2u r0, r1, r2, r3;
            asm volatile("ds_read_b64_tr_b16 %0, %4\n\tds_read_b64_tr_b16 %1, %5\n\tds_read_b64_tr_b16 %2, %6\n\tds_read_b64_tr_b16 %3, %7\n\ts_waitcnt lgkmcnt(0)"
                         : "=&v"(r0), "=&v"(r1), "=&v"(r2), "=&v"(r3) : "v"(ad[0]), "v"(ad[1]), "v"(ad[2]), "v"(ad[3]) : "memory");
            v4u f0; f0.x = r0.x; f0.y = r0.y; f0.z = r1.x; f0.w = r1.y;
            v4u f1; f1.x = r2.x; f1.y = r2.y; f1.z = r3.x; f1.w = r3.y;
            const pg8::f32x4 p0 = __builtin_amdgcn_mfma_f32_16x16x32_bf16(__builtin_bit_cast(bf16x8, f0), cf, (pg8::f32x4){0.f, 0.f, 0.f, 0.f}, 0, 0, 0);
            const pg8::f32x4 p1 = __builtin_amdgcn_mfma_f32_16x16x32_bf16(__builtin_bit_cast(bf16x8, f1), cf, (pg8::f32x4){0.f, 0.f, 0.f, 0.f}, 0, 0, 0);
            pa[cb >> 1].x = pk2c(p0[0], p0[1]); pa[cb >> 1].y = pk2c(p0[2], p0[3]); pa[cb >> 1].z = pk2c(p1[0], p1[1]); pa[cb >> 1].w = pk2c(p1[2], p1[3]);
        }
        pg8::f32x4 acc[8];
#pragma unroll
        for (int db = 0; db < 8; ++db) acc[db] = (pg8::f32x4){0.f, 0.f, 0.f, 0.f};
#pragma unroll
        for (int ks = 0; ks < 4; ++ks) { const bf16x8 pf = __builtin_bit_cast(bf16x8, pa[ks]);
#pragma unroll
            for (int db = 0; db < 8; ++db) acc[db] = __builtin_amdgcn_mfma_f32_16x16x32_bf16(wf[ks][db], pf, acc[db], 0, 0, 0); }
        float ss = 0.f;
#pragma unroll
        for (int db = 0; db < 8; ++db) ss += (acc[db][0] * acc[db][0] + acc[db][1] * acc[db][1]) + (acc[db][2] * acc[db][2] + acc[db][3] * acc[db][3]);
        ss += __shfl_xor(ss, 16); ss += __shfl_xor(ss, 32);
        const float rs = 1.f / sqrtf(ss * (1.f / 128.f) + EPS);
        bf16* MRG = (bf16*)(a.ws + WS_MRG);
#pragma unroll
        for (int db = 0; db < 8; ++db) { const f32x4 o = acc[db] * rs;
            v2u w; w.x = pk2(o[0], o[1]); w.y = pk2(o[2], o[3]); *(GAS v2u*)(MRG + (size_t)row * D + GI * 128 + 16 * db + 4 * fq) = w; }
    }
}
__device__ __forceinline__ f32x2 up2(unsigned w) { f32x2 r; r.x = bflo(w); r.y = bfhi(w); return r; }
__device__ __forceinline__ unsigned pk2v(f32x2 v) { const bf16n2 b = __builtin_convertvector(v, bf16n2); return __builtin_bit_cast(unsigned, b); }
template <int CTRL> __device__ __forceinline__ float dpp_f(float v) { return __builtin_bit_cast(float, __builtin_amdgcn_update_dpp(0, __builtin_bit_cast(int, v), CTRL, 0xf, 0xf, true)); }
__device__ __forceinline__ void conv_half(const Args& a, int row0, int half, bool sample, int lane) {
    const bf16* P1 = (const bf16*)(a.ws + WS_P1); bf16* MRG = (bf16*)(a.ws + WS_MRG);
    const int ch = 8 * lane, i0 = 8 * half;
    const bf16* histv = sample ? (const bf16*)(a.ws + WS_HISTV) + (size_t)(((row0 >> 4) & 15) * 2 + 2) * 512 : (const bf16*)(a.ws + WS_ZERO);
    const int hstep = sample ? 512 : 0, t0 = sample ? 0 : (row0 & 4095);
    v4u xv[10], xb[8];
#pragma unroll
    for (int k = 0; k < 10; ++k) { const int i = i0 + k - 2; const bf16* p = (t0 + i >= 0) ? P1 + (size_t)(row0 + i) * 1536 + 1024 : histv + (ptrdiff_t)i * hstep; xv[k] = *(const GAS v4u*)(p + ch); }
#pragma unroll
    for (int k = 0; k < 8; ++k) xb[k] = *(const GAS v4u*)(P1 + (size_t)(row0 + i0 + k) * 1536 + 512 + ch);
    f32x2 w0[4], w1[4], w2[4];
#pragma unroll
    for (int q = 0; q < 4; ++q) { w0[q] = *(const GAS f32x2*)(a.in[11] + ch + 2 * q); w1[q] = *(const GAS f32x2*)(a.in[11] + 512 + ch + 2 * q); w2[q] = *(const GAS f32x2*)(a.in[11] + 1024 + ch + 2 * q); }
    f32x2 va[4], vb[4], vc[4];
#pragma unroll
    for (int q = 0; q < 4; ++q) { va[q] = up2(xv[0][q]); vb[q] = up2(xv[1][q]); }
#pragma unroll
    for (int k = 0; k < 8; ++k) {
        f32x2 y[4]; f32x2 s2 = {0.f, 0.f};
#pragma unroll
        for (int q = 0; q < 4; ++q) { vc[q] = up2(xv[k + 2][q]); const f32x2 bg = up2(xb[k][q]);
            f32x2 cv = w0[q] * va[q]; cv = __builtin_elementwise_fma(w1[q], vb[q], cv); cv = __builtin_elementwise_fma(w2[q], vc[q], cv);
            y[q] = bg * cv; s2 = __builtin_elementwise_fma(y[q], y[q], s2); }
        float ss = s2.x + s2.y;
        ss += dpp_f<0xB1>(ss); ss += dpp_f<0x4E>(ss); ss += dpp_f<0x141>(ss);
        const float rs = 1.f / sqrtf(ss * (1.f / 64.f) + EPS);
        v4u o;
#pragma unroll
        for (int q = 0; q < 4; ++q) { const f32x2 r2 = {rs, rs}; o[q] = pk2v(y[q] * r2); }
        *(GAS v4u*)(MRG + (size_t)(row0 + i0 + k) * D + 512 + ch) = o;
#pragma unroll
        for (int q = 0; q < 4; ++q) { va[q] = vb[q]; vb[q] = vc[q]; }
    }
}
__device__ __forceinline__ void unpack8(const v4u w, float (&f)[8]) { f[0] = bflo(w.x); f[1] = bfhi(w.x); f[2] = bflo(w.y); f[3] = bfhi(w.y); f[4] = bflo(w.z); f[5] = bfhi(w.z); f[6] = bflo(w.w); f[7] = bfhi(w.w); }
__device__ __forceinline__ int mixer_blk(int xg, int bl) { return xg < 0 ? bl : (bl < 128 ? xg * 128 + bl : 1024 + xg * 2 + (bl - 128)); }
template <int GI> __device__ __forceinline__ void mixer_wave(const Args& a, LAS unsigned char* lds, int xg, int j, int nj, int wave, int lane) {
    LAS unsigned char* tile = lds + wave * 16384;
    if (xg >= 0 && nj == 56) {
        int bl0 = -1, nblk = 0;
        if (j < 42) { bl0 = 3 * j; nblk = 3; } else if (j == 42) { bl0 = 126; nblk = 2; } else if (j < 45) { bl0 = 128 + (j - 43); nblk = 1; }
        const int row0 = bl0 >= 0 ? mixer_blk(xg, bl0) * 16 : 0; const bool sample = row0 >= MP;
        if (nblk) pool_issue<GI>(a, tile, row0, nblk, sample, lane);
        int c0 = -1, c1 = -1;
        if (j >= 45) { c0 = 2 * (j - 45); c1 = c0 + 1; } else if (j <= 42) c0 = 22 + j;
        if (c0 >= 0) { const int h = 4 * c0 + GI, r0 = mixer_blk(xg, h >> 1) * 16; conv_half(a, r0, h & 1, r0 >= MP, lane); }
        if (c1 >= 0) { const int h = 4 * c1 + GI, r0 = mixer_blk(xg, h >> 1) * 16; conv_half(a, r0, h & 1, r0 >= MP, lane); }
        asm volatile("" ::: "memory");
        if (nblk) pool_compute<GI>(a, lds, tile, row0, nblk, sample, lane);
    } else {
        const int nb = xg >= 0 ? 130 : M / 16;
        for (int bl = j; bl < nb; bl += nj) { const int row0 = mixer_blk(xg, bl) * 16;
            pool_issue<GI>(a, tile, row0, 1, row0 >= MP, lane); pool_compute<GI>(a, lds, tile, row0, 1, row0 >= MP, lane); }
        for (int h = j * 4 + GI; h < 2 * nb; h += nj * 4) { const int r0 = mixer_blk(xg, h >> 1) * 16; conv_half(a, r0, h & 1, r0 >= MP, lane); }
    }
}
__device__ __forceinline__ void mixer_all(const Args& a, LAS unsigned char* lds, int xg, int cu, int ncu, int wave, int lane_) {
    int lane = lane_; asm volatile("" : "+v"(lane));
    const int gi = wave & 3, j = cu * 2 + (wave >> 2), nj = ncu * 2;
    if (gi == 0) mixer_wave<0>(a, lds, xg, j, nj, wave, lane);
    else if (gi == 1) mixer_wave<1>(a, lds, xg, j, nj, wave, lane);
    else if (gi == 2) mixer_wave<2>(a, lds, xg, j, nj, wave, lane);
    else mixer_wave<3>(a, lds, xg, j, nj, wave, lane);
}

__device__ __forceinline__ void resid_row(const float* base, const float* raw, const float* g, float* xo, bf16* xn, int lane_) {
    int lane = lane_; asm volatile("" : "+v"(lane));
    const GAS f32x4* rr = (const GAS f32x4*)raw + lane; const GAS f32x4* bb = (const GAS f32x4*)base + lane; const GAS f32x4* gg = (const GAS f32x4*)g + lane;
    f32x4 v[4]; float s = 0.f;
#pragma unroll
    for (int j = 0; j < 4; ++j) { v[j] = rr[64 * j]; s += (v[j].x * v[j].x + v[j].y * v[j].y) + (v[j].z * v[j].z + v[j].w * v[j].w); }
    const float rs = 1.f / sqrtf(wave_sum(s) * (1.f / D) + EPS);
    float s2 = 0.f;
#pragma unroll
    for (int j = 0; j < 4; ++j) { v[j] = bb[64 * j] + v[j] * rs * gg[64 * j]; s2 += (v[j].x * v[j].x + v[j].y * v[j].y) + (v[j].z * v[j].z + v[j].w * v[j].w); }
    GAS f32x4* oo = (GAS f32x4*)xo + lane;
#pragma unroll
    for (int j = 0; j < 4; ++j) oo[64 * j] = v[j];
    if (xn) { const float r2 = 1.f / sqrtf(wave_sum(s2) * (1.f / D) + EPS); GAS v2u* o8 = (GAS v2u*)xn + lane;
#pragma unroll
        for (int j = 0; j < 4; ++j) { v2u w; w.x = pk2(v[j].x * r2, v[j].y * r2); w.y = pk2(v[j].z * r2, v[j].w * r2); o8[64 * j] = w; } }
}

#define MFMA32(a, b, c) __builtin_amdgcn_mfma_f32_32x32x16_bf16((a), (b), (c), 0, 0, 0)
__device__ __forceinline__ bf16x8 pack8(const f32x16& x, int s) {
    v4u p; p.x = pk2(x[8 * s], x[8 * s + 1]); p.y = pk2(x[8 * s + 2], x[8 * s + 3]); p.z = pk2(x[8 * s + 4], x[8 * s + 5]); p.w = pk2(x[8 * s + 6], x[8 * s + 7]);
    return __builtin_bit_cast(bf16x8, p);
}
__device__ __forceinline__ void attn_stage(LAS unsigned char* lds, const bf16* G, unsigned pitch  , int wave, int lane) {
    const GAS char* gb = (const GAS char*)G + (size_t)wave * 32 * pitch;
    const unsigned hi = (unsigned)lane >> 5, l31 = (unsigned)lane & 31u;
#pragma unroll
    for (int n = 0; n < 16; ++n) { const unsigned rl = 2u * n + hi;
        const unsigned off = rl * pitch + ((l31 ^ (rl & 15u)) << 4);
        __builtin_amdgcn_global_load_lds((const GAS unsigned*)(gb + off), (LAS unsigned*)(lds + (wave * 16 + n) * 1024), 16, 0, 0); }
}
__device__ __forceinline__ void attn_unit(LAS unsigned char* lds, const bf16* Qb, bf16* Ob, unsigned qoff, const bf16* Kg, const bf16* VTg, bool store, int wave, int lane_) {
    int lane = lane_; asm volatile("" : "+v"(lane));
    const int r = lane & 31, h = lane >> 5;
    attn_stage(lds, Kg, 2048u, wave, lane);
    const GAS char* qp = (const GAS char*)Qb;
    const unsigned qo = qoff + 16u * h;
    const unsigned x = (unsigned)(h ^ (r & 15));
    const LAS unsigned char* fo[8]; const LAS unsigned char* fo2[8];
#pragma unroll
    for (int k = 0; k < 8; ++k) { fo[k] = lds + ((unsigned)r * 512u + (((unsigned)(2 * k) ^ x) * 16u)); fo2[k] = fo[k] + 65536; asm volatile("" : "+v"(fo2[k])); }
    bf16x8 qf[8];
#pragma unroll
    for (int k = 0; k < 8; ++k) qf[k] = *(const GAS bf16x8*)(qp + qo + 32 * k);
    asm volatile("s_waitcnt vmcnt(0)" ::: "memory"); __syncthreads();
    f32x16 s[8];
#pragma unroll
    for (int mb = 0; mb < 8; ++mb)
#pragma unroll
        for (int i = 0; i < 16; ++i) s[mb][i] = 0.f;
#pragma unroll
    for (int hf = 0; hf < 2; ++hf) {
        if (hf == 1) {
#pragma unroll
            for (int k = 0; k < 8; ++k) qf[k] = *(const GAS bf16x8*)(qp + qo + 256 + 32 * k);
        }
        bf16x8 kc[8], kn[8];
#pragma unroll
        for (int k = 0; k < 8; ++k) kc[k] = *(const LAS bf16x8*)(fo[k] + hf * 256);
#pragma unroll
        for (int mb = 0; mb < 8; ++mb) {
            if (mb < 7) {
#pragma unroll
                for (int k = 0; k < 8; ++k) kn[k] = *(const LAS bf16x8*)((mb + 1 < 4 ? fo[k] : fo2[k]) + (((mb + 1) & 3) * 16384 + hf * 256)); }
            __builtin_amdgcn_s_setprio(1);
#pragma unroll
            for (int k = 0; k < 8; ++k) s[mb] = MFMA32(kc[k], qf[k], s[mb]);
            __builtin_amdgcn_s_setprio(0);
#pragma unroll
            for (int k = 0; k < 8; ++k) kc[k] = kn[k];
            asm volatile("" ::: "memory");
        }
    }
    asm volatile("s_waitcnt lgkmcnt(0)" ::: "memory"); __syncthreads();
    { int lane2 = lane; asm volatile("" : "+v"(lane2)); attn_stage(lds, VTg, 512u, wave, lane2); }
    float mx = -3.0e38f;
#pragma unroll
    for (int mb = 0; mb < 8; ++mb)
#pragma unroll
        for (int i = 0; i < 16; ++i) mx = fmaxf(mx, s[mb][i]);
    mx = fmaxf(mx, __shfl_xor(mx, 32));
    float sum; { const float nmc = -mx * 1.44269504089f; const f32x2 c2 = {1.44269504089f, 1.44269504089f}, m2 = {nmc, nmc}; f32x2 sum2 = {0.f, 0.f};
#pragma unroll
    for (int mb = 0; mb < 8; ++mb)
#pragma unroll
        for (int i = 0; i < 16; i += 2) { const f32x2 t = __builtin_elementwise_fma((f32x2){s[mb][i], s[mb][i + 1]}, c2, m2);
            const f32x2 p = {__builtin_amdgcn_exp2f(t.x), __builtin_amdgcn_exp2f(t.y)}; s[mb][i] = p.x; s[mb][i + 1] = p.y; sum2 += p; }
    sum = sum2.x + sum2.y; }
    sum += __shfl_xor(sum, 32);
    const float inv = 1.f / sum;
    bf16x8 pf[8][2];
#pragma unroll
    for (int mb = 0; mb < 8; ++mb) { pf[mb][0] = pack8(s[mb], 0); pf[mb][1] = pack8(s[mb], 1); }
    asm volatile("s_waitcnt vmcnt(0)" ::: "memory"); __syncthreads();
    GAS char* op = (GAS char*)Ob;
    bf16x8 vc[8], vn[8];
#pragma unroll
    for (int k = 0; k < 8; ++k) vc[k] = *(const LAS bf16x8*)(fo[k]);
#pragma unroll
    for (int eb = 0; eb < 8; ++eb) {
        f32x16 o;
#pragma unroll
        for (int i = 0; i < 16; ++i) o[i] = 0.f;
#pragma unroll
        for (int hv = 0; hv < 2; ++hv) {
            const int nstep = 2 * eb + hv + 1;
            if (nstep < 16) { const int neb = nstep >> 1, nhv = nstep & 1;
#pragma unroll
                for (int k = 0; k < 8; ++k) vn[k] = *(const LAS bf16x8*)((neb < 4 ? fo[k] : fo2[k]) + ((neb & 3) * 16384 + nhv * 256)); }
            __builtin_amdgcn_s_setprio(1);
#pragma unroll
            for (int k = 0; k < 8; ++k) o = MFMA32(vc[k], pf[4 * hv + (k >> 1)][k & 1], o);
            __builtin_amdgcn_s_setprio(0);
#pragma unroll
            for (int k = 0; k < 8; ++k) vc[k] = vn[k];
            asm volatile("" ::: "memory");
        }
        if (store) {
#pragma unroll
            for (int g = 0; g < 4; ++g) { v2u w; w.x = pk2(o[4 * g] * inv, o[4 * g + 1] * inv); w.y = pk2(o[4 * g + 2] * inv, o[4 * g + 3] * inv);
                *(GAS v2u*)(op + qoff + 8u * h + (64 * eb + 16 * g)) = w; }
        }
    }
    asm volatile("s_waitcnt lgkmcnt(0)" ::: "memory"); __syncthreads();
}

__device__ __forceinline__ void attn_unit_small(LAS unsigned char* lds, const bf16* Qb, bf16* Ob, const bf16* Kg, const bf16* VTg, int wave, int lane_) {
    int lane = lane_; asm volatile("" : "+v"(lane));
    const int r = lane & 31, h = lane >> 5;
    const GAS char* qp = (const GAS char*)Qb; const GAS char* kp = (const GAS char*)Kg + (size_t)wave * 65536; const GAS char* vp = (const GAS char*)VTg + (size_t)wave * 16384;
    const unsigned qo = (unsigned)(r & 15) * 2048u + 16u * h, ko = (unsigned)r * 2048u + 16u * h, vo = (unsigned)r * 512u + 16u * h;
    bf16x8 qf[16], kf[16], vf[16];
#pragma unroll
    for (int ks = 0; ks < 16; ++ks) { qf[ks] = *(const GAS bf16x8*)(qp + qo + 32 * ks); kf[ks] = *(const GAS bf16x8*)(kp + ko + 32 * ks); }
#pragma unroll
    for (int c = 0; c < 16; ++c) vf[c] = *(const GAS bf16x8*)(vp + vo + 32 * c);
    f32x16 s;
#pragma unroll
    for (int i = 0; i < 16; ++i) s[i] = 0.f;
#pragma unroll
    for (int ks = 0; ks < 16; ++ks) s = MFMA32(kf[ks], qf[ks], s);
    LAS float* red = (LAS float*)lds;
    LAS unsigned char* pbuf = lds + 4096;
    float mx = s[0];
#pragma unroll
    for (int i = 1; i < 16; ++i) mx = fmaxf(mx, s[i]);
    mx = fmaxf(mx, __shfl_xor(mx, 32));
    if (h == 0) red[wave * 32 + r] = mx;
    asm volatile("s_waitcnt lgkmcnt(0)" ::: "memory"); __syncthreads();
#pragma unroll
    for (int w = 0; w < 8; ++w) mx = fmaxf(mx, red[w * 32 + r]);
    float sum = 0.f;
#pragma unroll
    for (int i = 0; i < 16; ++i) { const float p = __builtin_amdgcn_exp2f((s[i] - mx) * 1.44269504089f); s[i] = p; sum += p; }
    sum += __shfl_xor(sum, 32);
    if (h == 0) red[256 + wave * 32 + r] = sum;
    *(LAS bf16x8*)(pbuf + (wave * 2 + 0) * 1024 + lane * 16) = pack8(s, 0);
    *(LAS bf16x8*)(pbuf + (wave * 2 + 1) * 1024 + lane * 16) = pack8(s, 1);
    asm volatile("s_waitcnt lgkmcnt(0)" ::: "memory"); __syncthreads();
    float tot = 0.f;
#pragma unroll
    for (int w = 0; w < 8; ++w) tot += red[256 + w * 32 + r];
    const float inv = 1.f / tot;
    f32x16 o;
#pragma unroll
    for (int i = 0; i < 16; ++i) o[i] = 0.f;
#pragma unroll
    for (int c = 0; c < 16; ++c) { const bf16x8 pf = *(const LAS bf16x8*)(pbuf + c * 1024 + lane * 16); o = MFMA32(vf[c], pf, o); }
    if (r < 16) { GAS char* op = (GAS char*)Ob + (unsigned)r * 2048u + 8u * h + 64u * wave;
#pragma unroll
        for (int g = 0; g < 4; ++g) { v2u w2; w2.x = pk2(o[4 * g] * inv, o[4 * g + 1] * inv); w2.y = pk2(o[4 * g + 2] * inv, o[4 * g + 3] * inv); *(GAS v2u*)(op + 16 * g) = w2; } }
    asm volatile("s_waitcnt lgkmcnt(0)" ::: "memory"); __syncthreads();
}

template <int NT, int KCH>
__device__ __forceinline__ void micro_gemm(LAS unsigned char* lds, const bf16* A, int lda, const bf16* Bt, int ldb, const int (&cb)[NT], int wave, int lane_, int tid_, float (&val)[NT][2]) {
    int lane = lane_, tid = tid_; asm volatile("" : "+v"(lane), "+v"(tid));
    constexpr int KB = (KCH > 8 && NT == 1) ? 16 : 8;
    const int r = lane & 31, h = lane >> 5;
    const GAS char* ap = (const GAS char*)A; const GAS char* bp = (const GAS char*)Bt;
    const unsigned ao = ((unsigned)r * lda + wave * (KCH * 16) + 8 * h) * 2u, bo = ((unsigned)r * ldb + wave * (KCH * 16) + 8 * h) * 2u;
    f32x16 acc[NT];
#pragma unroll
    for (int nt = 0; nt < NT; ++nt)
#pragma unroll
        for (int i = 0; i < 16; ++i) acc[nt][i] = 0.f;
#pragma unroll 1
    for (int kc = 0; kc < KCH; kc += KB) {
        bf16x8 af[KB], bfr[NT][KB];
#pragma unroll
        for (int i = 0; i < KB; ++i) af[i] = *(const GAS bf16x8*)(ap + ao + (kc + i) * 32);
#pragma unroll
        for (int nt = 0; nt < NT; ++nt)
#pragma unroll
            for (int i = 0; i < KB; ++i) bfr[nt][i] = *(const GAS bf16x8*)(bp + (size_t)cb[nt] * ldb * 2 + bo + (kc + i) * 32);
#pragma unroll
        for (int nt = 0; nt < NT; ++nt)
#pragma unroll
            for (int i = 0; i < KB; ++i) acc[nt] = MFMA32(af[i], bfr[nt][i], acc[nt]);
    }
    LAS float* part = (LAS float*)lds;
#pragma unroll
    for (int nt = 0; nt < NT; ++nt)
#pragma unroll
        for (int i = 0; i < 16; ++i) part[(wave * NT + nt) * 1024 + ((i & 3) + 8 * (i >> 2) + 4 * h) * 32 + r] = acc[nt][i];
    __syncthreads();
#pragma unroll
    for (int nt = 0; nt < NT; ++nt) { float s0 = 0.f, s1 = 0.f;
#pragma unroll
        for (int w = 0; w < 8; ++w) { const f32x2 p = *(const LAS f32x2*)(part + (w * NT + nt) * 1024 + 2 * tid); s0 += p.x; s1 += p.y; }
        val[nt][0] = s0; val[nt][1] = s1; }
}
__device__ __forceinline__ void micro_gemm_lds(LAS unsigned char* lds, const bf16* A, int lda, const bf16* Bt, int ldb, int cb0, int wave, int lane_, int tid_, float (&val)[1][2]) {
    int lane = lane_, tid = tid_; asm volatile("" : "+v"(lane), "+v"(tid));
    const int r = lane & 31, h = lane >> 5;
    LAS unsigned char* reg = lds + wave * 16384;
    __syncthreads();
    { const unsigned rq = (unsigned)lane >> 4, pc = (unsigned)lane & 15u;
      const GAS char* ap = (const GAS char*)A + wave * 256; const GAS char* bp = (const GAS char*)(Bt + (size_t)cb0 * ldb) + wave * 256;
#pragma unroll
      for (int n = 0; n < 8; ++n) { const unsigned row = 4u * n + rq, lc = pc ^ (row & 15u);
          __builtin_amdgcn_global_load_lds((const GAS unsigned*)(ap + row * (unsigned)(lda * 2) + lc * 16u), (LAS unsigned*)(reg + n * 1024), 16, 0, 0); }
#pragma unroll
      for (int n = 0; n < 8; ++n) { const unsigned row = 4u * n + rq, lc = pc ^ (row & 15u);
          __builtin_amdgcn_global_load_lds((const GAS unsigned*)(bp + row * (unsigned)(ldb * 2) + lc * 16u), (LAS unsigned*)(reg + 8192 + n * 1024), 16, 0, 0); } }
    f32x16 acc;
#pragma unroll
    for (int i = 0; i < 16; ++i) acc[i] = 0.f;
    const LAS unsigned char* fa = reg + r * 256; const unsigned x = (unsigned)(r & 15);
    asm volatile("s_waitcnt vmcnt(0)" ::: "memory");
    bf16x8 af[8], bfr[8];
#pragma unroll
    for (int i = 0; i < 8; ++i) { const unsigned pcx = ((unsigned)(2 * i + h) ^ x) * 16u; af[i] = *(const LAS bf16x8*)(fa + pcx); bfr[i] = *(const LAS bf16x8*)(fa + 8192 + pcx); }
#pragma unroll
    for (int i = 0; i < 8; ++i) acc = MFMA32(af[i], bfr[i], acc);
    asm volatile("s_waitcnt lgkmcnt(0)" ::: "memory");
    LAS float* part = (LAS float*)reg;
#pragma unroll
    for (int i = 0; i < 16; ++i) part[((i & 3) + 8 * (i >> 2) + 4 * h) * 32 + r] = acc[i];
    __syncthreads();
    float s0 = 0.f, s1 = 0.f;
#pragma unroll
    for (int w = 0; w < 8; ++w) { const f32x2 p = *(const LAS f32x2*)((const LAS float*)(lds + w * 16384) + 2 * tid); s0 += p.x; s1 += p.y; }
    val[0][0] = s0; val[0][1] = s1;
}
__device__ __forceinline__ void micro_gemm_lds_k4096(LAS unsigned char* lds, const bf16* A, int lda, const bf16* Bt, int ldb, int cb0, int wave, int lane_, int tid_, float (&val)[1][2]) {
    int lane = lane_, tid = tid_; asm volatile("" : "+v"(lane), "+v"(tid));
    const int r = lane & 31, h = lane >> 5;
    LAS unsigned char* reg = lds + wave * 16384;
    __syncthreads();
    const unsigned rq = (unsigned)lane >> 3, pc = (unsigned)lane & 7u;
    const GAS char* ap = (const GAS char*)A + wave * 128; const GAS char* bp = (const GAS char*)(Bt + (size_t)cb0 * ldb) + wave * 128;
    unsigned ao[4], bo[4];
#pragma unroll
    for (int n = 0; n < 4; ++n) { const unsigned row = 8u * n + rq, lc = pc ^ ((row >> 1) & 7u); ao[n] = row * (unsigned)(lda * 2) + lc * 16u; bo[n] = row * (unsigned)(ldb * 2) + lc * 16u; }
#define MG4K_ISSUE(rd) do { LAS unsigned char* dst_ = reg + ((rd) & 1) * 8192; \
        _Pragma("unroll") for (int n = 0; n < 4; ++n) __builtin_amdgcn_global_load_lds((const GAS unsigned*)(ap + (rd) * 1024 + ao[n]), (LAS unsigned*)(dst_ + n * 1024), 16, 0, 0); \
        _Pragma("unroll") for (int n = 0; n < 4; ++n) __builtin_amdgcn_global_load_lds((const GAS unsigned*)(bp + (rd) * 1024 + bo[n]), (LAS unsigned*)(dst_ + 4096 + n * 1024), 16, 0, 0); } while (0)
    f32x16 acc;
#pragma unroll
    for (int i = 0; i < 16; ++i) acc[i] = 0.f;
    const unsigned x = (unsigned)(r >> 1) & 7u;
    MG4K_ISSUE(0);
#pragma unroll
    for (int rd = 0; rd < 8; ++rd) {
        if (rd < 7) { MG4K_ISSUE(rd + 1); asm volatile("s_waitcnt vmcnt(8)" ::: "memory"); } else asm volatile("s_waitcnt vmcnt(0)" ::: "memory");
        const LAS unsigned char* fa = reg + (rd & 1) * 8192 + r * 128;
        bf16x8 af[4], bfr[4];
#pragma unroll
        for (int i = 0; i < 4; ++i) { const unsigned pcx = ((unsigned)(2 * i + h) ^ x) * 16u; af[i] = *(const LAS bf16x8*)(fa + pcx); bfr[i] = *(const LAS bf16x8*)(fa + 4096 + pcx); }
#pragma unroll
        for (int i = 0; i < 4; ++i) acc = MFMA32(af[i], bfr[i], acc);
        asm volatile("s_waitcnt lgkmcnt(0)" ::: "memory");
    }
#undef MG4K_ISSUE
    LAS float* part = (LAS float*)reg;
#pragma unroll
    for (int i = 0; i < 16; ++i) part[((i & 3) + 8 * (i >> 2) + 4 * h) * 32 + r] = acc[i];
    __syncthreads();
    float s0 = 0.f, s1 = 0.f;
#pragma unroll
    for (int w = 0; w < 8; ++w) { const f32x2 p = *(const LAS f32x2*)((const LAS float*)(lds + w * 16384) + 2 * tid); s0 += p.x; s1 += p.y; }
    val[0][0] = s0; val[0][1] = s1;
}
template <int NT>
__device__ __forceinline__ void micro_gemm_lds_nt(LAS unsigned char* lds, const bf16* A, int lda, const bf16* Bt, int ldb, const int (&cb)[NT], int wave, int lane_, int tid_, float (&val)[NT][2]) {
    int lane = lane_, tid = tid_; asm volatile("" : "+v"(lane), "+v"(tid));
    const int r = lane & 31, h = lane >> 5;
    LAS unsigned char* reg = lds + wave * 16384;
    __syncthreads();
    { const unsigned rq = (unsigned)lane >> 4, pc = (unsigned)lane & 15u; const GAS char* ap = (const GAS char*)A + wave * 256;
#pragma unroll
      for (int n = 0; n < 8; ++n) { const unsigned row = 4u * n + rq, lc = pc ^ (row & 15u);
          __builtin_amdgcn_global_load_lds((const GAS unsigned*)(ap + row * (unsigned)(lda * 2) + lc * 16u), (LAS unsigned*)(reg + n * 1024), 16, 0, 0); } }
    const unsigned rq8 = (unsigned)lane >> 3, pc8 = (unsigned)lane & 7u;
    unsigned bo[4];
#pragma unroll
    for (int n = 0; n < 4; ++n) { const unsigned row = 8u * n + rq8, lc = pc8 ^ ((row >> 1) & 7u); bo[n] = row * (unsigned)(ldb * 2) + lc * 16u; }
    const GAS char* bbase = (const GAS char*)Bt + wave * 256;
#define MGNT_ISSUE(rd) do { LAS unsigned char* dst_ = reg + 8192 + ((rd) & 1) * 4096; const GAS char* bp_ = bbase + (size_t)cb[(rd) >> 1] * ldb * 2 + ((rd) & 1) * 128; \
        _Pragma("unroll") for (int n = 0; n < 4; ++n) __builtin_amdgcn_global_load_lds((const GAS unsigned*)(bp_ + bo[n]), (LAS unsigned*)(dst_ + n * 1024), 16, 0, 0); } while (0)
    MGNT_ISSUE(0);
    f32x16 acc[NT];
#pragma unroll
    for (int nt = 0; nt < NT; ++nt)
#pragma unroll
        for (int i = 0; i < 16; ++i) acc[nt][i] = 0.f;
    asm volatile("s_waitcnt vmcnt(4)" ::: "memory");
    bf16x8 af[8];
    { const LAS unsigned char* fa = reg + r * 256; const unsigned x = (unsigned)(r & 15);
#pragma unroll
      for (int i = 0; i < 8; ++i) af[i] = *(const LAS bf16x8*)(fa + (((unsigned)(2 * i + h) ^ x) * 16u)); }
    const unsigned x8 = (unsigned)(r >> 1) & 7u;
#pragma unroll
    for (int rd = 0; rd < 2 * NT; ++rd) {
        if (rd + 1 < 2 * NT) { MGNT_ISSUE(rd + 1); asm volatile("s_waitcnt vmcnt(4)" ::: "memory"); } else asm volatile("s_waitcnt vmcnt(0)" ::: "memory");
        const LAS unsigned char* fb = reg + 8192 + (rd & 1) * 4096 + r * 128;
        bf16x8 bfr[4];
#pragma unroll
        for (int i = 0; i < 4; ++i) bfr[i] = *(const LAS bf16x8*)(fb + (((unsigned)(2 * i + h) ^ x8) * 16u));
#pragma unroll
        for (int i = 0; i < 4; ++i) acc[rd >> 1] = MFMA32(af[4 * (rd & 1) + i], bfr[i], acc[rd >> 1]);
        asm volatile("s_waitcnt lgkmcnt(0)" ::: "memory");
    }
#undef MGNT_ISSUE
    LAS float* part = (LAS float*)reg;
#pragma unroll
    for (int nt = 0; nt < NT; ++nt)
#pragma unroll
        for (int i = 0; i < 16; ++i) part[nt * 1024 + ((i & 3) + 8 * (i >> 2) + 4 * h) * 32 + r] = acc[nt][i];
    __syncthreads();
#pragma unroll
    for (int nt = 0; nt < NT; ++nt) { float s0 = 0.f, s1 = 0.f;
#pragma unroll
        for (int w = 0; w < 8; ++w) { const f32x2 p = *(const LAS f32x2*)((const LAS float*)(lds + w * 16384) + nt * 1024 + 2 * tid); s0 += p.x; s1 += p.y; }
        val[nt][0] = s0; val[nt][1] = s1; }
}
__device__ __forceinline__ void sample_gemm1_piece(const Args& a, LAS unsigned char* lds, int p, int wave, int lane, int tid_) {
    int tid = tid_; asm volatile("" : "+v"(tid));
    const int rg = p & 7, cp = p >> 3; int cb[2];
    if (cp < 16) { cb[0] = 64 * cp; cb[1] = 64 * cp + 32; } else { const int q = cp - 16; cb[0] = 1024 + 256 * (q >> 2) + 32 * (q & 3); cb[1] = cb[0] + 128; }
    float val[2][2];
    micro_gemm_lds_nt<2>(lds, (const bf16*)(a.ws + WS_XN) + (size_t)(MP + 32 * rg) * D, D, (const bf16*)(a.ws + WS_WIN), D, cb, wave, lane, tid, val);
    const int rs_ = 32 * rg + (tid >> 4), row = MP + rs_, t = rs_ & 15, sb = rs_ >> 4, c2 = 2 * (tid & 15);
    bf16* P1 = (bf16*)(a.ws + WS_P1) + (size_t)row * 1536;
    if (cp < 16) {
#pragma unroll
        for (int nt = 0; nt < 2; ++nt) { const int col = cb[nt] + c2; *(GAS unsigned*)(P1 + col) = pk2(val[nt][0], val[nt][1]);
            if (cp < 8 && t >= 1) *(GAS f32x2*)(a.out + OUT_POOL_S + (size_t)(sb * 15 + t - 1) * 512 + col) = (f32x2){val[nt][0], val[nt][1]}; }
    } else {
        const int ch = 32 * (cp - 16) + c2; const float v0 = val[0][0] * val[1][0], v1 = val[0][1] * val[1][1];
        *(GAS unsigned*)(P1 + 1024 + ch) = pk2(v0, v1);
        if (t >= 14) *(GAS f32x2*)(a.out + OUT_CONV_S + (size_t)(sb * 2 + t - 14) * 512 + ch) = (f32x2){v0, v1};
    }
    __syncthreads();
}
struct SampleX { unsigned* xbuf; unsigned* cnt; float* rsp; unsigned* tmo; };
template <int NT, int KCH, int MODE>
__device__ __forceinline__ void sample_gemm_piece(LAS unsigned char* lds, const bf16* A, int K, const bf16* Bt, bf16* C, int ldc, const float* rsp, int p, int wave, int lane, int tid_) {
    int tid = tid_; asm volatile("" : "+v"(tid));
    const int rg = p & 7, cp = p >> 3; int cb[NT];
#pragma unroll
    for (int nt = 0; nt < NT; ++nt) cb[nt] = 32 * NT * cp + 32 * nt;
    const int rl = 32 * rg + (tid >> 4); const size_t row = MP + rl; const int c2 = 2 * (tid & 15);
    f32x4 pr[8];
    if (rsp) { const GAS f32x4* pp = (const GAS f32x4*)(rsp + (size_t)rl * 32);
#pragma unroll
        for (int k = 0; k < 8; ++k) pr[k] = pp[k]; }
    float val[NT][2];
    if constexpr (NT == 1 && KCH == 8) micro_gemm_lds(lds, A + (size_t)(MP + 32 * rg) * K, K, Bt, K, cb[0], wave, lane, tid, val);
    else if constexpr (KCH == 8) micro_gemm_lds_nt<NT>(lds, A + (size_t)(MP + 32 * rg) * K, K, Bt, K, cb, wave, lane, tid, val);
    else micro_gemm<NT, KCH>(lds, A + (size_t)(MP + 32 * rg) * K, K, Bt, K, cb, wave, lane, tid, val);
    float rs = 1.f;
    if (rsp) { f32x4 t = pr[0];
#pragma unroll
        for (int k = 1; k < 8; ++k) t = t + pr[k];
        rs = 1.f / sqrtf(((t[0] + t[1]) + (t[2] + t[3])) * (1.f / D) + EPS); }
#pragma unroll
    for (int nt = 0; nt < NT; ++nt) {
        float v0 = val[nt][0] * rs, v1 = val[nt][1] * rs;
        if (MODE == 2) { v0 = fmaxf(v0, 0.f); v0 *= v0; v1 = fmaxf(v1, 0.f); v1 *= v1; }
        *(GAS unsigned*)(C + row * ldc + cb[nt] + c2) = pk2(v0, v1);
    }
    __syncthreads();
}
template <int KCH>
__device__ __forceinline__ void sample_fused_A(LAS unsigned char* lds, const bf16* A, int K, const bf16* Bt, const SampleX& sx, int p, int wave, int lane, int tid_) {
    int tid = tid_; asm volatile("" : "+v"(tid));
    const int rg = p & 7, cp = p >> 3; int cb[1] = {32 * cp};
    float val[1][2];
    if constexpr (KCH == 8) micro_gemm_lds(lds, A + (size_t)(MP + 32 * rg) * K, K, Bt, K, cb[0], wave, lane, tid, val);
    else if constexpr (KCH == 32) micro_gemm_lds_k4096(lds, A + (size_t)(MP + 32 * rg) * K, K, Bt, K, cb[0], wave, lane, tid, val);
    else micro_gemm<1, KCH>(lds, A + (size_t)(MP + 32 * rg) * K, K, Bt, K, cb, wave, lane, tid, val);
    const int rl = 32 * rg + (tid >> 4);
    float s = val[0][0] * val[0][0] + val[0][1] * val[0][1];
    s += __shfl_xor(s, 1); s += __shfl_xor(s, 2); s += __shfl_xor(s, 4); s += __shfl_xor(s, 8);
    if ((tid & 15) == 0) __hip_atomic_store(sx.xbuf + (size_t)rl * 32 + cp, __float_as_uint(s), __ATOMIC_RELAXED, __HIP_MEMORY_SCOPE_AGENT);
    *(LAS f32x2*)(lds + STASH_OFF + tid * 8) = (f32x2){val[0][0], val[0][1]};
    asm volatile("s_waitcnt vmcnt(0) lgkmcnt(0)" ::: "memory"); __syncthreads();
    if (tid == 0) __hip_atomic_fetch_add(sx.cnt + 64 * rg, 1u, __ATOMIC_RELAXED, __HIP_MEMORY_SCOPE_AGENT);
}
template <bool FINAL>
__device__ __forceinline__ void sample_fused_B(LAS unsigned char* lds, const float* base, const float* g, float* Y, bf16* X, const SampleX& sx, int p, int wave, int lane, int tid_) {
    int tid = tid_; asm volatile("" : "+v"(tid));
    const int rg = p & 7, cp = p >> 3;
    const int rl = 32 * rg + (tid >> 4); const int col = 32 * cp + 2 * (tid & 15);
    const f32x2 bs = *(const GAS f32x2*)(base + (size_t)rl * D + col), gv = *(const GAS f32x2*)(g + col);
    if (wave == 0) { unsigned sp = 0;
        while ((unsigned)__builtin_amdgcn_readfirstlane(__hip_atomic_load(sx.cnt + 64 * rg, __ATOMIC_RELAXED, __HIP_MEMORY_SCOPE_AGENT)) < 32u) {
            __builtin_amdgcn_s_sleep(2);
            if ((++sp & 1023u) == 0u) { if (__hip_atomic_load(sx.tmo, __ATOMIC_RELAXED, __HIP_MEMORY_SCOPE_AGENT) != 0u) break; if (sp > (1u << 22)) { if (lane == 0) __hip_atomic_store(sx.tmo, 1u, __ATOMIC_RELAXED, __HIP_MEMORY_SCOPE_AGENT); break; } } }
        }
    __syncthreads();
    float tot = 0.f;
    { const unsigned* slot = sx.xbuf + (size_t)rl * 32;
#pragma unroll
      for (int k = 0; k < 32; ++k) tot += __uint_as_float(__hip_atomic_load(slot + k, __ATOMIC_RELAXED, __HIP_MEMORY_SCOPE_AGENT)); }
    const f32x2 val = *(const LAS f32x2*)(lds + STASH_OFF + tid * 8);
    const float rs = 1.f / sqrtf(tot * (1.f / D) + EPS);
    const float x0 = bs[0] + val[0] * rs * gv[0], x1 = bs[1] + val[1] * rs * gv[1];
    *(GAS f32x2*)(Y + (size_t)rl * D + col) = (f32x2){x0, x1};
    if (!FINAL) {
        *(GAS unsigned*)(X + (size_t)rl * D + col) = pk2(x0, x1);
        float q = x0 * x0 + x1 * x1;
        q += __shfl_xor(q, 1); q += __shfl_xor(q, 2); q += __shfl_xor(q, 4); q += __shfl_xor(q, 8);
        if ((tid & 15) == 0) sx.rsp[(size_t)rl * 32 + cp] = q;
    }
    __syncthreads();
}
template <int KCH, bool FINAL>
__device__ __forceinline__ void sample_fused_piece(LAS unsigned char* lds, const bf16* A, int K, const bf16* Bt, const float* base, const float* g, float* Y, bf16* X, const SampleX& sx, int p, int wave, int lane, int tid) {
    sample_fused_A<KCH>(lds, A, K, Bt, sx, p, wave, lane, tid);
    sample_fused_B<FINAL>(lds, base, g, Y, X, sx, p, wave, lane, tid);
}

__global__ void __launch_bounds__(NWAVES * 64, 2) enc_fwd(Args args) {
    extern __shared__ __attribute__((aligned(16))) unsigned char lds_raw[];
    LAS unsigned char* lds = (LAS unsigned char*)lds_raw;
    volatile LAS unsigned* MISC = (volatile LAS unsigned*)(lds + MISC_OFF);
    const int tid = threadIdx.x, lane = tid & 63, wave = __builtin_amdgcn_readfirstlane(tid >> 6);
    const int G = gridDim.x; const int bx = blockIdx.x; const int vcu = (G % 8 == 0) ? (bx % 8) * (G / 8) + bx / 8 : bx;
    const int gw = vcu * NWAVES + wave, NGW = G * NWAVES;
    unsigned char* ws = args.ws;
    unsigned* ctl = (unsigned*)(ws + WS_CTL);
    for (int u = tid; u < (LDS_BYTES - LDSCTL_OFF) / 4; u += NWAVES * 64) ((LAS unsigned*)(lds + LDSCTL_OFF))[u] = 0u;
    __syncthreads();
    XcdBarrier bar = xcd_barrier_post(ctl + CW_BAR, MISC + 8);
#define GRID_BAR() do { xcd_arrive(bar); xcd_wait(bar); } while (0)
    if (tid == 0) { unsigned* gp = ctl + CW_BAR + XB_GRP(bx & 7); const unsigned me = bar.x + 1u;
        const unsigned prev = atomicCAS(gp, 0u, me);
        if (prev != 0u && prev != me) __hip_atomic_store(ctl + CW_BAR + XB_MIS, 1u, __ATOMIC_RELAXED, __HIP_MEMORY_SCOPE_AGENT); }
    bf16* XN = (bf16*)(ws + WS_XN);
    float* Y = args.out + OUT_Y;

    p0_prologue(args, lds, gw, NGW, wave, lane);
    GRID_BAR();

    const bool localok = G == 256 && __hip_atomic_load(ctl + CW_BAR + XB_MIS, __ATOMIC_RELAXED, __HIP_MEMORY_SCOPE_AGENT) == 0u;
#define GRID_BAR_NOWB() do { if (localok) { xcd_arrive<false>(bar); xcd_wait(bar); } else GRID_BAR(); } while (0)
#define LOCAL_BAR() do { if (localok) xcd_local_barrier(bar); else GRID_BAR(); } while (0)
    if (bx & 1) for (int p = bx; p < 256; p += G) sample_gemm1_piece(args, lds, p, wave, lane, tid);
    { pg8::Gemm g{XN, (const bf16*)(ws + WS_WIN), MP, NIN, D}; pg8::StaticOrder S; S.init(MP, NIN, G, bx);
      pg8::Epi1 E{(bf16*)(ws + WS_P1), args.out + OUT_POOL_P, args.out + OUT_CONV_P, args.out + OUT_POOL_S, args.out + OUT_CONV_S};
      pg8::gemm_phase<pg8::Epi1, pg8::StaticOrder, true, true>(lds, g, S, E); }
    if (!(bx & 1)) for (int p = bx; p < 256; p += G) sample_gemm1_piece(args, lds, p, wave, lane, tid);
    GRID_BAR();

    if (bx < 32 && G > 32) {
      pg8::Gemm g{(const bf16*)(ws + WS_MN), (const bf16*)(ws + WS_WKV), 1024, 2048, D}; pg8::StaticOrder S; S.init(1024, 2048, 32, bx);
      pg8::EpiKV E{args.out + OUT_MK, args.out + OUT_MV, (bf16*)(ws + WS_KB), (bf16*)(ws + WS_VT)};
      pg8::gemm_phase<pg8::EpiKV, pg8::StaticOrder, true, true>(lds, g, S, E);
    } else {
      const int gw2 = (bx - 32) * NWAVES + wave, NGW2 = (G - 32) * NWAVES;
      if (G == 256) mixer_all(args, lds, bx & 7, (bx - 32) >> 3, 28, wave, lane);
      else mixer_all(args, lds, -1, bx - 32, G - 32, wave, lane);
      if (G == 256) { const int lw = ((bx - 32) >> 3) * NWAVES + wave, xg = bx & 7, NV = (180 + 2 * 44) * 8;
          if (lw < 180) p2_late(args, lds, lw * 8 + xg, NV, wave, lane);
          else { p2_late(args, lds, (180 + 2 * (lw - 180)) * 8 + xg, NV, wave, lane); p2_late(args, lds, (181 + 2 * (lw - 180)) * 8 + xg, NV, wave, lane); } }
      else { __syncthreads(); p2_late(args, lds, gw2, NGW2, wave, lane); }
    }
    GRID_BAR();

    bf16* SQO = (bf16*)(ws + WS_SQO) - (size_t)MP * D; bf16* SAO = (bf16*)(ws + WS_SAO) - (size_t)MP * D; bf16* SHID = (bf16*)(ws + WS_SHID) - (size_t)MP * FF;
    unsigned* tmo = ctl + CW_TMO;
    float* Ys = Y + (size_t)MP * D; bf16* XNs = XN + (size_t)MP * D;
    const SampleX sx0{(unsigned*)(ws + WS_SXB), ctl + CW_SSEAM, (float*)(ws + WS_SRSP), tmo};
    const SampleX sx1{(unsigned*)(ws + WS_SXB + 32768), ctl + CW_SSEAM + 512, (float*)(ws + WS_SRSP + 32768), tmo};
    const SampleX sx2{(unsigned*)(ws + WS_SXB + 65536), ctl + CW_SSEAM + 1024, nullptr, tmo};

    { pg8::Gemm g{(const bf16*)(ws + WS_MRG), (const bf16*)(ws + WS_WOUT), MP, D, D}; pg8::StaticOrder S; S.init(MP, D, G, bx);
      pg8::EpiRes<1> E{(const float*)(ws + WS_RNORM), XN, nullptr, args.in[15], (unsigned*)(ws + WS_XB1), ctl + CW_SEAM, (float*)(ws + WS_RSP1), tmo};
      if (G == 256) sample_fused_A<8>(lds, (const bf16*)(ws + WS_MRG), D, (const bf16*)(ws + WS_WOUT), sx0, bx, wave, lane, tid);
      pg8::gemm_phase<pg8::EpiRes<1>, pg8::StaticOrder, false, true>(lds, g, S, E); }
    if (G == 256) sample_fused_B<false>(lds, args.in[1], args.in[15], Ys, XNs, sx0, bx, wave, lane, tid);
    else for (int p = bx; p < 256; p += G) sample_fused_piece<8, false>(lds, (const bf16*)(ws + WS_MRG), D, (const bf16*)(ws + WS_WOUT), args.in[1], args.in[15], Ys, XNs, sx0, p, wave, lane, tid);
    LOCAL_BAR();
    if (bx & 1) for (int p = bx; p < 256; p += G) sample_gemm_piece<1, 8, 1>(lds, XN, D, (const bf16*)(ws + WS_WQ), SQO, D, sx0.rsp, p, wave, lane, tid);
    { pg8::Gemm g{XN, (const bf16*)(ws + WS_WQ), MP, D, D}; pg8::StaticOrder S; S.init(MP, D, G, bx);
      pg8::EpiBf16S<0, false> E{(bf16*)(ws + WS_QO), D, (const float*)(ws + WS_RSP1), nullptr};
      pg8::gemm_phase<pg8::EpiBf16S<0, false>, pg8::StaticOrder, true, true>(lds, g, S, E); }
    if (!(bx & 1)) for (int p = bx; p < 256; p += G) sample_gemm_piece<1, 8, 1>(lds, XN, D, (const bf16*)(ws + WS_WQ), SQO, D, sx0.rsp, p, wave, lane, tid);
    LOCAL_BAR();
    { const bf16* QO = (const bf16*)(ws + WS_QO); bf16* AO = (bf16*)(ws + WS_AO);
      pg8::StaticOrder SA; SA.init(MP, D, G, bx); pg8::Unit au;
      for (int i = 0; SA.next(i, au); ++i) {
          const int hd = au.pn, b = au.pm >> 4; const size_t qb = (size_t)(au.pm * 256 + wave * 32) * D + hd * 256;
          int ln = lane; asm volatile("" : "+v"(ln));
          attn_unit(lds, QO + qb, AO + qb, (unsigned)(ln & 31) * 2048u, (const bf16*)(ws + WS_KB) + (size_t)b * 256 * 1024 + hd * 256, (const bf16*)(ws + WS_VT) + (size_t)(b * 4 + hd) * 65536, true, wave, ln);
      } }
    if (G == 256 && bx >= 64) { int ln = lane; asm volatile("" : "+v"(ln));
        p0_items(args, (LAS float*)(lds + wave * 16384), DN_LO, DN_HI, (bx - 64) * NWAVES + wave, 192 * NWAVES, ln); }
    else if (G != 256) { int ln = lane; asm volatile("" : "+v"(ln)); p0_items(args, (LAS float*)(lds + wave * 16384), DN_LO, DN_HI, gw, NGW, ln); }
    for (int u = bx; u < 64; u += G) {
        const int sb = 2 * (u & 7) + (u >> 5), hd = (u >> 3) & 3; const size_t qb = (size_t)(MP + sb * 16) * D + hd * 256;
        attn_unit_small(lds, SQO + qb, SAO + qb, (const bf16*)(ws + WS_KBS) + (size_t)sb * 256 * 1024 + hd * 256, (const bf16*)(ws + WS_VTS) + (size_t)(sb * 4 + hd) * 65536, wave, lane);
    }
    GRID_BAR_NOWB();
    { pg8::Gemm g{(const bf16*)(ws + WS_AO), (const bf16*)(ws + WS_WCO), MP, D, D}; pg8::StaticOrder S; S.init(MP, D, G, bx);
      pg8::EpiRes<2> E{nullptr, XN, nullptr, args.in[22], (unsigned*)(ws + WS_XB2), ctl + CW_SEAM + 4096, (float*)(ws + WS_RSP2), tmo};
      if (G == 256) sample_fused_A<8>(lds, SAO, D, (const bf16*)(ws + WS_WCO), sx1, bx, wave, lane, tid);
      pg8::gemm_phase<pg8::EpiRes<2>, pg8::StaticOrder, false, true>(lds, g, S, E); }
    if (G == 256) sample_fused_B<false>(lds, Ys, args.in[22], Ys, XNs, sx1, bx, wave, lane, tid);
    else for (int p = bx; p < 256; p += G) sample_fused_piece<8, false>(lds, SAO, D, (const bf16*)(ws + WS_WCO), Ys, args.in[22], Ys, XNs, sx1, p, wave, lane, tid);
    LOCAL_BAR();
    if (bx & 1) for (int p = bx; p < 256; p += G) sample_gemm_piece<4, 8, 2>(lds, XN, D, (const bf16*)(ws + WS_WUP), SHID, FF, sx1.rsp, p, wave, lane, tid);
    { pg8::Gemm g{XN, (const bf16*)(ws + WS_WUP), MP, FF, D}; pg8::StaticOrder S; S.init(MP, FF, G, bx);
      LAS float* rstab = (LAS float*)(lds + RSTAB_OFF);
      { pg8::Unit u0; if (S.next(0, u0) && tid < 256) { const f32x4 p = *(const GAS f32x4*)((const float*)(ws + WS_RSP2) + (size_t)(u0.pm * 256 + tid) * 4);
            rstab[tid] = 1.0f / sqrtf(((p[0] + p[1]) + (p[2] + p[3])) * (1.0f / 1024.0f) + EPS); } }
      __syncthreads();
      pg8::EpiBf16S<1, true> E{(bf16*)(ws + WS_HID), FF, (const float*)(ws + WS_RSP2), rstab};
      pg8::gemm_phase<pg8::EpiBf16S<1, true>, pg8::StaticOrder, true, true>(lds, g, S, E); }
    if (!(bx & 1)) for (int p = bx; p < 256; p += G) sample_gemm_piece<4, 8, 2>(lds, XN, D, (const bf16*)(ws + WS_WUP), SHID, FF, sx1.rsp, p, wave, lane, tid);
    LOCAL_BAR();
    { pg8::Gemm g{(const bf16*)(ws + WS_HID), (const bf16*)(ws + WS_WDOWN), MP, D, FF}; pg8::StaticOrder S; S.init(MP, D, G, bx);
      pg8::EpiRes<3> E{nullptr, XN, Y, args.in[26], (unsigned*)(ws + WS_XB3), ctl + CW_SEAM + 8192, nullptr, tmo};
      if (G == 256 && (bx & 1)) sample_fused_A<32>(lds, SHID, FF, (const bf16*)(ws + WS_WDOWN), sx2, bx, wave, lane, tid);
      pg8::gemm_phase<pg8::EpiRes<3>, pg8::StaticOrder, false, true>(lds, g, S, E); }
    if (G == 256 && !(bx & 1)) { __syncthreads(); sample_fused_A<32>(lds, SHID, FF, (const bf16*)(ws + WS_WDOWN), sx2, bx, wave, lane, tid); }
    if (G == 256) sample_fused_B<true>(lds, Ys, args.in[26], Ys, nullptr, sx2, bx, wave, lane, tid);
    else for (int p = bx; p < 256; p += G) sample_fused_piece<32, true>(lds, SHID, FF, (const bf16*)(ws + WS_WDOWN), Ys, args.in[26], Ys, nullptr, sx2, p, wave, lane, tid);
}

extern "C" void kernel_launch(void* const* d_in, const int* in_sizes, int n_in, void* d_out, int out_size, void* d_ws, size_t ws_size, hipStream_t stream) {
    static int grid = 0;
    if (grid == 0) {
        if (n_in != 27 || (size_t)out_size != OUT_TOTAL || ws_size < WS_END) { fprintf(stderr, "kernel_launch: unexpected sizes n_in %d out %d ws %zu\n", n_in, out_size, ws_size); grid = -1; return; }
        int dev = 0, cus = 0, per_cu = 0;
        if (hipGetDevice(&dev) != hipSuccess || hipDeviceGetAttribute(&cus, hipDeviceAttributeMultiprocessorCount, dev) != hipSuccess) { grid = -1; return; }
        if (hipFuncSetAttribute((const void*)enc_fwd, hipFuncAttributeMaxDynamicSharedMemorySize, LDS_BYTES) != hipSuccess) { fprintf(stderr, "kernel_launch: hipFuncSetAttribute failed\n"); grid = -1; return; }
        if (hipOccupancyMaxActiveBlocksPerMultiprocessor(&per_cu, (const void*)enc_fwd, NWAVES * 64, LDS_BYTES) != hipSuccess || per_cu < 1) { fprintf(stderr, "kernel_launch: occupancy query says %d blocks/CU\n", per_cu); per_cu = 1; }
        (void)hipGetLastError();
        grid = cus;
    }
    if (grid < 0) return;
    (void)hipMemsetAsync((char*)d_ws + WS_CTL, 0, CTL_ZERO_BYTES, stream);
    Args a{};
    for (int i = 0; i < 27; ++i) a.in[i] = (const float*)d_in[i];
    a.out = (float*)d_out; a.ws = (unsigned char*)d_ws;
    hipLaunchKernelGGL(enc_fwd, dim3(grid), dim3(NWAVES * 64), LDS_BYTES, stream, a);
}
```
